# Optimizing an MI355X kernel written in HIP

```python
import jax, jax.numpy as jnp
from jax import lax
import numpy as np

D_MODEL = 1024
BATCH = 8
SEQ = 4096
DEPTH = 1

CHUNK = 64
ATTN_HEADS = 8
ATTN_KV_HEADS = 2
HEAD_DIM = 64
ATTN_WIDTH = ATTN_HEADS * HEAD_DIM
KV_WIDTH = ATTN_KV_HEADS * HEAD_DIM
ATTN_SCALE = HEAD_DIM ** -0.5
IDX_HEADS = 4
IDX_DIM = 64
IDX_ROPE_DIM = 32
IDX_SCALE = (IDX_HEADS ** -0.5) * (IDX_DIM ** -0.5)
IDX_TOPK_MAX = 256
QUERY_BLOCK = 128
POOL_GROUPS = 4
POOL_WINDOWS = (2, 4, 8, 16)
POOL_WIDTH = 512
POOL_GROUP_DIM = POOL_WIDTH // POOL_GROUPS
N_EXPERTS = 32
TOP_K = 4
EXPERT_DIM = D_MODEL
SWIGLU_ALPHA = 1.702
SWIGLU_LIMIT = 7.0
EXPERT_BLOCK = 256
ROPE_THETA = 10000.0
NORM_EPS = 1e-6
IN_SPLITS = (ATTN_WIDTH, KV_WIDTH, KV_WIDTH, IDX_HEADS * IDX_DIM, IDX_DIM, IDX_HEADS, POOL_WIDTH, D_MODEL, D_MODEL)
IN_WIDTH = ATTN_WIDTH + 2 * KV_WIDTH + IDX_HEADS * IDX_DIM + IDX_DIM + IDX_HEADS + POOL_WIDTH + 2 * D_MODEL

kernel_name = "hybrid_dsa_pool_moe_block"


def rms_norm(x, g):
    xf = x.astype(jnp.float32)
    y = xf * lax.rsqrt(jnp.mean(xf * xf, axis=-1, keepdims=True) + NORM_EPS)
    return (y * g.astype(jnp.float32)).astype(x.dtype)


def layer_norm(x, g, b):
    xf = x.astype(jnp.float32)
    mu = jnp.mean(xf, axis=-1, keepdims=True)
    var = jnp.mean(jnp.square(xf - mu), axis=-1, keepdims=True)
    y = (xf - mu) * lax.rsqrt(var + NORM_EPS)
    return (y * g.astype(jnp.float32) + b.astype(jnp.float32)).astype(x.dtype)


def rope(x, positions):
    d = x.shape[-1]
    inv_freq = ROPE_THETA ** (-jnp.arange(0, d, 2, dtype=jnp.float32) / d)
    ang = positions.astype(jnp.float32)[:, :, None, None] * inv_freq
    cos, sin = jnp.cos(ang), jnp.sin(ang)
    xf = x.astype(jnp.float32)
    x1, x2 = xf[..., : d // 2], xf[..., d // 2:]
    return jnp.concatenate([x1 * cos - x2 * sin, x2 * cos + x1 * sin], axis=-1).astype(x.dtype)


def dsa_attention(q, k, v, q_idx, k_idx, w_idx):
    b, s = q.shape[0], q.shape[1]
    n_sel = min(IDX_TOPK_MAX, s // 4)
    n_blocks = s // QUERY_BLOCK
    groups = ATTN_HEADS // ATTN_KV_HEADS
    key_pos = jnp.arange(s, dtype=jnp.int32)
    k_idx_f = k_idx.astype(jnp.float32)

    def to_blocks(a):
        return jnp.moveaxis(a.reshape((b, n_blocks, QUERY_BLOCK) + a.shape[2:]), 1, 0)

    q_b = to_blocks(q.reshape(b, s, ATTN_KV_HEADS, groups, HEAD_DIM))
    qi_b = to_blocks(q_idx)
    w_b = to_blocks(w_idx)
    starts = jnp.arange(n_blocks, dtype=jnp.int32) * QUERY_BLOCK

    def block_fn(args):
        qb, qib, wb, t0 = args
        t = t0 + jnp.arange(QUERY_BLOCK, dtype=jnp.int32)
        chunk_end = (t // CHUNK + 1) * CHUNK
        logits = jnp.einsum('bthd,bsd->bths', qib.astype(jnp.float32), k_idx_f)
        score = jnp.einsum('bths,bth->bts', jax.nn.relu(logits), wb.astype(jnp.float32)) * IDX_SCALE
        admissible = key_pos[None, :] < chunk_end[:, None]
        score = jnp.where(admissible[None], score, -jnp.inf)
        _, sel = lax.top_k(score, n_sel)
        valid = sel < chunk_end[None, :, None]
        k_sel = jax.vmap(lambda kk, ii: kk[ii])(k, sel)
        v_sel = jax.vmap(lambda vv, ii: vv[ii])(v, sel)
        att = jnp.einsum('btrgd,btnrd->btrgn', qb.astype(jnp.float32), k_sel.astype(jnp.float32)) * ATTN_SCALE
        att = jnp.where(valid[:, :, None, None, :], att, -jnp.inf)
        prob = jax.nn.softmax(att, axis=-1)
        return jnp.einsum('btrgn,btnrd->btrgd', prob.astype(v.dtype), v_sel)

    out = lax.map(block_fn, (q_b, qi_b, w_b, starts))
    return jnp.moveaxis(out, 0, 1).reshape(b, s, ATTN_WIDTH)


def multiscale_pool(p, pool_mix_w, pool_scale):
    b, s, _ = p.shape
    pf = p.astype(jnp.float32).reshape(b, s, POOL_GROUPS, POOL_GROUP_DIM)
    csum = jnp.concatenate([jnp.zeros_like(pf[:, :1]), jnp.cumsum(pf, axis=1)], axis=1)
    t = jnp.arange(s, dtype=jnp.int32)
    means = []
    for g, w in enumerate(POOL_WINDOWS):
        lo = jnp.maximum(t + 1 - w, 0)
        cnt = jnp.minimum(t + 1, w).astype(jnp.float32)
        means.append((csum[:, 1:, g] - csum[:, lo, g]) / cnt[None, :, None])
    mean = jnp.stack(means, axis=2)
    mixed = (mean - pf).astype(p.dtype)
    mixed = jnp.einsum('bsgc,gcd->bsgd', mixed, pool_mix_w)
    return mixed.reshape(b, s, POOL_WIDTH) * pool_scale


def moe_ffn(h, router_w, router_b, w_gate_up, b_gate_up, w_down, b_down):
    b, s, d = h.shape
    n_tok = b * s
    hf = h.reshape(n_tok, d)
    logits = (hf @ router_w + router_b).astype(jnp.float32)
    top_vals, top_idx = lax.top_k(logits, TOP_K)
    gates = jax.nn.softmax(top_vals, axis=-1)
    n_assign = n_tok * TOP_K
    expert_flat = top_idx.reshape(-1)
    token_flat = jnp.arange(n_assign, dtype=jnp.int32) // TOP_K
    gate_flat = gates.reshape(-1)
    order = jnp.argsort(expert_flat)
    e_sorted = expert_flat[order]
    counts = jnp.bincount(expert_flat, length=N_EXPERTS)
    group_start = jnp.cumsum(counts) - counts
    padded = (counts + EXPERT_BLOCK - 1) // EXPERT_BLOCK * EXPERT_BLOCK
    pad_end = jnp.cumsum(padded)
    pad_start = pad_end - padded
    dest = pad_start[e_sorted] + (jnp.arange(n_assign, dtype=jnp.int32) - group_start[e_sorted])
    n_blocks = -(-(n_assign + N_EXPERTS * (EXPERT_BLOCK - 1)) // EXPERT_BLOCK)
    n_rows = n_blocks * EXPERT_BLOCK
    slot_token = jnp.full((n_rows,), n_tok, jnp.int32).at[dest].set(token_flat[order])
    slot_gate = jnp.zeros((n_rows,), jnp.float32).at[dest].set(gate_flat[order])
    block_expert = jnp.minimum(
        jnp.searchsorted(pad_end, jnp.arange(n_blocks, dtype=jnp.int32) * EXPERT_BLOCK, side='right'),
        N_EXPERTS - 1)
    h_pad = jnp.concatenate([hf, jnp.zeros((1, d), hf.dtype)], axis=0)

    def run_block(args):
        tok, e = args
        xb = h_pad[tok]
        gu = xb @ w_gate_up[e] + b_gate_up[e]
        gate = jnp.minimum(gu[:, :EXPERT_DIM], SWIGLU_LIMIT)
        up = jnp.clip(gu[:, EXPERT_DIM:], -SWIGLU_LIMIT, SWIGLU_LIMIT)
        act = gate * jax.nn.sigmoid(SWIGLU_ALPHA * gate) * (up + 1.0)
        return act @ w_down[e] + b_down[e]

    out = lax.map(run_block, (slot_token.reshape(n_blocks, EXPERT_BLOCK), block_expert))
    out = out.reshape(n_rows, d) * slot_gate[:, None].astype(out.dtype)
    y = jax.ops.segment_sum(out, slot_token, num_segments=n_tok + 1)[:n_tok]
    return y.reshape(b, s, d)


def setup_inputs(seed: int = 0) -> dict:
    key = jax.random.key(seed)
    ks = jax.random.split(key, 24)
    L = DEPTH

    def normal(k, shape, scale):
        return jax.random.normal(k, shape, jnp.float32) * scale

    x = normal(ks[0], (BATCH, SEQ, D_MODEL), 1.0)
    offsets = jax.random.randint(ks[1], (BATCH, 1), 0, 16, dtype=jnp.int32) * CHUNK
    positions = jnp.arange(SEQ, dtype=jnp.int32)[None, :] + offsets
    return {
        "x": x,
        "positions": positions,
        "norm1_g": 1.0 + normal(ks[2], (L, D_MODEL), 0.05),
        "w_in": normal(ks[3], (L, D_MODEL, IN_WIDTH), D_MODEL ** -0.5),
        "q_norm_g": 1.0 + normal(ks[4], (L, HEAD_DIM), 0.05),
        "k_norm_g": 1.0 + normal(ks[5], (L, HEAD_DIM), 0.05),
        "idx_k_norm_g": 1.0 + normal(ks[6], (L, IDX_DIM), 0.05),
        "idx_k_norm_b": normal(ks[7], (L, IDX_DIM), 0.05),
        "w_branch_attn": normal(ks[8], (L, ATTN_WIDTH, D_MODEL), ATTN_WIDTH ** -0.5),
        "pool_mix_w": normal(ks[9], (L, POOL_GROUPS, POOL_GROUP_DIM, POOL_GROUP_DIM), POOL_GROUP_DIM ** -0.5),
        "pool_scale": 1.0 + normal(ks[10], (L, POOL_WIDTH), 0.05),
        "w_branch_pool": normal(ks[11], (L, POOL_WIDTH, D_MODEL), POOL_WIDTH ** -0.5),
        "w_out": normal(ks[12], (L, D_MODEL, D_MODEL), D_MODEL ** -0.5),
        "norm2_g": 1.0 + normal(ks[13], (L, D_MODEL), 0.05),
        "router_w": normal(ks[14], (L, D_MODEL, N_EXPERTS), D_MODEL ** -0.5),
        "router_b": normal(ks[15], (L, N_EXPERTS), 0.01),
        "w_gate_up": normal(ks[16], (L, N_EXPERTS, D_MODEL, 2 * EXPERT_DIM), D_MODEL ** -0.5),
        "b_gate_up": normal(ks[17], (L, N_EXPERTS, 2 * EXPERT_DIM), 0.02),
        "w_down": normal(ks[18], (L, N_EXPERTS, EXPERT_DIM, D_MODEL), EXPERT_DIM ** -0.5),
        "b_down": normal(ks[19], (L, N_EXPERTS, D_MODEL), 0.02),
    }


def reference(x, positions, norm1_g, w_in, q_norm_g, k_norm_g, idx_k_norm_g, idx_k_norm_b,
              w_branch_attn, pool_mix_w, pool_scale, w_branch_pool, w_out, norm2_g,
              router_w, router_b, w_gate_up, b_gate_up, w_down, b_down):
    b, s, _ = x.shape
    split_at = np.cumsum(IN_SPLITS)[:-1].tolist()
    for l in range(DEPTH):
        h = rms_norm(x, norm1_g[l])
        proj = h @ w_in[l]
        q, k, v, qi, ki, wi, pool_in, gate_a, gate_p = jnp.split(proj, split_at, axis=-1)
        q = rope(rms_norm(q.reshape(b, s, ATTN_HEADS, HEAD_DIM), q_norm_g[l]), positions)
        k = rope(rms_norm(k.reshape(b, s, ATTN_KV_HEADS, HEAD_DIM), k_norm_g[l]), positions)
        v = v.reshape(b, s, ATTN_KV_HEADS, HEAD_DIM)
        qi = qi.reshape(b, s, IDX_HEADS, IDX_DIM)
        qi = jnp.concatenate([rope(qi[..., :IDX_ROPE_DIM], positions), qi[..., IDX_ROPE_DIM:]], axis=-1)
        ki = layer_norm(ki, idx_k_norm_g[l], idx_k_norm_b[l])[:, :, None, :]
        ki = jnp.concatenate([rope(ki[..., :IDX_ROPE_DIM], positions), ki[..., IDX_ROPE_DIM:]], axis=-1)[:, :, 0]
        attn = dsa_attention(q, k, v, qi, ki, wi)
        pooled = multiscale_pool(pool_in, pool_mix_w[l], pool_scale[l])
        merged = (jax.nn.sigmoid(gate_a) * (attn @ w_branch_attn[l])
                  + jax.nn.sigmoid(gate_p) * (pooled @ w_branch_pool[l]))
        x = x + merged @ w_out[l]
        h2 = rms_norm(x, norm2_g[l])
        x = x + moe_ffn(h2, router_w[l], router_b[l], w_gate_up[l], b_gate_up[l], w_down[l], b_down[l])
    return x
```

```cpp
#include <hip/hip_runtime.h>
#include <hip/hip_cooperative_groups.h>
#include <cstdio>
#include <cstdint>
#include <cmath>
namespace cg = cooperative_groups;

#ifndef MK_MODE
#define MK_MODE 1
#endif

#define LAS __attribute__((address_space(3)))
typedef unsigned short bf16_t;
typedef short bf16x8 __attribute__((ext_vector_type(8)));
typedef float f32x2 __attribute__((ext_vector_type(2)));
typedef float f32x4 __attribute__((ext_vector_type(4)));
typedef float f32x16 __attribute__((ext_vector_type(16)));
typedef unsigned u32x2 __attribute__((ext_vector_type(2)));
typedef unsigned u32x4 __attribute__((ext_vector_type(4)));

constexpr int D = 1024, NBATCH = 8, SEQ = 4096, NTOK = NBATCH * SEQ;
constexpr int NEXP = 32, TOPK = 4;
constexpr int INW = 3652, INWP = 3840;
constexpr int NSLOT = 139264;
constexpr float NORM_EPS = 1e-6f;
constexpr int NWAVES = 8, NTHREADS = 512;
constexpr int LDS_BYTES = 147456;
constexpr int RING_BYTES = 131072;
constexpr int MISC_OFF = 135168;

constexpr size_t MiB = 1u << 20;
constexpr size_t WS_CTL = 0;
constexpr size_t WS_BCNT = 64 * 1024;
constexpr size_t WS_WCNT = 128 * 1024;
constexpr size_t WS_CS = 2 * MiB;
constexpr size_t WS_WIN = 16 * MiB;
constexpr size_t WS_WA = 24 * MiB;
constexpr size_t WS_WEFF = 25 * MiB;
constexpr size_t WS_WOUT = 26 * MiB;
constexpr size_t WS_WGU = 28 * MiB;
constexpr size_t WS_WD = 156 * MiB;
constexpr size_t WS_REC_E = 220 * MiB;
constexpr size_t WS_REC_POS = 221 * MiB;
constexpr size_t WS_REC_GATE = 222 * MiB;
constexpr size_t WS_SLOT_OF = 223 * MiB;
constexpr size_t WS_SLOT_GATE = 223 * MiB + 512 * 1024;
constexpr size_t WS_XN = 226 * MiB;
constexpr size_t WS_Q = 290 * MiB;
constexpr size_t WS_K = 322 * MiB;
constexpr size_t WS_V = 330 * MiB;
constexpr size_t WS_QI = 338 * MiB;
constexpr size_t WS_KI = 354 * MiB;
constexpr size_t WS_WI = 358 * MiB;
constexpr size_t WS_POOL = 360 * MiB;
constexpr size_t WS_GA = 392 * MiB;
constexpr size_t WS_GP = 456 * MiB;
constexpr size_t WS_ATTN = 520 * MiB;
constexpr size_t WS_MIXED = 552 * MiB;
constexpr size_t WS_TA = 584 * MiB;
constexpr size_t WS_MERGED = 648 * MiB;
constexpr size_t WS_H2 = WS_XN;
constexpr size_t WS_H2S = 290 * MiB;
constexpr size_t WS_Y = WS_H2S;
constexpr size_t WS_ACT = 562 * MiB;
constexpr size_t WS_END = 834 * MiB;
static_assert(WS_SLOT_GATE + (size_t)NSLOT * 4 <= WS_XN, "ws map");

__device__ __forceinline__ unsigned cvt_pk_bf16(float lo, float hi) { unsigned r; asm volatile("v_cvt_pk_bf16_f32 %0, %1, %2" : "=v"(r) : "v"(lo), "v"(hi)); return r; }
__device__ __forceinline__ float bf_lo(unsigned w) { return __uint_as_float(w << 16); }
__device__ __forceinline__ float bf_hi(unsigned w) { return __uint_as_float(w & 0xffff0000u); }
__device__ __forceinline__ float wave_sum(float v) {
#pragma unroll
    for (int o = 1; o < 64; o <<= 1) v += __shfl_xor(v, o);
    return v;
}
__device__ __forceinline__ float sigmoidf_(float x) { return 1.0f / (1.0f + __expf(-x)); }
#define LDS_WAIT() asm volatile("s_waitcnt lgkmcnt(0)" ::: "memory")

__host__ __device__ __forceinline__ int idx_bj_j(int d, int& bj) {
    int j;
    if (d < 16) { bj = 0; j = d; } else if (d < 32) { bj = 1; j = d - 16; } else if (d < 48) { bj = 0; j = d - 16; } else { bj = 1; j = d - 32; }
    return j;
}
__host__ __device__ __forceinline__ int win_phys(int n) {
    if (n < 512) { const int h = n >> 6, d = n & 63; return 256 * (h >> 2) + 128 * (d >> 5) + 32 * (h & 3) + (d & 31); }
    if (n < 768) { const int h = (n - 512) >> 6, d = n & 63; return 512 + 128 * (d >> 5) + 32 * h + (d & 31); }
    if (n < 1024) { const int h = (n - 768) >> 6, d = n & 63; int bj; const int j = idx_bj_j(d, bj); return 768 + 128 * bj + 32 * h + j; }
    if (n < 1088) { const int d = n - 1024; int bj; const int j = idx_bj_j(d, bj); return 1024 + 128 * bj + j; }
    if (n < 1092) return 1024 + 32 + (n - 1088);
    if (n < 1604) return 1280 + (n - 1092);
    if (n < 2628) return 1792 + (n - 1604);
    return 2816 + (n - 2628);
}

namespace pg8 {
constexpr int BM = 256, BK = 64, HALF = 128, HTB = HALF * BK * 2, STAGE_BYTES = 8 * HTB, NXCD = 8, WGM = 8;
__host__ __device__ __forceinline__ int lds_byte(int r, int c) { const int st = (r >> 4) * 2 + (c >> 5), rr = r & 15, cc = c & 31, ob = rr * 64 + cc * 2; return st * 1024 + (ob ^ (((ob >> 9) & 1) << 5)); }
__host__ __device__ __forceinline__ void stage_rc(int b, int& R, int& C) { const int st = b / 1024, sb = b % 1024, swz = sb ^ (((sb >> 9) & 1) << 5); R = (st >> 1) * 16 + swz / 64; C = (st & 1) * 32 + (swz % 64) / 2; }
__host__ __device__ __forceinline__ int perm32(int rho) { const int n = rho >> 4, i = rho & 15; return 8 * (i >> 2) + 4 * n + (i & 3); }

struct Unit { int pm, pn; };
struct Gemm { const bf16_t* A; const bf16_t* Bt; int M, N, K; };

struct StaticOrder {
    int nM, nN, nwg, G, c;
    __device__ void init(int M, int N, int G_, int c_) { nM = M / BM; nN = N / BM; nwg = nM * nN; G = G_; c = c_; }
    __device__ bool next(int i, Unit& u) const {
        const long L = (long)i * G + c; if (L >= nwg) return false;
        int wgid = (int)L; { const int q = nwg / NXCD, r = nwg % NXCD, xcd = wgid % NXCD, off = wgid / NXCD; wgid = (xcd < r ? xcd * (q + 1) : r * (q + 1) + (xcd - r) * q) + off; }
        const int nig = WGM * nN, gid = wgid / nig, fm = gid * WGM, gsz = (nM - fm) < WGM ? (nM - fm) : WGM;
        u.pm = fm + ((wgid % nig) % gsz); u.pn = (wgid % nig) / gsz; return true;
    }
};
template <int NPN> struct MoeOrder {
    const LAS int* tstart; int G, c;
    __device__ bool next(int i, Unit& u) const {
        const int L = i * G + c; const int ntile = tstart[NEXP];
        if (L >= ntile * NPN) return false;
        const int ti = L / NPN, pn = L % NPN; int e = 0;
#pragma unroll
        for (int k = 1; k < NEXP; ++k) e += (tstart[k] <= ti) ? 1 : 0;
        u.pm = ti; u.pn = e * NPN + pn; return true;
    }
};

template <class Epi, class Sched>
__device__ __forceinline__ void gemm_phase(LAS unsigned char* lds, const Gemm g, const Sched& S, const Epi& E) {
    const int tid = threadIdx.x, wid = __builtin_amdgcn_readfirstlane(tid >> 6), lane = tid & 63, wr = wid >> 2, wc = wid & 3, fr = lane & 15, fq = lane >> 4;
    const int K = g.K, nt = K / BK;
    unsigned voffA[2], voffB[2];
#pragma unroll
    for (int i = 0; i < 2; ++i) { int R, C; stage_rc(tid * 16 + i * 8192, R, C); const int Rb = (R & ~31) + perm32(R & 31);
        voffA[i] = (unsigned)(R * K + C) * 2u; voffB[i] = (unsigned)(Rb * K + C) * 2u; }
    const size_t kstep = (size_t)(BK * 2);
    const size_t hstep = (size_t)HALF * K * 2;
    const size_t tstep = 2 * hstep;
    const unsigned ldsw = (unsigned)wid * 1024u;
    const int aoff = lds_byte(wr * 64 + fr, fq * 8), boff = lds_byte(wc * 32 + fr, fq * 8);
#define PG8_SA(b, h) (((b) * 2 + (h)) * HTB)
#define PG8_SB(b, h) ((4 + (b) * 2 + (h)) * HTB)
#define PG8_STAGE(bufoff, gbase, voff) do { _Pragma("unroll") for (int _i = 0; _i < 2; ++_i) \
        __builtin_amdgcn_global_load_lds((const unsigned*)((const char*)(gbase) + (voff)[_i]), (LAS unsigned*)(lds + (bufoff) + ldsw + _i * 8192), 16, 0, 0); } while (0)
#define PG8_LDA(dst, b, h) do { _Pragma("unroll") for (int m = 0; m < 4; ++m) _Pragma("unroll") for (int k = 0; k < 2; ++k) dst[m][k] = *(const LAS bf16x8*)(lds + PG8_SA(b, h) + aoff + m * 2048 + k * 1024); } while (0)
#define PG8_LDB(dst, b, h) do { _Pragma("unroll") for (int n = 0; n < 2; ++n) _Pragma("unroll") for (int k = 0; k < 2; ++k) dst[n][k] = *(const LAS bf16x8*)(lds + PG8_SB(b, h) + boff + n * 2048 + k * 1024); } while (0)
#define PG8_MMA(ai, bj, At, Bt) do { __builtin_amdgcn_s_setprio(1); _Pragma("unroll") for (int m = 0; m < 4; ++m) _Pragma("unroll") for (int n = 0; n < 2; ++n) _Pragma("unroll") for (int k = 0; k < 2; ++k) \
        acc[ai][bj][m][n] = __builtin_amdgcn_mfma_f32_16x16x32_bf16(Bt[n][k], At[m][k], acc[ai][bj][m][n], 0, 0, 0); __builtin_amdgcn_s_setprio(0); } while (0)
#define PG8_WAIT_V(n) asm volatile("s_waitcnt vmcnt(" #n ")" ::: "memory")
#define PG8_WAIT_L(n) asm volatile("s_waitcnt lgkmcnt(" #n ")" ::: "memory")
#define PG8_BAR __builtin_amdgcn_s_barrier()
#define PG8_SCHED __builtin_amdgcn_sched_barrier(0)
    Unit cur, nxt; int ui = 0;
    if (!S.next(0, cur)) return;
    f32x4 acc[2][2][4][2];
#pragma unroll
    for (int a = 0; a < 2; ++a)
#pragma unroll
        for (int b = 0; b < 2; ++b)
#pragma unroll
            for (int m = 0; m < 4; ++m)
#pragma unroll
                for (int n = 0; n < 2; ++n) acc[a][b][m][n] = (f32x4){0.f, 0.f, 0.f, 0.f};
    bf16x8 At[4][2], B0[2][2], B1[2][2];
    const char* cA = (const char*)g.A + (size_t)cur.pm * tstep; const char* cB = (const char*)g.Bt + (size_t)cur.pn * tstep;
    PG8_STAGE(PG8_SB(0, 0), cB, voffB); PG8_STAGE(PG8_SB(0, 1), cB + hstep, voffB); PG8_STAGE(PG8_SA(0, 0), cA, voffA); PG8_STAGE(PG8_SA(0, 1), cA + hstep, voffA);
    if (wr == 1) PG8_BAR;
    PG8_WAIT_V(2); PG8_BAR;
    PG8_STAGE(PG8_SB(1, 0), cB + kstep, voffB); PG8_STAGE(PG8_SA(1, 0), cA + kstep, voffA); PG8_STAGE(PG8_SB(1, 1), cB + hstep + kstep, voffB);
    PG8_WAIT_V(6); PG8_BAR;
    for (;;) {
        const bool has_next = S.next(ui + 1, nxt);
        const char* nA = has_next ? (const char*)g.A + (size_t)nxt.pm * tstep : cA; const char* nB = has_next ? (const char*)g.Bt + (size_t)nxt.pn * tstep : cB;
        for (int t = 0; t < nt; t += 2) {
            const bool last = (t == nt - 2);
            const char* a1 = cA + (size_t)(t + 1) * kstep;
            const char* a2 = last ? nA : cA + (size_t)(t + 2) * kstep; const char* b2 = last ? nB : cB + (size_t)(t + 2) * kstep;
            const char* a3 = a2 + kstep; const char* b3 = b2 + kstep;
            PG8_LDB(B0, 0, 0); PG8_LDB(B1, 0, 1); PG8_SCHED; PG8_LDA(At, 0, 0); PG8_STAGE(PG8_SA(1, 1), a1 + hstep, voffA);
            PG8_WAIT_V(8); PG8_WAIT_L(0); PG8_BAR; PG8_MMA(0, 0, At, B0); PG8_MMA(0, 1, At, B1); PG8_BAR; PG8_SCHED;
            PG8_LDA(At, 0, 1); PG8_STAGE(PG8_SB(0, 0), b2, voffB); PG8_STAGE(PG8_SB(0, 1), b2 + hstep, voffB); PG8_STAGE(PG8_SA(0, 0), a2, voffA);
            PG8_WAIT_V(8); PG8_WAIT_L(0); PG8_BAR; PG8_MMA(1, 0, At, B0); PG8_MMA(1, 1, At, B1); PG8_BAR; PG8_SCHED;
            PG8_LDB(B0, 1, 0); PG8_LDB(B1, 1, 1); PG8_SCHED; PG8_LDA(At, 1, 0); PG8_STAGE(PG8_SA(0, 1), a2 + hstep, voffA);
            PG8_WAIT_V(8); PG8_WAIT_L(0); PG8_BAR; PG8_MMA(0, 0, At, B0); PG8_MMA(0, 1, At, B1); PG8_BAR; PG8_SCHED;
            PG8_LDA(At, 1, 1); PG8_STAGE(PG8_SB(1, 0), b3, voffB); PG8_STAGE(PG8_SB(1, 1), b3 + hstep, voffB); PG8_STAGE(PG8_SA(1, 0), a3, voffA);
            PG8_WAIT_V(8); PG8_WAIT_L(0); PG8_BAR; PG8_MMA(1, 0, At, B0); PG8_MMA(1, 1, At, B1); PG8_BAR; PG8_SCHED;
        }
        if (wr == 0) PG8_BAR;
        E(acc, cur, wr, wc, fr, fq);
        if (!has_next) break;
#pragma unroll
        for (int a = 0; a < 2; ++a)
#pragma unroll
            for (int b = 0; b < 2; ++b)
#pragma unroll
                for (int m = 0; m < 4; ++m)
#pragma unroll
                    for (int n = 0; n < 2; ++n) acc[a][b][m][n] = (f32x4){0.f, 0.f, 0.f, 0.f};
        cur = nxt; cA = nA; cB = nB; ++ui;
        if (wr == 1) PG8_BAR;
    }
    PG8_WAIT_V(0);
    PG8_BAR;
#undef PG8_SA
#undef PG8_SB
#undef PG8_STAGE
#undef PG8_LDA
#undef PG8_LDB
#undef PG8_MMA
#undef PG8_WAIT_V
#undef PG8_WAIT_L
#undef PG8_BAR
#undef PG8_SCHED
}
}

struct Params {
    const float* x; const int* pos; const float* norm1_g; const float* w_in; const float* q_norm_g; const float* k_norm_g;
    const float* idx_g; const float* idx_b; const float* w_a; const float* pool_mix; const float* pool_scale; const float* w_b;
    const float* w_out; const float* norm2_g; const float* router_w; const float* router_b; const float* w_gu; const float* b_gu;
    const float* w_d; const float* b_d;
    float* out; unsigned char* ws; int ph_lo, ph_hi;
};

using pg8::Unit; using pg8::HALF;
__device__ __forceinline__ void st8(bf16_t* p, const float (&v)[8]) {
    u32x4 w; w.x = cvt_pk_bf16(v[0], v[1]); w.y = cvt_pk_bf16(v[2], v[3]); w.z = cvt_pk_bf16(v[4], v[5]); w.w = cvt_pk_bf16(v[6], v[7]); *(u32x4*)p = w;
}
__device__ __forceinline__ void ld8f(const float* p, float (&v)[8]) { const f32x4 a = *(const f32x4*)p, b = *(const f32x4*)(p + 4); v[0]=a[0]; v[1]=a[1]; v[2]=a[2]; v[3]=a[3]; v[4]=b[0]; v[5]=b[1]; v[6]=b[2]; v[7]=b[3]; }
__device__ __forceinline__ void ld8bf(const bf16_t* p, float (&v)[8]) { const u32x4 w = *(const u32x4*)p; v[0]=bf_lo(w.x); v[1]=bf_hi(w.x); v[2]=bf_lo(w.y); v[3]=bf_hi(w.y); v[4]=bf_lo(w.z); v[5]=bf_hi(w.z); v[6]=bf_lo(w.w); v[7]=bf_hi(w.w); }

struct EpiInProj {
    bf16_t *Q, *Kb, *Vb, *Qi, *Ki, *Pool, *Ga, *Gp; float* Wi; const float* cs; const float *gq, *gk, *lng, *lnb;
    __device__ __forceinline__ void operator()(const f32x4 (&acc)[2][2][4][2], const Unit& u, int wr, int wc, int fr, int fq) const {
        const int pn = u.pn;
#pragma unroll
        for (int ai = 0; ai < 2; ++ai)
#pragma unroll
            for (int m = 0; m < 4; ++m) {
                const int row = u.pm * 256 + ai * HALF + wr * 64 + m * 16 + fr;
                float v0[8], v1[8];
#pragma unroll
                for (int n = 0; n < 2; ++n)
#pragma unroll
                    for (int i = 0; i < 4; ++i) { v0[4 * n + i] = acc[ai][0][m][n][i]; v1[4 * n + i] = acc[ai][1][m][n][i]; }
                if (pn <= 1 || (pn == 2 && wc < 2)) {
                    float ss = 0.f;
#pragma unroll
                    for (int j = 0; j < 8; ++j) ss += v0[j] * v0[j] + v1[j] * v1[j];
                    ss += __shfl_xor(ss, 16); ss += __shfl_xor(ss, 32);
                    const float rs = 1.0f / sqrtf(ss * (1.0f / 64.0f) + NORM_EPS);
                    const float* gg = (pn <= 1) ? gq : gk; const float sc = (pn <= 1) ? 0.125f : 1.0f;
                    float g0[8], g1[8], cc[8], sn[8];
                    ld8f(gg + 8 * fq, g0); ld8f(gg + 32 + 8 * fq, g1);
                    ld8f(cs + (size_t)row * 96 + 8 * fq, cc); ld8f(cs + (size_t)row * 96 + 48 + 8 * fq, sn);
                    float o0[8], o1[8];
#pragma unroll
                    for (int j = 0; j < 8; ++j) { const float x1 = v0[j] * rs * g0[j], x2 = v1[j] * rs * g1[j]; o0[j] = (x1 * cc[j] - x2 * sn[j]) * sc; o1[j] = (x2 * cc[j] + x1 * sn[j]) * sc; }
                    bf16_t* dst = (pn <= 1) ? Q + (size_t)row * 512 + (4 * pn + wc) * 64 : Kb + (size_t)row * 128 + wc * 64;
                    st8(dst + 8 * fq, o0); st8(dst + 32 + 8 * fq, o1);
                } else if (pn == 2) {
                    bf16_t* dst = Vb + (size_t)row * 128 + (wc - 2) * 64;
                    st8(dst + 8 * fq, v0); st8(dst + 32 + 8 * fq, v1);
                } else if (pn == 3 || (pn == 4 && wc == 0)) {
                    if (pn == 4) {
                        float s = 0.f;
#pragma unroll
                        for (int j = 0; j < 8; ++j) s += v0[j] + v1[j];
                        s += __shfl_xor(s, 16); s += __shfl_xor(s, 32);
                        const float mu = s * (1.0f / 64.0f); float q = 0.f;
#pragma unroll
                        for (int j = 0; j < 8; ++j) { v0[j] -= mu; v1[j] -= mu; q += v0[j] * v0[j] + v1[j] * v1[j]; }
                        q += __shfl_xor(q, 16); q += __shfl_xor(q, 32);
                        const float rs = 1.0f / sqrtf(q * (1.0f / 64.0f) + NORM_EPS);
                        const int d0 = (fq < 2) ? 8 * fq : 8 * fq + 16, d1 = (fq < 2) ? 16 + 8 * fq : 8 * fq + 32;
                        float a0[8], a1[8], b0[8], b1[8];
                        ld8f(lng + d0, a0); ld8f(lng + d1, a1); ld8f(lnb + d0, b0); ld8f(lnb + d1, b1);
#pragma unroll
                        for (int j = 0; j < 8; ++j) { v0[j] = v0[j] * rs * a0[j] + b0[j]; v1[j] = v1[j] * rs * a1[j] + b1[j]; }
                    }
                    bf16_t* dst = (pn == 3) ? Qi + (size_t)row * 256 + wc * 64 : Ki + (size_t)row * 64;
                    if (fq < 2) {
                        float cc[8], sn[8];
                        ld8f(cs + (size_t)row * 96 + 32 + 8 * fq, cc); ld8f(cs + (size_t)row * 96 + 48 + 32 + 8 * fq, sn);
                        float o0[8], o1[8];
#pragma unroll
                        for (int j = 0; j < 8; ++j) { o0[j] = v0[j] * cc[j] - v1[j] * sn[j]; o1[j] = v1[j] * cc[j] + v0[j] * sn[j]; }
                        st8(dst + 8 * fq, o0); st8(dst + 16 + 8 * fq, o1);
                    } else { st8(dst + 8 * fq + 16, v0); st8(dst + 8 * fq + 32, v1); }
                } else if (pn == 4) {
                    if (wc == 1 && fq == 0) *(f32x4*)(Wi + (size_t)row * 4) = (f32x4){v0[0] * 0.0625f, v0[1] * 0.0625f, v0[2] * 0.0625f, v0[3] * 0.0625f};
                } else if (pn <= 6) {
                    bf16_t* dst = Pool + (size_t)row * 512 + (pn - 5) * 256 + wc * 32 + 8 * fq;
                    st8(dst, v0); st8(dst + HALF, v1);
                } else {
                    bf16_t* dst = ((pn <= 10) ? Ga + (size_t)row * 1024 + (pn - 7) * 256 : Gp + (size_t)row * 1024 + (pn - 11) * 256) + wc * 32 + 8 * fq;
#pragma unroll
                    for (int j = 0; j < 8; ++j) { v0[j] = sigmoidf_(v0[j]); v1[j] = sigmoidf_(v1[j]); }
                    st8(dst, v0); st8(dst + HALF, v1);
                }
            }
    }
};

struct EpiGateMul {
    const bf16_t* G; const bf16_t* T; bf16_t* O;
    __device__ __forceinline__ void operator()(const f32x4 (&acc)[2][2][4][2], const Unit& u, int wr, int wc, int fr, int fq) const {
#pragma unroll
        for (int ai = 0; ai < 2; ++ai)
#pragma unroll
            for (int m = 0; m < 4; ++m) {
                const size_t off = (size_t)(u.pm * 256 + ai * HALF + wr * 64 + m * 16 + fr) * 1024 + u.pn * 256 + wc * 32 + 8 * fq;
#pragma unroll
                for (int bj = 0; bj < 2; ++bj) {
                    float g[8], o[8]; ld8bf(G + off + bj * HALF, g);
#pragma unroll
                    for (int n = 0; n < 2; ++n)
#pragma unroll
                        for (int i = 0; i < 4; ++i) o[4 * n + i] = g[4 * n + i] * acc[ai][bj][m][n][i];
                    if (T) { float t[8]; ld8bf(T + off + bj * HALF, t);
#pragma unroll
                        for (int j = 0; j < 8; ++j) o[j] += t[j]; }
                    st8(O + off + bj * HALF, o);
                }
            }
    }
};
struct EpiResid {
    const float* X; float* O;
    __device__ __forceinline__ void operator()(const f32x4 (&acc)[2][2][4][2], const Unit& u, int wr, int wc, int fr, int fq) const {
#pragma unroll
        for (int ai = 0; ai < 2; ++ai)
#pragma unroll
            for (int m = 0; m < 4; ++m) {
                const size_t off = (size_t)(u.pm * 256 + ai * HALF + wr * 64 + m * 16 + fr) * 1024 + u.pn * 256 + wc * 32 + 8 * fq;
#pragma unroll
                for (int bj = 0; bj < 2; ++bj)
#pragma unroll
                    for (int n = 0; n < 2; ++n) { const size_t o = off + bj * HALF + 4 * n; *(f32x4*)(O + o) = *(const f32x4*)(X + o) + acc[ai][bj][m][n]; }
            }
    }
};
struct EpiGateUp {
    const float* bias; bf16_t* Act;
    __device__ __forceinline__ void operator()(const f32x4 (&acc)[2][2][4][2], const Unit& u, int wr, int wc, int fr, int fq) const {
        const int e = u.pn >> 3, pnl = u.pn & 7, col = pnl * 128 + wc * 32 + 8 * fq;
        float bg[8], bu[8]; ld8f(bias + (size_t)e * 2048 + col, bg); ld8f(bias + (size_t)e * 2048 + 1024 + col, bu);
#pragma unroll
        for (int ai = 0; ai < 2; ++ai)
#pragma unroll
            for (int m = 0; m < 4; ++m) {
                const size_t row = (size_t)(u.pm * 256 + ai * HALF + wr * 64 + m * 16 + fr);
                float o[8];
#pragma unroll
                for (int n = 0; n < 2; ++n)
#pragma unroll
                    for (int i = 0; i < 4; ++i) { const int j = 4 * n + i;
                        const float gt = fminf(acc[ai][0][m][n][i] + bg[j], 7.0f), up = fminf(fmaxf(acc[ai][1][m][n][i] + bu[j], -7.0f), 7.0f);
                        o[j] = gt * sigmoidf_(1.702f * gt) * (up + 1.0f); }
                st8(Act + row * 1024 + col, o);
            }
    }
};
struct EpiDown {
    const float* bias; const float* sgate; bf16_t* Y;
    __device__ __forceinline__ void operator()(const f32x4 (&acc)[2][2][4][2], const Unit& u, int wr, int wc, int fr, int fq) const {
        const int e = u.pn >> 2, pnl = u.pn & 3, col = pnl * 256 + wc * 32 + 8 * fq;
        float b0[8], b1[8]; ld8f(bias + (size_t)e * 1024 + col, b0); ld8f(bias + (size_t)e * 1024 + col + HALF, b1);
#pragma unroll
        for (int ai = 0; ai < 2; ++ai)
#pragma unroll
            for (int m = 0; m < 4; ++m) {
                const size_t row = (size_t)(u.pm * 256 + ai * HALF + wr * 64 + m * 16 + fr);
                const float gt = sgate[row];
                float o0[8], o1[8];
#pragma unroll
                for (int n = 0; n < 2; ++n)
#pragma unroll
                    for (int i = 0; i < 4; ++i) { const int j = 4 * n + i; o0[j] = (acc[ai][0][m][n][i] + b0[j]) * gt; o1[j] = (acc[ai][1][m][n][i] + b1[j]) * gt; }
                st8(Y + row * 1024 + col, o0); st8(Y + row * 1024 + col + HALF, o1);
            }
    }
};

template <class RowMap>
__device__ __forceinline__ void cvt_item(const float* W, int K, int N, bf16_t* WT, LAS float* scr, int kb, int nb, int lane, const RowMap& rm) {
    const int k0 = kb * 64, n0 = nb * 64, n4 = lane & 15, kr = lane >> 4, n = n0 + 4 * n4;
    f32x4 v[16];
#pragma unroll
    for (int i = 0; i < 16; ++i) v[i] = (n < N) ? *(const f32x4*)(W + (size_t)(k0 + 4 * i + kr) * N + n) : (f32x4){0.f, 0.f, 0.f, 0.f};
#pragma unroll
    for (int i = 0; i < 16; ++i) { LAS float* d = scr + (4 * i + kr) * 65 + 4 * n4; d[0] = v[i][0]; d[1] = v[i][1]; d[2] = v[i][2]; d[3] = v[i][3]; }
    LDS_WAIT(); asm volatile("" ::: "memory");
    const int c8 = lane & 7;
#pragma unroll
    for (int jj = 0; jj < 8; ++jj) { const int nn = (lane >> 3) + 8 * jj; const LAS float* s = scr + (8 * c8) * 65 + nn;
        if (n0 + nn < N) { u32x4 o; o.x = cvt_pk_bf16(s[0], s[65]); o.y = cvt_pk_bf16(s[2 * 65], s[3 * 65]); o.z = cvt_pk_bf16(s[4 * 65], s[5 * 65]); o.w = cvt_pk_bf16(s[6 * 65], s[7 * 65]);
            *(u32x4*)(WT + (size_t)rm(n0 + nn) * K + k0 + 8 * c8) = o; } }
    LDS_WAIT(); asm volatile("" ::: "memory");
}
struct RmIdent { int off; __device__ __forceinline__ int operator()(int n) const { return off + n; } };
struct RmWin { __device__ __forceinline__ int operator()(int n) const { return win_phys(n); } };
struct RmGu { int e; __device__ __forceinline__ int operator()(int n) const { return e * 2048 + 256 * ((n & 1023) >> 7) + 128 * (n >> 10) + (n & 127); } };

__device__ __forceinline__ void phase0(const Params& p, LAS unsigned char* lds, int bid, int G) {
    const int tid = threadIdx.x, lane = tid & 63, wave = __builtin_amdgcn_readfirstlane(tid >> 6);
    const int gw = bid * NWAVES + wave, NGW = G * NWAVES;
    unsigned char* ws = p.ws;
    LAS float* scr = (LAS float*)(lds + wave * 16640);
    constexpr int I_GU = NEXP * 16 * 32, I_D = NEXP * 16 * 16, I_IN = 16 * 58, I_A = 8 * 16, I_O = 16 * 16;
    constexpr int NITEMS = I_GU + I_D + I_IN + I_A + I_O;
    for (int it = gw; it < NITEMS; it += NGW) {
        int r = it;
        if (r < I_GU) { const int e = r / 512, q = r % 512; cvt_item(p.w_gu + (size_t)e * 1024 * 2048, 1024, 2048, (bf16_t*)(ws + WS_WGU), scr, q / 32, q % 32, lane, RmGu{e}); continue; } r -= I_GU;
        if (r < I_D) { const int e = r / 256, q = r % 256; cvt_item(p.w_d + (size_t)e * 1024 * 1024, 1024, 1024, (bf16_t*)(ws + WS_WD), scr, q / 16, q % 16, lane, RmIdent{e * 1024}); continue; } r -= I_D;
        if (r < I_IN) { cvt_item(p.w_in, 1024, INW, (bf16_t*)(ws + WS_WIN), scr, r / 58, r % 58, lane, RmWin{}); continue; } r -= I_IN;
        if (r < I_A) { cvt_item(p.w_a, 512, 1024, (bf16_t*)(ws + WS_WA), scr, r / 16, r % 16, lane, RmIdent{0}); continue; } r -= I_A;
        cvt_item(p.w_out, 1024, 1024, (bf16_t*)(ws + WS_WOUT), scr, r / 16, r % 16, lane, RmIdent{0});
    }
    for (int it = gw; it < 16 * 4 * 16; it += NGW) {
        const int nb = it & 15, g = (it >> 4) & 3, cb = it >> 6, n = nb * 64 + lane, c0 = cb * 8;
        float a[8];
#pragma unroll
        for (int q = 0; q < 8; ++q) a[q] = 0.f;
        const float* mix = p.pool_mix + (size_t)g * 128 * 128 + (size_t)c0 * 128;
        for (int d = 0; d < 128; ++d) {
            const float wb = p.pool_scale[g * 128 + d] * p.w_b[(size_t)(g * 128 + d) * 1024 + n];
#pragma unroll
            for (int q = 0; q < 8; ++q) a[q] += mix[q * 128 + d] * wb;
        }
        st8((bf16_t*)(ws + WS_WEFF) + (size_t)n * 512 + g * 128 + c0, a);
    }
    {
        f32x4 gv[4];
#pragma unroll
        for (int j = 0; j < 4; ++j) gv[j] = *(const f32x4*)(p.norm1_g + 4 * lane + 256 * j);
        bf16_t* XN = (bf16_t*)(ws + WS_XN);
        for (int m = gw; m < NTOK; m += NGW) {
            const f32x4* xr = (const f32x4*)(p.x + (size_t)m * D) + lane;
            f32x4 v[4]; float s = 0.f;
#pragma unroll
            for (int j = 0; j < 4; ++j) { v[j] = xr[64 * j]; s += (v[j].x * v[j].x + v[j].y * v[j].y) + (v[j].z * v[j].z + v[j].w * v[j].w); }
            const float rs = 1.0f / sqrtf(wave_sum(s) * (1.0f / D) + NORM_EPS);
#pragma unroll
            for (int j = 0; j < 4; ++j) { const f32x4 o = v[j] * rs * gv[j]; u32x2 w; w.x = cvt_pk_bf16(o.x, o.y); w.y = cvt_pk_bf16(o.z, o.w); *(u32x2*)(XN + (size_t)m * D + 4 * lane + 256 * j) = w; }
        }
    }
    {
        float* cs = (float*)(ws + WS_CS);
        for (int i = bid * NTHREADS + tid; i < NTOK * 48; i += G * NTHREADS) {
            const int row = i / 48, j = i % 48;
            const float ex = (j < 32) ? -(float)j / 32.0f : -(float)(j - 32) / 16.0f;
            const float ang = (float)p.pos[row] * powf(10000.0f, ex);
            float sn, cc; sincosf(ang, &sn, &cc);
            cs[(size_t)row * 96 + j] = cc; cs[(size_t)row * 96 + 48 + j] = sn;
        }
    }
}

__device__ __forceinline__ void pool_phase(const Params& p, int bid, int G) {
    const int tid = threadIdx.x, lane = tid & 63, wave = __builtin_amdgcn_readfirstlane(tid >> 6);
    const int gw = bid * NWAVES + wave, NGW = G * NWAVES;
    const bf16_t* Pool = (const bf16_t*)(p.ws + WS_POOL); bf16_t* Mixed = (bf16_t*)(p.ws + WS_MIXED);
    const int w = 2 << (lane >> 4);
    for (int it = gw; it < NBATCH * 256; it += NGW) {
        const int b = it >> 8, tb = (it & 255) * 16;
        const bf16_t* P = Pool + (size_t)b * SEQ * 512 + 8 * lane;
        float sum[8];
#pragma unroll
        for (int q = 0; q < 8; ++q) sum[q] = 0.f;
        for (int d = 1; d < 16; ++d) if (d < w && tb - d >= 0) { float v[8]; ld8bf(P + (size_t)(tb - d) * 512, v);
#pragma unroll
            for (int q = 0; q < 8; ++q) sum[q] += v[q]; }
        for (int t = tb; t < tb + 16; ++t) {
            float cur[8]; ld8bf(P + (size_t)t * 512, cur);
#pragma unroll
            for (int q = 0; q < 8; ++q) sum[q] += cur[q];
            const float inv = 1.0f / (float)((t + 1 < w) ? t + 1 : w);
            float o[8];
#pragma unroll
            for (int q = 0; q < 8; ++q) o[q] = sum[q] * inv - cur[q];
            st8(Mixed + ((size_t)b * SEQ + t) * 512 + 8 * lane, o);
            if (t - w + 1 >= 0) { float old[8]; ld8bf(P + (size_t)(t - w + 1) * 512, old);
#pragma unroll
                for (int q = 0; q < 8; ++q) sum[q] -= old[q]; }
        }
    }
}

__device__ __forceinline__ int count_ge(const unsigned (&key)[64], int nj, unsigned mid) {
    int cnt = 0;
#pragma unroll
    for (int jb = 0; jb < 8; ++jb) if (jb * 8 < nj) {
#pragma unroll
        for (int q = 0; q < 8; ++q) cnt += __popcll(__ballot(key[jb * 8 + q] >= mid)); }
    return cnt;
}
__device__ __forceinline__ int lane_prefix(unsigned long long m) { return __builtin_amdgcn_mbcnt_hi((unsigned)(m >> 32), __builtin_amdgcn_mbcnt_lo((unsigned)m, 0u)); }

__device__ __forceinline__ void attn_unit(const Params& p, LAS unsigned char* lds, int b, int t0) {
    const int tid = threadIdx.x, lane = tid & 63, wave = __builtin_amdgcn_readfirstlane(tid >> 6);
    const bf16_t* Qb = (const bf16_t*)(p.ws + WS_Q); const bf16_t* Kb = (const bf16_t*)(p.ws + WS_K); const bf16_t* Vb = (const bf16_t*)(p.ws + WS_V);
    const bf16_t* Qi = (const bf16_t*)(p.ws + WS_QI); const bf16_t* Ki = (const bf16_t*)(p.ws + WS_KI); const float* Wi = (const float*)(p.ws + WS_WI);
    bf16_t* Attn = (bf16_t*)(p.ws + WS_ATTN);
    LAS float* SC = (LAS float*)lds;
    const int c = t0 >> 6, nj = c + 1, nk = 64 * nj, ntile = nk >> 5;
    const size_t tok0 = (size_t)b * SEQ + t0;
    {
        const int r = lane & 31, hh = lane >> 5;
        bf16x8 qa[4];
        const bf16_t* qp = Qi + (tok0 + (r >> 2)) * 256 + (r & 3) * 64 + 8 * hh;
#pragma unroll
        for (int ks = 0; ks < 4; ++ks) qa[ks] = *(const bf16x8*)(qp + 16 * ks);
        f32x4 wv[4];
#pragma unroll
        for (int g = 0; g < 4; ++g) wv[g] = *(const f32x4*)(Wi + (tok0 + 2 * g + hh) * 4);
        for (int kt = wave; kt < ntile; kt += NWAVES) {
            const bf16_t* kp = Ki + ((size_t)b * SEQ + kt * 32 + r) * 64 + 8 * hh;
            bf16x8 kb[4];
#pragma unroll
            for (int ks = 0; ks < 4; ++ks) kb[ks] = *(const bf16x8*)(kp + 16 * ks);
            f32x16 acc;
#pragma unroll
            for (int q = 0; q < 16; ++q) acc[q] = 0.f;
#pragma unroll
            for (int ks = 0; ks < 4; ++ks) acc = __builtin_amdgcn_mfma_f32_32x32x16_bf16(qa[ks], kb[ks], acc, 0, 0, 0);
#pragma unroll
            for (int g = 0; g < 4; ++g) {
                float s = fmaf(wv[g][0], fmaxf(acc[4 * g], 0.f), 0.0f);
                s = fmaf(wv[g][1], fmaxf(acc[4 * g + 1], 0.f), s); s = fmaf(wv[g][2], fmaxf(acc[4 * g + 2], 0.f), s); s = fmaf(wv[g][3], fmaxf(acc[4 * g + 3], 0.f), s);
                SC[(2 * g + hh) * 4096 + kt * 32 + r] = s;
            }
        }
    }
    __syncthreads();
    LAS float* row = SC + wave * 4096;
    unsigned key[64];
#pragma unroll
    for (int jb = 0; jb < 8; ++jb) {
#pragma unroll
        for (int q = 0; q < 8; ++q) key[jb * 8 + q] = 0u;
        if (jb * 8 < nj) {
#pragma unroll
            for (int q = 0; q < 8; ++q) { const int j = jb * 8 + q; const unsigned u = __float_as_uint(row[j * 64 + lane]); const unsigned kk = (u & 0x80000000u) ? ~u : (u | 0x80000000u); key[j] = (j < nj) ? kk : 0u; }
        }
    }
    unsigned hiSel = 1u, T = 0u; int rrem = 0;
    if (nk > 256) {
        unsigned km = 0u;
#pragma unroll
        for (int j = 0; j < 64; ++j) km = key[j] > km ? key[j] : km;
#pragma unroll
        for (int o = 1; o < 64; o <<= 1) { const unsigned t = (unsigned)__shfl_xor((int)km, o); km = t > km ? t : km; }
        unsigned lo = 0u, hi = km + 1u; int cnt_hi = 0; bool exact = false;
        while (hi - lo > 1u) {
            const unsigned mid = lo + ((hi - lo) >> 1);
            const int cnt = count_ge(key, nj, mid);
            if (cnt >= 256) { lo = mid; if (cnt == 256) { exact = true; break; } } else { hi = mid; cnt_hi = cnt; }
        }
        if (exact) { hiSel = lo; T = 0u; rrem = 0; } else { hiSel = hi; T = lo; rrem = 256 - cnt_hi; }
    }
    LDS_WAIT();
    LAS int* list = (LAS int*)row;
    int nsel = 0;
#pragma unroll
    for (int j = 0; j < 64; ++j) if ((j & ~7) < nj) {
        const bool eq = (key[j] == T) && (key[j] < hiSel);
        const unsigned long long eqm = __ballot(eq);
        const bool take = eq && (lane_prefix(eqm) < rrem);
        const int ne = __popcll(eqm); rrem = (ne < rrem) ? rrem - ne : 0;
        const bool sel = (key[j] >= hiSel) || take;
        const unsigned long long sm = __ballot(sel);
        if (sel) list[nsel + lane_prefix(sm)] = j * 64 + lane;
        nsel += __popcll(sm);
    }
    LDS_WAIT();
    const size_t tok = tok0 + wave;
    LAS float* Pm = row + 256;
    {
        const int cq = lane & 15, kq = lane >> 4;
        bf16x8 qb[4];
#pragma unroll
        for (int ks = 0; ks < 4; ++ks) { qb[ks] = (bf16x8){0, 0, 0, 0, 0, 0, 0, 0};
            if (cq < 8 && (ks >> 1) == (cq >> 2)) qb[ks] = *(const bf16x8*)(Qb + tok * 512 + cq * 64 + 32 * (ks & 1) + 8 * kq); }
        f32x4 sacc[16];
#pragma unroll
        for (int tg = 0; tg < 4; ++tg) {
            if (tg * 64 < nsel) {
#pragma unroll
                for (int tq = 0; tq < 4; ++tq) { const int tile = tg * 4 + tq;
                    const int ky = list[tile * 16 + cq];
                    const bf16_t* kp = Kb + ((size_t)b * SEQ + ky) * 128 + 8 * kq;
                    f32x4 a = (f32x4){0.f, 0.f, 0.f, 0.f};
#pragma unroll
                    for (int ks = 0; ks < 4; ++ks) a = __builtin_amdgcn_mfma_f32_16x16x32_bf16(*(const bf16x8*)(kp + 32 * ks), qb[ks], a, 0, 0, 0);
                    sacc[tile] = a; }
            } else {
#pragma unroll
                for (int tq = 0; tq < 4; ++tq) sacc[tg * 4 + tq] = (f32x4){-INFINITY, -INFINITY, -INFINITY, -INFINITY};
            }
        }
        float mx = -INFINITY;
#pragma unroll
        for (int t = 0; t < 16; ++t) mx = fmaxf(fmaxf(fmaxf(mx, sacc[t][0]), fmaxf(sacc[t][1], sacc[t][2])), sacc[t][3]);
        mx = fmaxf(mx, __shfl_xor(mx, 16)); mx = fmaxf(mx, __shfl_xor(mx, 32));
        float sm = 0.f;
#pragma unroll
        for (int t = 0; t < 16; ++t)
#pragma unroll
            for (int i = 0; i < 4; ++i) { const float e = __expf(sacc[t][i] - mx); sacc[t][i] = e; sm += e; }
        sm += __shfl_xor(sm, 16); sm += __shfl_xor(sm, 32);
        const float inv = 1.0f / sm;
        if (cq < 8) {
#pragma unroll
            for (int t = 0; t < 16; ++t) if (t * 16 < nsel) {
#pragma unroll
                for (int i = 0; i < 4; ++i) Pm[(t * 16 + 4 * kq + i) * 8 + cq] = sacc[t][i] * inv; }
        }
    }
    LDS_WAIT();
    {
        const int par = lane >> 5, l5 = lane & 31, kvh = l5 >> 4;
        float o[4][4];
#pragma unroll
        for (int h = 0; h < 4; ++h)
#pragma unroll
            for (int d = 0; d < 4; ++d) o[h][d] = 0.f;
        const bf16_t* vbase = Vb + (size_t)b * SEQ * 128 + 4 * l5;
        for (int sp = 0; sp < nsel / 2; sp += 4) {
            u32x2 vv[4]; f32x4 pp[4];
#pragma unroll
            for (int q = 0; q < 4; ++q) { const int slot = 2 * (sp + q) + par; const int ky = list[slot];
                vv[q] = *(const u32x2*)(vbase + (size_t)ky * 128); pp[q] = *(const LAS f32x4*)(Pm + slot * 8 + 4 * kvh); }
#pragma unroll
            for (int q = 0; q < 4; ++q) { const float v0 = bf_lo(vv[q].x), v1 = bf_hi(vv[q].x), v2 = bf_lo(vv[q].y), v3 = bf_hi(vv[q].y);
#pragma unroll
                for (int h = 0; h < 4; ++h) { o[h][0] += pp[q][h] * v0; o[h][1] += pp[q][h] * v1; o[h][2] += pp[q][h] * v2; o[h][3] += pp[q][h] * v3; } }
        }
#pragma unroll
        for (int hh = 0; hh < 2; ++hh) {
            float tot[4];
#pragma unroll
            for (int d = 0; d < 4; ++d) { float x = o[hh][d], y = o[2 + hh][d]; asm volatile("" : "+v"(x), "+v"(y));
                const float keep = par ? y : x, send = par ? x : y; tot[d] = keep + __shfl_xor(send, 32); }
            const float a0 = tot[0], a1 = tot[1], a2 = tot[2], a3 = tot[3];
            u32x2 w; w.x = cvt_pk_bf16(a0, a1); w.y = cvt_pk_bf16(a2, a3);
            *(u32x2*)(Attn + tok * 512 + (4 * kvh + 2 * par + hh) * 64 + 4 * (l5 & 15)) = w;
        }
    }
    __syncthreads();
}

__device__ __forceinline__ void attn_phase(const Params& p, LAS unsigned char* lds, int bid, int G) {
    for (int i = 0;; ++i) {
        int b, r;
        if (G == 256) { if (i >= 16) break; b = bid & 7; const int y = bid >> 3; r = i * 32 + ((i & 1) ? 31 - y : y); }
        else { const int u = bid + i * G; if (u >= NBATCH * 512) break; b = u & 7; r = u >> 3; }
        const int c = 63 - (r >> 3), sx = r & 7;
        attn_unit(p, lds, b, 64 * c + 8 * sx);
    }
}

constexpr int T_TSTART = 0, T_PADSTART = 40, T_BLOCKBASE = 80, T_NE = 112, T_WB = 144  , T_PART = 400  ;
__device__ __forceinline__ void router_phase(const Params& p, LAS unsigned char* lds, int bid, int G) {
    const int tid = threadIdx.x, lane = tid & 63, wave = __builtin_amdgcn_readfirstlane(tid >> 6);
    constexpr int WP = 1028;
    LAS float* WrT = (LAS float*)lds;
    for (int i = tid; i < 1024 * 32 / 4; i += NTHREADS) { const f32x4 v = *(const f32x4*)(p.router_w + 4 * (size_t)i); const int c = i >> 3, e0 = 4 * (i & 7); const float g = p.norm2_g[c];
        WrT[(e0 + 0) * WP + c] = v[0] * g; WrT[(e0 + 1) * WP + c] = v[1] * g; WrT[(e0 + 2) * WP + c] = v[2] * g; WrT[(e0 + 3) * WP + c] = v[3] * g; }
    __syncthreads();
    LAS int* tbl = (LAS int*)(lds + MISC_OFF);
    const float* X1 = p.out; bf16_t* H2 = (bf16_t*)(p.ws + WS_H2);
    int* rec_e = (int*)(p.ws + WS_REC_E); int* rec_pos = (int*)(p.ws + WS_REC_POS); float* rec_gate = (float*)(p.ws + WS_REC_GATE);
    const int ex = lane & 15, kq = lane >> 4;
    const size_t tokw = (size_t)bid * 128 + wave * 16;
    f32x4 acc0 = (f32x4){0.f, 0.f, 0.f, 0.f}, acc1 = acc0; float ssq = 0.f;
    {
        const float* xr = X1 + (tokw + ex) * D + 4 * kq;
        const LAS float* w0 = WrT + ex * WP + 4 * kq; const LAS float* w1 = w0 + 16 * WP;
#pragma unroll 4
        for (int q = 0; q < 64; ++q) {
            const f32x4 a = *(const f32x4*)(xr + 16 * q); const f32x4 b0 = *(const LAS f32x4*)(w0 + 16 * q), b1 = *(const LAS f32x4*)(w1 + 16 * q);
            ssq += (a.x * a.x + a.y * a.y) + (a.z * a.z + a.w * a.w);
#pragma unroll
            for (int k = 0; k < 4; ++k) { acc0 = __builtin_amdgcn_mfma_f32_16x16x4f32(a[k], b0[k], acc0, 0, 0, 0); acc1 = __builtin_amdgcn_mfma_f32_16x16x4f32(a[k], b1[k], acc1, 0, 0, 0); }
        }
    }
    ssq += __shfl_xor(ssq, 16); ssq += __shfl_xor(ssq, 32);
    const float rs = 1.0f / sqrtf(ssq * (1.0f / D) + NORM_EPS);
    const float br0 = p.router_b[ex], br1 = p.router_b[ex + 16];
    float lg0[4], lg1[4];
#pragma unroll
    for (int i = 0; i < 4; ++i) { const float r = __shfl(rs, 4 * kq + i); lg0[i] = acc0[i] * r + br0; lg1[i] = acc1[i] * r + br1; }
    int ti[4][4]; float tv[4][4];
#pragma unroll
    for (int r = 0; r < 4; ++r)
#pragma unroll
        for (int i = 0; i < 4; ++i) {
            float bv = (lg0[i] >= lg1[i]) ? lg0[i] : lg1[i]; int bi = (lg0[i] >= lg1[i]) ? ex : ex + 16;
#pragma unroll
            for (int m = 1; m < 16; m <<= 1) { const float ov = __shfl_xor(bv, m); const int oi = __shfl_xor(bi, m); const bool better = (ov > bv) || (ov == bv && oi < bi); bv = better ? ov : bv; bi = better ? oi : bi; }
            tv[i][r] = bv; ti[i][r] = bi;
            if (bi == ex) lg0[i] = -INFINITY; if (bi == ex + 16) lg1[i] = -INFINITY;
        }
    unsigned M[4];
#pragma unroll
    for (int i = 0; i < 4; ++i) M[i] = (1u << ti[i][0]) | (1u << ti[i][1]) | (1u << ti[i][2]) | (1u << ti[i][3]);
    unsigned Mall[16];
#pragma unroll
    for (int t = 0; t < 16; ++t) Mall[t] = (unsigned)__builtin_amdgcn_readlane((int)M[t & 3], 16 * (t >> 2));
#pragma unroll
    for (int i = 0; i < 4; ++i) {
        const int t = 4 * kq + i;
        const float e1 = __expf(tv[i][1] - tv[i][0]), e2 = __expf(tv[i][2] - tv[i][0]), e3 = __expf(tv[i][3] - tv[i][0]); const float inv = 1.0f / (1.0f + e1 + e2 + e3);
#pragma unroll
        for (int r = 0; r < 4; ++r) {
            const int x = ti[i][r]; int pos = 0;
#pragma unroll
            for (int tp = 0; tp < 16; ++tp) pos += (tp < t) ? (int)((Mall[tp] >> x) & 1u) : 0;
            const float gt = (r == 0 ? 1.0f : (r == 1 ? e1 : (r == 2 ? e2 : e3))) * inv;
            if (ex == r) { rec_e[(tokw + t) * 4 + r] = x; rec_pos[(tokw + t) * 4 + r] = pos; rec_gate[(tokw + t) * 4 + r] = gt; }
        }
    }
    { int cnt = 0;
#pragma unroll
        for (int t = 0; t < 16; ++t) cnt += (int)((Mall[t] >> (lane & 31)) & 1u);
        if (lane < 32) tbl[T_WB + wave * 32 + lane] = cnt; }
    {
        f32x4 g2[4];
#pragma unroll
        for (int j = 0; j < 4; ++j) g2[j] = *(const f32x4*)(p.norm2_g + 4 * lane + 256 * j);
#pragma unroll 4
        for (int t = 0; t < 16; ++t) {
            const float r = __shfl(rs, t);
            const f32x4* xr = (const f32x4*)(X1 + (tokw + t) * D) + lane;
#pragma unroll
            for (int j = 0; j < 4; ++j) { const f32x4 h = xr[64 * j] * r * g2[j]; u32x2 w; w.x = cvt_pk_bf16(h.x, h.y); w.y = cvt_pk_bf16(h.z, h.w); *(u32x2*)(H2 + (tokw + t) * D + 4 * lane + 256 * j) = w; }
        }
    }
    __syncthreads();
    if (tid < 256) ((int*)(p.ws + WS_WCNT))[(size_t)bid * 256 + tid] = tbl[T_WB + tid];
    if (tid < 32) { int sm = 0;
#pragma unroll
        for (int w = 0; w < 8; ++w) sm += tbl[T_WB + w * 32 + tid];
        ((int*)(p.ws + WS_BCNT))[bid * 32 + tid] = sm; }
    __syncthreads();
}

__device__ __forceinline__ void moe_tables(const Params& p, LAS int* tbl, int bid) {
    const int tid = threadIdx.x; const int* bcnt = (const int*)(p.ws + WS_BCNT);
    { const int e = tid & 31, part = tid >> 5; int all = 0, below = 0;
        for (int k = 0; k < 16; ++k) { const int blk = part * 16 + k; const int v = bcnt[blk * 32 + e]; all += v; below += (blk < bid) ? v : 0; }
        tbl[T_PART + part * 32 + e] = all; tbl[T_PART + 512 + part * 32 + e] = below; }
    __syncthreads();
    if (tid < 32) { int all = 0, below = 0;
        for (int q = 0; q < 16; ++q) { all += tbl[T_PART + q * 32 + tid]; below += tbl[T_PART + 512 + q * 32 + tid]; }
        tbl[T_NE + tid] = all; tbl[T_BLOCKBASE + tid] = below; }
    __syncthreads();
    if (tid == 0) { int ps = 0, ts = 0;
        for (int e = 0; e < NEXP; ++e) { tbl[T_PADSTART + e] = ps; tbl[T_TSTART + e] = ts; const int nt = (tbl[T_NE + e] + 255) >> 8; ps += nt * 256; ts += nt; }
        tbl[T_PADSTART + NEXP] = ps; tbl[T_TSTART + NEXP] = ts; }
    __syncthreads();
}

__device__ __forceinline__ void permute_phase(const Params& p, LAS unsigned char* lds, int bid, int G) {
    const int tid = threadIdx.x, lane = tid & 63, wave = __builtin_amdgcn_readfirstlane(tid >> 6);
    LAS int* tbl = (LAS int*)(lds + MISC_OFF);
    moe_tables(p, tbl, bid);
    if (tid < 256) { const int w = tid >> 5, e = tid & 31; int s = 0; const int* wc = (const int*)(p.ws + WS_WCNT) + (size_t)bid * 256;
        for (int q = 0; q < 8; ++q) s += (q < w) ? wc[q * 32 + e] : 0;
        tbl[T_WB + tid] = s; }
    __syncthreads();
    const int* rec_e = (const int*)(p.ws + WS_REC_E); const int* rec_pos = (const int*)(p.ws + WS_REC_POS); const float* rec_gate = (const float*)(p.ws + WS_REC_GATE);
    int* slot_of = (int*)(p.ws + WS_SLOT_OF); float* slot_gate = (float*)(p.ws + WS_SLOT_GATE);
    const bf16_t* H2 = (const bf16_t*)(p.ws + WS_H2); bf16_t* H2S = (bf16_t*)(p.ws + WS_H2S);
    for (int idx = wave; idx < 512; idx += NWAVES) {
        const int tl = idx >> 2, r = idx & 3; const size_t tk = (size_t)bid * 128 + tl;
        const int e = rec_e[tk * 4 + r], pw = rec_pos[tk * 4 + r];
        const int slot = tbl[T_PADSTART + e] + tbl[T_BLOCKBASE + e] + tbl[T_WB + (tl >> 4) * 32 + e] + pw;
        if (lane == 0) { slot_of[tk * 4 + r] = slot; slot_gate[slot] = rec_gate[tk * 4 + r]; }
        const u32x4 v0 = *(const u32x4*)(H2 + tk * D + 8 * lane), v1 = *(const u32x4*)(H2 + tk * D + 512 + 8 * lane);
        *(u32x4*)(H2S + (size_t)slot * D + 8 * lane) = v0; *(u32x4*)(H2S + (size_t)slot * D + 512 + 8 * lane) = v1;
    }
}

__device__ __forceinline__ void combine_phase(const Params& p, int bid, int G) {
    const int tid = threadIdx.x, lane = tid & 63, wave = __builtin_amdgcn_readfirstlane(tid >> 6);
    const int gw = bid * NWAVES + wave, NGW = G * NWAVES;
    const int* slot_of = (const int*)(p.ws + WS_SLOT_OF); const bf16_t* Y = (const bf16_t*)(p.ws + WS_Y);
    for (int tk = gw; tk < NTOK; tk += NGW) {
        int sl[4];
#pragma unroll
        for (int r = 0; r < 4; ++r) sl[r] = slot_of[(size_t)tk * 4 + r];
        float* orow = p.out + (size_t)tk * D;
#pragma unroll
        for (int j = 0; j < 4; ++j) { f32x4 a = *(const f32x4*)(orow + 4 * lane + 256 * j);
#pragma unroll
            for (int r = 0; r < 4; ++r) { const u32x2 y = *(const u32x2*)(Y + (size_t)sl[r] * D + 4 * lane + 256 * j); a.x += bf_lo(y.x); a.y += bf_hi(y.x); a.z += bf_lo(y.y); a.w += bf_hi(y.y); }
            *(f32x4*)(orow + 4 * lane + 256 * j) = a; }
    }
}

constexpr int NPH = 11;
__global__ void __launch_bounds__(NTHREADS, 2) mega(Params p) {
    extern __shared__ __attribute__((aligned(16))) unsigned char lds_raw[];
    LAS unsigned char* lds = (LAS unsigned char*)lds_raw;
    cg::grid_group grid = cg::this_grid();
    const int bid = blockIdx.x, G = gridDim.x;
    unsigned char* ws = p.ws;
#ifndef PH_MASK
#define PH_MASK 0x7ff
#endif
#define IN(k) (((PH_MASK >> (k)) & 1) && p.ph_lo <= (k) && (k) < p.ph_hi)
#define SEAM(k) do { if (IN(k) && IN((k) + 1)) grid.sync(); } while (0)
    if (IN(0)) phase0(p, lds, bid, G);
    SEAM(0);
    if (IN(1)) {
        pg8::Gemm g{(const bf16_t*)(ws + WS_XN), (const bf16_t*)(ws + WS_WIN), NTOK, INWP, D}; pg8::StaticOrder S; S.init(NTOK, INWP, G, bid);
        EpiInProj E{(bf16_t*)(ws + WS_Q), (bf16_t*)(ws + WS_K), (bf16_t*)(ws + WS_V), (bf16_t*)(ws + WS_QI), (bf16_t*)(ws + WS_KI), (bf16_t*)(ws + WS_POOL), (bf16_t*)(ws + WS_GA), (bf16_t*)(ws + WS_GP),
                    (float*)(ws + WS_WI), (const float*)(ws + WS_CS), p.q_norm_g, p.k_norm_g, p.idx_g, p.idx_b};
        pg8::gemm_phase(lds, g, S, E);
    }
    SEAM(1);
    if (IN(2)) { pool_phase(p, bid, G); attn_phase(p, lds, bid, G); }
    SEAM(2);
    if (IN(3)) {
        pg8::Gemm g{(const bf16_t*)(ws + WS_ATTN), (const bf16_t*)(ws + WS_WA), NTOK, D, 512}; pg8::StaticOrder S; S.init(NTOK, D, G, bid);
        EpiGateMul E{(const bf16_t*)(ws + WS_GA), nullptr, (bf16_t*)(ws + WS_TA)};
        pg8::gemm_phase(lds, g, S, E);
    }
    SEAM(3);
    if (IN(4)) {
        pg8::Gemm g{(const bf16_t*)(ws + WS_MIXED), (const bf16_t*)(ws + WS_WEFF), NTOK, D, 512}; pg8::StaticOrder S; S.init(NTOK, D, G, bid);
        EpiGateMul E{(const bf16_t*)(ws + WS_GP), (const bf16_t*)(ws + WS_TA), (bf16_t*)(ws + WS_MERGED)};
        pg8::gemm_phase(lds, g, S, E);
    }
    SEAM(4);
    if (IN(5)) {
        pg8::Gemm g{(const bf16_t*)(ws + WS_MERGED), (const bf16_t*)(ws + WS_WOUT), NTOK, D, D}; pg8::StaticOrder S; S.init(NTOK, D, G, bid);
        EpiResid E{p.x, p.out};
        pg8::gemm_phase(lds, g, S, E);
    }
    SEAM(5);
    if (IN(6)) router_phase(p, lds, bid, G);
    SEAM(6);
    if (IN(7)) permute_phase(p, lds, bid, G);
    SEAM(7);
    if (IN(8)) {
        LAS int* tbl = (LAS int*)(lds + MISC_OFF); moe_tables(p, tbl, bid);
        pg8::Gemm g{(const bf16_t*)(ws + WS_H2S), (const bf16_t*)(ws + WS_WGU), NSLOT, NEXP * 2048, D}; pg8::MoeOrder<8> S{tbl + T_TSTART, G, bid};
        EpiGateUp E{p.b_gu, (bf16_t*)(ws + WS_ACT)};
        pg8::gemm_phase(lds, g, S, E);
    }
    SEAM(8);
    if (IN(9)) {
        LAS int* tbl = (LAS int*)(lds + MISC_OFF); moe_tables(p, tbl, bid);
        pg8::Gemm g{(const bf16_t*)(ws + WS_ACT), (const bf16_t*)(ws + WS_WD), NSLOT, NEXP * 1024, D}; pg8::MoeOrder<4> S{tbl + T_TSTART, G, bid};
        EpiDown E{p.b_d, (const float*)(ws + WS_SLOT_GATE), (bf16_t*)(ws + WS_Y)};
        pg8::gemm_phase(lds, g, S, E);
    }
    SEAM(9);
    if (IN(10)) combine_phase(p, bid, G);
#undef IN
#undef SEAM
}

extern "C" void kernel_launch(void* const* d_in, const int* in_sizes, int n_in, void* d_out, int out_size, void* d_ws, size_t ws_size, hipStream_t stream) {
    static int grid = 0;
    if (grid == 0) {
        if (n_in != 20 || out_size != NTOK * D || ws_size < WS_END) { fprintf(stderr, "kernel_launch: unexpected shapes: n_in %d out %d ws %zu (need %zu)\n", n_in, out_size, ws_size, (size_t)WS_END); grid = -1; return; }
        int dev = 0, cus = 0, per_cu = 0;
        hipGetDevice(&dev); hipDeviceGetAttribute(&cus, hipDeviceAttributeMultiprocessorCount, dev);
        if (hipFuncSetAttribute((const void*)mega, hipFuncAttributeMaxDynamicSharedMemorySize, LDS_BYTES) != hipSuccess) { fprintf(stderr, "kernel_launch: hipFuncSetAttribute failed\n"); grid = -1; return; }
        if (hipOccupancyMaxActiveBlocksPerMultiprocessor(&per_cu, (const void*)mega, NTHREADS, LDS_BYTES) != hipSuccess || per_cu < 1) { fprintf(stderr, "kernel_launch: occupancy query says %d blocks per CU\n", per_cu); per_cu = 1; }
        (void)hipGetLastError();
        grid = cus;
        if (grid != 256) fprintf(stderr, "kernel_launch: %d CUs; the router / permute phases assume a 256-workgroup grid\n", grid);
    }
    if (grid < 0) return;
    Params p{};
    p.x = (const float*)d_in[0]; p.pos = (const int*)d_in[1]; p.norm1_g = (const float*)d_in[2]; p.w_in = (const float*)d_in[3]; p.q_norm_g = (const float*)d_in[4];
    p.k_norm_g = (const float*)d_in[5]; p.idx_g = (const float*)d_in[6]; p.idx_b = (const float*)d_in[7]; p.w_a = (const float*)d_in[8]; p.pool_mix = (const float*)d_in[9];
    p.pool_scale = (const float*)d_in[10]; p.w_b = (const float*)d_in[11]; p.w_out = (const float*)d_in[12]; p.norm2_g = (const float*)d_in[13]; p.router_w = (const float*)d_in[14];
    p.router_b = (const float*)d_in[15]; p.w_gu = (const float*)d_in[16]; p.b_gu = (const float*)d_in[17]; p.w_d = (const float*)d_in[18]; p.b_d = (const float*)d_in[19];
    p.out = (float*)d_out; p.ws = (unsigned char*)d_ws;
#if MK_MODE == 0
    p.ph_lo = 0; p.ph_hi = NPH;
    void* args[] = {&p};
    hipError_t e = hipLaunchCooperativeKernel((const void*)mega, dim3(grid), dim3(NTHREADS), args, LDS_BYTES, stream);
    if (e != hipSuccess) fprintf(stderr, "kernel_launch: cooperative launch failed: %s (grid %d)\n", hipGetErrorString(e), grid);
#else
    for (int k = 0; k < NPH; ++k) { p.ph_lo = k; p.ph_hi = k + 1; hipLaunchKernelGGL(mega, dim3(grid), dim3(NTHREADS), LDS_BYTES, stream, p); }
#endif
}
```

```cpp
#include <hip/hip_runtime.h>
#include <hip/hip_cooperative_groups.h>
#include <cstdio>
#include <cstdint>
#include <cmath>
namespace cg = cooperative_groups;

#ifndef MK_MODE
#define MK_MODE 0
#endif

#define LAS __attribute__((address_space(3)))
typedef unsigned short bf16_t;
typedef short bf16x8 __attribute__((ext_vector_type(8)));
typedef float f32x2 __attribute__((ext_vector_type(2)));
typedef float f32x4 __attribute__((ext_vector_type(4)));
typedef float f32x16 __attribute__((ext_vector_type(16)));
typedef unsigned u32x2 __attribute__((ext_vector_type(2)));
typedef unsigned u32x4 __attribute__((ext_vector_type(4)));

constexpr int D = 1024, NBATCH = 8, SEQ = 4096, NTOK = NBATCH * SEQ;
constexpr int NEXP = 32, TOPK = 4;
constexpr int INW = 3652, INWP = 3840;
constexpr int NSLOT = 139264;
constexpr float NORM_EPS = 1e-6f;
constexpr int NWAVES = 8, NTHREADS = 512;
constexpr int LDS_BYTES = 147456;
constexpr int RING_BYTES = 131072;
constexpr int MISC_OFF = 135168;

constexpr size_t MiB = 1u << 20;
constexpr size_t WS_CTL = 0;
constexpr size_t WS_BCNT = 64 * 1024;
constexpr size_t WS_WCNT = 128 * 1024;
constexpr size_t WS_CS = 2 * MiB;
constexpr size_t WS_WIN = 16 * MiB;
constexpr size_t WS_WA = 24 * MiB;
constexpr size_t WS_WEFF = 25 * MiB;
constexpr size_t WS_WOUT = 26 * MiB;
constexpr size_t WS_WGU = 28 * MiB;
constexpr size_t WS_WD = 156 * MiB;
constexpr size_t WS_REC_E = 220 * MiB;
constexpr size_t WS_REC_POS = 221 * MiB;
constexpr size_t WS_REC_GATE = 222 * MiB;
constexpr size_t WS_SLOT_OF = 223 * MiB;
constexpr size_t WS_SLOT_GATE = 223 * MiB + 512 * 1024;
constexpr size_t WS_XN = 226 * MiB;
constexpr size_t WS_Q = 290 * MiB;
constexpr size_t WS_K = 322 * MiB;
constexpr size_t WS_V = 330 * MiB;
constexpr size_t WS_QI = 338 * MiB;
constexpr size_t WS_KI = 354 * MiB;
constexpr size_t WS_WI = 358 * MiB;
constexpr size_t WS_POOL = 360 * MiB;
constexpr size_t WS_GA = 392 * MiB;
constexpr size_t WS_GP = 456 * MiB;
constexpr size_t WS_ATTN = 520 * MiB;
constexpr size_t WS_MIXED = 552 * MiB;
constexpr size_t WS_TA = 584 * MiB;
constexpr size_t WS_MERGED = 648 * MiB;
constexpr size_t WS_H2 = WS_XN;
constexpr size_t WS_H2S = 290 * MiB;
constexpr size_t WS_Y = WS_H2S;
constexpr size_t WS_ACT = 562 * MiB;
constexpr size_t WS_END = 834 * MiB;
static_assert(WS_SLOT_GATE + (size_t)NSLOT * 4 <= WS_XN, "ws map");

__device__ __forceinline__ unsigned cvt_pk_bf16(float lo, float hi) { unsigned r; asm volatile("v_cvt_pk_bf16_f32 %0, %1, %2" : "=v"(r) : "v"(lo), "v"(hi)); return r; }
__device__ __forceinline__ float bf_lo(unsigned w) { return __uint_as_float(w << 16); }
__device__ __forceinline__ float bf_hi(unsigned w) { return __uint_as_float(w & 0xffff0000u); }
__device__ __forceinline__ float wave_sum(float v) {
#pragma unroll
    for (int o = 1; o < 64; o <<= 1) v += __shfl_xor(v, o);
    return v;
}
__device__ __forceinline__ float sigmoidf_(float x) { return 1.0f / (1.0f + __expf(-x)); }
#define LDS_WAIT() asm volatile("s_waitcnt lgkmcnt(0)" ::: "memory")

__host__ __device__ __forceinline__ int idx_bj_j(int d, int& bj) {
    int j;
    if (d < 16) { bj = 0; j = d; } else if (d < 32) { bj = 1; j = d - 16; } else if (d < 48) { bj = 0; j = d - 16; } else { bj = 1; j = d - 32; }
    return j;
}
__host__ __device__ __forceinline__ int win_phys(int n) {
    if (n < 512) { const int h = n >> 6, d = n & 63; return 256 * (h >> 2) + 128 * (d >> 5) + 32 * (h & 3) + (d & 31); }
    if (n < 768) { const int h = (n - 512) >> 6, d = n & 63; return 512 + 128 * (d >> 5) + 32 * h + (d & 31); }
    if (n < 1024) { const int h = (n - 768) >> 6, d = n & 63; int bj; const int j = idx_bj_j(d, bj); return 768 + 128 * bj + 32 * h + j; }
    if (n < 1088) { const int d = n - 1024; int bj; const int j = idx_bj_j(d, bj); return 1024 + 128 * bj + j; }
    if (n < 1092) return 1024 + 32 + (n - 1088);
    if (n < 1604) return 1280 + (n - 1092);
    if (n < 2628) return 1792 + (n - 1604);
    return 2816 + (n - 2628);
}

namespace pg8 {
constexpr int BM = 256, BK = 64, HALF = 128, HTB = HALF * BK * 2, STAGE_BYTES = 8 * HTB, NXCD = 8, WGM = 8;
__host__ __device__ __forceinline__ int lds_byte(int r, int c) { const int st = (r >> 4) * 2 + (c >> 5), rr = r & 15, cc = c & 31, ob = rr * 64 + cc * 2; return st * 1024 + (ob ^ (((ob >> 9) & 1) << 5)); }
__host__ __device__ __forceinline__ void stage_rc(int b, int& R, int& C) { const int st = b / 1024, sb = b % 1024, swz = sb ^ (((sb >> 9) & 1) << 5); R = (st >> 1) * 16 + swz / 64; C = (st & 1) * 32 + (swz % 64) / 2; }
__host__ __device__ __forceinline__ int perm32(int rho) { const int n = rho >> 4, i = rho & 15; return 8 * (i >> 2) + 4 * n + (i & 3); }

struct Unit { int pm, pn; };
struct Gemm { const bf16_t* A; const bf16_t* Bt; int M, N, K; };

struct StaticOrder {
    int nM, nN, nwg, G, c;
    __device__ void init(int M, int N, int G_, int c_) { nM = M / BM; nN = N / BM; nwg = nM * nN; G = G_; c = c_; }
    __device__ bool next(int i, Unit& u) const {
        const long L = (long)i * G + c; if (L >= nwg) return false;
        int wgid = (int)L; { const int q = nwg / NXCD, r = nwg % NXCD, xcd = wgid % NXCD, off = wgid / NXCD; wgid = (xcd < r ? xcd * (q + 1) : r * (q + 1) + (xcd - r) * q) + off; }
        const int nig = WGM * nN, gid = wgid / nig, fm = gid * WGM, gsz = (nM - fm) < WGM ? (nM - fm) : WGM;
        u.pm = fm + ((wgid % nig) % gsz); u.pn = (wgid % nig) / gsz; return true;
    }
};
template <int NPN> struct MoeOrder {
    const LAS int* tstart; int G, c;
    __device__ bool next(int i, Unit& u) const {
        const int L = i * G + c; const int ntile = tstart[NEXP];
        if (L >= ntile * NPN) return false;
        const int ti = L / NPN, pn = L % NPN; int e = 0;
#pragma unroll
        for (int k = 1; k < NEXP; ++k) e += (tstart[k] <= ti) ? 1 : 0;
        u.pm = ti; u.pn = e * NPN + pn; return true;
    }
};

template <class Epi, class Sched>
__device__ __forceinline__ void gemm_phase(LAS unsigned char* lds, const Gemm g, const Sched& S, const Epi& E) {
    const int tid = threadIdx.x, wid = __builtin_amdgcn_readfirstlane(tid >> 6), lane = tid & 63, wr = wid >> 2, wc = wid & 3, fr = lane & 15, fq = lane >> 4;
    const int K = g.K, nt = K / BK;
    unsigned voffA[2], voffB[2];
#pragma unroll
    for (int i = 0; i < 2; ++i) { int R, C; stage_rc(tid * 16 + i * 8192, R, C); const int Rb = (R & ~31) + perm32(R & 31);
        voffA[i] = (unsigned)(R * K + C) * 2u; voffB[i] = (unsigned)(Rb * K + C) * 2u; }
    const size_t kstep = (size_t)(BK * 2);
    const size_t hstep = (size_t)HALF * K * 2;
    const size_t tstep = 2 * hstep;
    const unsigned ldsw = (unsigned)wid * 1024u;
    const int aoff = lds_byte(wr * 64 + fr, fq * 8), boff = lds_byte(wc * 32 + fr, fq * 8);
#define PG8_SA(b, h) (((b) * 2 + (h)) * HTB)
#define PG8_SB(b, h) ((4 + (b) * 2 + (h)) * HTB)
#define PG8_STAGE(bufoff, gbase, voff) do { _Pragma("unroll") for (int _i = 0; _i < 2; ++_i) \
        __builtin_amdgcn_global_load_lds((const unsigned*)((const char*)(gbase) + (voff)[_i]), (LAS unsigned*)(lds + (bufoff) + ldsw + _i * 8192), 16, 0, 0); } while (0)
#define PG8_LDA(dst, b, h) do { _Pragma("unroll") for (int m = 0; m < 4; ++m) _Pragma("unroll") for (int k = 0; k < 2; ++k) dst[m][k] = *(const LAS bf16x8*)(lds + PG8_SA(b, h) + aoff + m * 2048 + k * 1024); } while (0)
#define PG8_LDB(dst, b, h) do { _Pragma("unroll") for (int n = 0; n < 2; ++n) _Pragma("unroll") for (int k = 0; k < 2; ++k) dst[n][k] = *(const LAS bf16x8*)(lds + PG8_SB(b, h) + boff + n * 2048 + k * 1024); } while (0)
#define PG8_MMA(ai, bj, At, Bt) do { __builtin_amdgcn_s_setprio(1); _Pragma("unroll") for (int m = 0; m < 4; ++m) _Pragma("unroll") for (int n = 0; n < 2; ++n) _Pragma("unroll") for (int k = 0; k < 2; ++k) \
        acc[ai][bj][m][n] = __builtin_amdgcn_mfma_f32_16x16x32_bf16(Bt[n][k], At[m][k], acc[ai][bj][m][n], 0, 0, 0); __builtin_amdgcn_s_setprio(0); } while (0)
#define PG8_WAIT_V(n) asm volatile("s_waitcnt vmcnt(" #n ")" ::: "memory")
#define PG8_WAIT_L(n) asm volatile("s_waitcnt lgkmcnt(" #n ")" ::: "memory")
#define PG8_BAR __builtin_amdgcn_s_barrier()
#define PG8_SCHED __builtin_amdgcn_sched_barrier(0)
    Unit cur, nxt; int ui = 0;
    if (!S.next(0, cur)) return;
    f32x4 acc[2][2][4][2];
#pragma unroll
    for (int a = 0; a < 2; ++a)
#pragma unroll
        for (int b = 0; b < 2; ++b)
#pragma unroll
            for (int m = 0; m < 4; ++m)
#pragma unroll
                for (int n = 0; n < 2; ++n) acc[a][b][m][n] = (f32x4){0.f, 0.f, 0.f, 0.f};
    bf16x8 At[4][2], B0[2][2], B1[2][2];
    const char* cA = (const char*)g.A + (size_t)cur.pm * tstep; const char* cB = (const char*)g.Bt + (size_t)cur.pn * tstep;
    PG8_STAGE(PG8_SB(0, 0), cB, voffB); PG8_STAGE(PG8_SB(0, 1), cB + hstep, voffB); PG8_STAGE(PG8_SA(0, 0), cA, voffA); PG8_STAGE(PG8_SA(0, 1), cA + hstep, voffA);
    if (wr == 1) PG8_BAR;
    PG8_WAIT_V(2); PG8_BAR;
    PG8_STAGE(PG8_SB(1, 0), cB + kstep, voffB); PG8_STAGE(PG8_SA(1, 0), cA + kstep, voffA); PG8_STAGE(PG8_SB(1, 1), cB + hstep + kstep, voffB);
    PG8_WAIT_V(6); PG8_BAR;
    for (;;) {
        const bool has_next = S.next(ui + 1, nxt);
        const char* nA = has_next ? (const char*)g.A + (size_t)nxt.pm * tstep : cA; const char* nB = has_next ? (const char*)g.Bt + (size_t)nxt.pn * tstep : cB;
        for (int t = 0; t < nt; t += 2) {
            const bool last = (t == nt - 2);
            const char* a1 = cA + (size_t)(t + 1) * kstep;
            const char* a2 = last ? nA : cA + (size_t)(t + 2) * kstep; const char* b2 = last ? nB : cB + (size_t)(t + 2) * kstep;
            const char* a3 = a2 + kstep; const char* b3 = b2 + kstep;
            PG8_LDB(B0, 0, 0); PG8_LDB(B1, 0, 1); PG8_SCHED; PG8_LDA(At, 0, 0); PG8_STAGE(PG8_SA(1, 1), a1 + hstep, voffA);
            PG8_WAIT_V(8); PG8_WAIT_L(0); PG8_BAR; PG8_MMA(0, 0, At, B0); PG8_MMA(0, 1, At, B1); PG8_BAR; PG8_SCHED;
            PG8_LDA(At, 0, 1); PG8_STAGE(PG8_SB(0, 0), b2, voffB); PG8_STAGE(PG8_SB(0, 1), b2 + hstep, voffB); PG8_STAGE(PG8_SA(0, 0), a2, voffA);
            PG8_WAIT_V(8); PG8_WAIT_L(0); PG8_BAR; PG8_MMA(1, 0, At, B0); PG8_MMA(1, 1, At, B1); PG8_BAR; PG8_SCHED;
            PG8_LDB(B0, 1, 0); PG8_LDB(B1, 1, 1); PG8_SCHED; PG8_LDA(At, 1, 0); PG8_STAGE(PG8_SA(0, 1), a2 + hstep, voffA);
            PG8_WAIT_V(8); PG8_WAIT_L(0); PG8_BAR; PG8_MMA(0, 0, At, B0); PG8_MMA(0, 1, At, B1); PG8_BAR; PG8_SCHED;
            PG8_LDA(At, 1, 1); PG8_STAGE(PG8_SB(1, 0), b3, voffB); PG8_STAGE(PG8_SB(1, 1), b3 + hstep, voffB); PG8_STAGE(PG8_SA(1, 0), a3, voffA);
            PG8_WAIT_V(8); PG8_WAIT_L(0); PG8_BAR; PG8_MMA(1, 0, At, B0); PG8_MMA(1, 1, At, B1); PG8_BAR; PG8_SCHED;
        }
        if (wr == 0) PG8_BAR;
        E(acc, cur, wr, wc, fr, fq);
        if (!has_next) break;
#pragma unroll
        for (int a = 0; a < 2; ++a)
#pragma unroll
            for (int b = 0; b < 2; ++b)
#pragma unroll
                for (int m = 0; m < 4; ++m)
#pragma unroll
                    for (int n = 0; n < 2; ++n) acc[a][b][m][n] = (f32x4){0.f, 0.f, 0.f, 0.f};
        cur = nxt; cA = nA; cB = nB; ++ui;
        if (wr == 1) PG8_BAR;
    }
    PG8_WAIT_V(0);
    PG8_BAR;
#undef PG8_SA
#undef PG8_SB
#undef PG8_STAGE
#undef PG8_LDA
#undef PG8_LDB
#undef PG8_MMA
#undef PG8_WAIT_V
#undef PG8_WAIT_L
#undef PG8_BAR
#undef PG8_SCHED
}
}

struct Params {
    const float* x; const int* pos; const float* norm1_g; const float* w_in; const float* q_norm_g; const float* k_norm_g;
    const float* idx_g; const float* idx_b; const float* w_a; const float* pool_mix; const float* pool_scale; const float* w_b;
    const float* w_out; const float* norm2_g; const float* router_w; const float* router_b; const float* w_gu; const float* b_gu;
    const float* w_d; const float* b_d;
    float* out; unsigned char* ws; int ph_lo, ph_hi;
};

using pg8::Unit; using pg8::HALF;
__device__ __forceinline__ void st8(bf16_t* p, const float (&v)[8]) {
    u32x4 w; w.x = cvt_pk_bf16(v[0], v[1]); w.y = cvt_pk_bf16(v[2], v[3]); w.z = cvt_pk_bf16(v[4], v[5]); w.w = cvt_pk_bf16(v[6], v[7]); *(u32x4*)p = w;
}
__device__ __forceinline__ void ld8f(const float* p, float (&v)[8]) { const f32x4 a = *(const f32x4*)p, b = *(const f32x4*)(p + 4); v[0]=a[0]; v[1]=a[1]; v[2]=a[2]; v[3]=a[3]; v[4]=b[0]; v[5]=b[1]; v[6]=b[2]; v[7]=b[3]; }
__device__ __forceinline__ void ld8bf(const bf16_t* p, float (&v)[8]) { const u32x4 w = *(const u32x4*)p; v[0]=bf_lo(w.x); v[1]=bf_hi(w.x); v[2]=bf_lo(w.y); v[3]=bf_hi(w.y); v[4]=bf_lo(w.z); v[5]=bf_hi(w.z); v[6]=bf_lo(w.w); v[7]=bf_hi(w.w); }

struct EpiInProj {
    bf16_t *Q, *Kb, *Vb, *Qi, *Ki, *Pool, *Ga, *Gp; float* Wi; const float* cs; const float *gq, *gk, *lng, *lnb;
    __device__ __forceinline__ void operator()(const f32x4 (&acc)[2][2][4][2], const Unit& u, int wr, int wc, int fr, int fq) const {
        const int pn = u.pn;
#pragma unroll
        for (int ai = 0; ai < 2; ++ai)
#pragma unroll
            for (int m = 0; m < 4; ++m) {
                const int row = u.pm * 256 + ai * HALF + wr * 64 + m * 16 + fr;
                float v0[8], v1[8];
#pragma unroll
                for (int n = 0; n < 2; ++n)
#pragma unroll
                    for (int i = 0; i < 4; ++i) { v0[4 * n + i] = acc[ai][0][m][n][i]; v1[4 * n + i] = acc[ai][1][m][n][i]; }
                if (pn <= 1 || (pn == 2 && wc < 2)) {
                    float ss = 0.f;
#pragma unroll
                    for (int j = 0; j < 8; ++j) ss += v0[j] * v0[j] + v1[j] * v1[j];
                    ss += __shfl_xor(ss, 16); ss += __shfl_xor(ss, 32);
                    const float rs = 1.0f / sqrtf(ss * (1.0f / 64.0f) + NORM_EPS);
                    const float* gg = (pn <= 1) ? gq : gk; const float sc = (pn <= 1) ? 0.125f : 1.0f;
                    float g0[8], g1[8], cc[8], sn[8];
                    ld8f(gg + 8 * fq, g0); ld8f(gg + 32 + 8 * fq, g1);
                    ld8f(cs + (size_t)row * 96 + 8 * fq, cc); ld8f(cs + (size_t)row * 96 + 48 + 8 * fq, sn);
                    float o0[8], o1[8];
#pragma unroll
                    for (int j = 0; j < 8; ++j) { const float x1 = v0[j] * rs * g0[j], x2 = v1[j] * rs * g1[j]; o0[j] = (x1 * cc[j] - x2 * sn[j]) * sc; o1[j] = (x2 * cc[j] + x1 * sn[j]) * sc; }
                    bf16_t* dst = (pn <= 1) ? Q + (size_t)row * 512 + (4 * pn + wc) * 64 : Kb + (size_t)row * 128 + wc * 64;
                    st8(dst + 8 * fq, o0); st8(dst + 32 + 8 * fq, o1);
                } else if (pn == 2) {
                    bf16_t* dst = Vb + (size_t)row * 128 + (wc - 2) * 64;
                    st8(dst + 8 * fq, v0); st8(dst + 32 + 8 * fq, v1);
                } else if (pn == 3 || (pn == 4 && wc == 0)) {
                    if (pn == 4) {
                        float s = 0.f;
#pragma unroll
                        for (int j = 0; j < 8; ++j) s += v0[j] + v1[j];
                        s += __shfl_xor(s, 16); s += __shfl_xor(s, 32);
                        const float mu = s * (1.0f / 64.0f); float q = 0.f;
#pragma unroll
                        for (int j = 0; j < 8; ++j) { v0[j] -= mu; v1[j] -= mu; q += v0[j] * v0[j] + v1[j] * v1[j]; }
                        q += __shfl_xor(q, 16); q += __shfl_xor(q, 32);
                        const float rs = 1.0f / sqrtf(q * (1.0f / 64.0f) + NORM_EPS);
                        const int d0 = (fq < 2) ? 8 * fq : 8 * fq + 16, d1 = (fq < 2) ? 16 + 8 * fq : 8 * fq + 32;
                        float a0[8], a1[8], b0[8], b1[8];
                        ld8f(lng + d0, a0); ld8f(lng + d1, a1); ld8f(lnb + d0, b0); ld8f(lnb + d1, b1);
#pragma unroll
                        for (int j = 0; j < 8; ++j) { v0[j] = v0[j] * rs * a0[j] + b0[j]; v1[j] = v1[j] * rs * a1[j] + b1[j]; }
                    }
                    bf16_t* dst = (pn == 3) ? Qi + (size_t)row * 256 + wc * 64 : Ki + (size_t)row * 64;
                    if (fq < 2) {
                        float cc[8], sn[8];
                        ld8f(cs + (size_t)row * 96 + 32 + 8 * fq, cc); ld8f(cs + (size_t)row * 96 + 48 + 32 + 8 * fq, sn);
                        float o0[8], o1[8];
#pragma unroll
                        for (int j = 0; j < 8; ++j) { o0[j] = v0[j] * cc[j] - v1[j] * sn[j]; o1[j] = v1[j] * cc[j] + v0[j] * sn[j]; }
                        st8(dst + 8 * fq, o0); st8(dst + 16 + 8 * fq, o1);
                    } else { st8(dst + 8 * fq + 16, v0); st8(dst + 8 * fq + 32, v1); }
                } else if (pn == 4) {
                    if (wc == 1 && fq == 0) *(f32x4*)(Wi + (size_t)row * 4) = (f32x4){v0[0] * 0.0625f, v0[1] * 0.0625f, v0[2] * 0.0625f, v0[3] * 0.0625f};
                } else if (pn <= 6) {
                    bf16_t* dst = Pool + (size_t)row * 512 + (pn - 5) * 256 + wc * 32 + 8 * fq;
                    st8(dst, v0); st8(dst + HALF, v1);
                } else {
                    bf16_t* dst = ((pn <= 10) ? Ga + (size_t)row * 1024 + (pn - 7) * 256 : Gp + (size_t)row * 1024 + (pn - 11) * 256) + wc * 32 + 8 * fq;
#pragma unroll
                    for (int j = 0; j < 8; ++j) { v0[j] = sigmoidf_(v0[j]); v1[j] = sigmoidf_(v1[j]); }
                    st8(dst, v0); st8(dst + HALF, v1);
                }
            }
    }
};

struct EpiGateMul {
    const bf16_t* G; const bf16_t* T; bf16_t* O;
    __device__ __forceinline__ void operator()(const f32x4 (&acc)[2][2][4][2], const Unit& u, int wr, int wc, int fr, int fq) const {
#pragma unroll
        for (int ai = 0; ai < 2; ++ai)
#pragma unroll
            for (int m = 0; m < 4; ++m) {
                const size_t off = (size_t)(u.pm * 256 + ai * HALF + wr * 64 + m * 16 + fr) * 1024 + u.pn * 256 + wc * 32 + 8 * fq;
#pragma unroll
                for (int bj = 0; bj < 2; ++bj) {
                    float g[8], o[8]; ld8bf(G + off + bj * HALF, g);
#pragma unroll
                    for (int n = 0; n < 2; ++n)
#pragma unroll
                        for (int i = 0; i < 4; ++i) o[4 * n + i] = g[4 * n + i] * acc[ai][bj][m][n][i];
                    if (T) { float t[8]; ld8bf(T + off + bj * HALF, t);
#pragma unroll
                        for (int j = 0; j < 8; ++j) o[j] += t[j]; }
                    st8(O + off + bj * HALF, o);
                }
            }
    }
};
struct EpiResid {
    const float* X; float* O;
    __device__ __forceinline__ void operator()(const f32x4 (&acc)[2][2][4][2], const Unit& u, int wr, int wc, int fr, int fq) const {
#pragma unroll
        for (int ai = 0; ai < 2; ++ai)
#pragma unroll
            for (int m = 0; m < 4; ++m) {
                const size_t off = (size_t)(u.pm * 256 + ai * HALF + wr * 64 + m * 16 + fr) * 1024 + u.pn * 256 + wc * 32 + 8 * fq;
#pragma unroll
                for (int bj = 0; bj < 2; ++bj)
#pragma unroll
                    for (int n = 0; n < 2; ++n) { const size_t o = off + bj * HALF + 4 * n; *(f32x4*)(O + o) = *(const f32x4*)(X + o) + acc[ai][bj][m][n]; }
            }
    }
};
struct EpiGateUp {
    const float* bias; bf16_t* Act;
    __device__ __forceinline__ void operator()(const f32x4 (&acc)[2][2][4][2], const Unit& u, int wr, int wc, int fr, int fq) const {
        const int e = u.pn >> 3, pnl = u.pn & 7, col = pnl * 128 + wc * 32 + 8 * fq;
        float bg[8], bu[8]; ld8f(bias + (size_t)e * 2048 + col, bg); ld8f(bias + (size_t)e * 2048 + 1024 + col, bu);
#pragma unroll
        for (int ai = 0; ai < 2; ++ai)
#pragma unroll
            for (int m = 0; m < 4; ++m) {
                const size_t row = (size_t)(u.pm * 256 + ai * HALF + wr * 64 + m * 16 + fr);
                float o[8];
#pragma unroll
                for (int n = 0; n < 2; ++n)
#pragma unroll
                    for (int i = 0; i < 4; ++i) { const int j = 4 * n + i;
                        const float gt = fminf(acc[ai][0][m][n][i] + bg[j], 7.0f), up = fminf(fmaxf(acc[ai][1][m][n][i] + bu[j], -7.0f), 7.0f);
                        o[j] = gt * sigmoidf_(1.702f * gt) * (up + 1.0f); }
                st8(Act + row * 1024 + col, o);
            }
    }
};
struct EpiDown {
    const float* bias; const float* sgate; bf16_t* Y;
    __device__ __forceinline__ void operator()(const f32x4 (&acc)[2][2][4][2], const Unit& u, int wr, int wc, int fr, int fq) const {
        const int e = u.pn >> 2, pnl = u.pn & 3, col = pnl * 256 + wc * 32 + 8 * fq;
        float b0[8], b1[8]; ld8f(bias + (size_t)e * 1024 + col, b0); ld8f(bias + (size_t)e * 1024 + col + HALF, b1);
#pragma unroll
        for (int ai = 0; ai < 2; ++ai)
#pragma unroll
            for (int m = 0; m < 4; ++m) {
                const size_t row = (size_t)(u.pm * 256 + ai * HALF + wr * 64 + m * 16 + fr);
                const float gt = sgate[row];
                float o0[8], o1[8];
#pragma unroll
                for (int n = 0; n < 2; ++n)
#pragma unroll
                    for (int i = 0; i < 4; ++i) { const int j = 4 * n + i; o0[j] = (acc[ai][0][m][n][i] + b0[j]) * gt; o1[j] = (acc[ai][1][m][n][i] + b1[j]) * gt; }
                st8(Y + row * 1024 + col, o0); st8(Y + row * 1024 + col + HALF, o1);
            }
    }
};

template <class RowMap>
__device__ __forceinline__ void cvt_item(const float* W, int K, int N, bf16_t* WT, LAS float* scr, int kb, int nb, int lane, const RowMap& rm) {
    const int k0 = kb * 64, n0 = nb * 64, n4 = lane & 15, kr = lane >> 4, n = n0 + 4 * n4;
    f32x4 v[16];
#pragma unroll
    for (int i = 0; i < 16; ++i) v[i] = (n < N) ? *(const f32x4*)(W + (size_t)(k0 + 4 * i + kr) * N + n) : (f32x4){0.f, 0.f, 0.f, 0.f};
#pragma unroll
    for (int i = 0; i < 16; ++i) { LAS float* d = scr + (4 * i + kr) * 65 + 4 * n4; d[0] = v[i][0]; d[1] = v[i][1]; d[2] = v[i][2]; d[3] = v[i][3]; }
    LDS_WAIT(); asm volatile("" ::: "memory");
    const int c8 = lane & 7;
#pragma unroll
    for (int jj = 0; jj < 8; ++jj) { const int nn = (lane >> 3) + 8 * jj; const LAS float* s = scr + (8 * c8) * 65 + nn;
        if (n0 + nn < N) { u32x4 o; o.x = cvt_pk_bf16(s[0], s[65]); o.y = cvt_pk_bf16(s[2 * 65], s[3 * 65]); o.z = cvt_pk_bf16(s[4 * 65], s[5 * 65]); o.w = cvt_pk_bf16(s[6 * 65], s[7 * 65]);
            *(u32x4*)(WT + (size_t)rm(n0 + nn) * K + k0 + 8 * c8) = o; } }
    LDS_WAIT(); asm volatile("" ::: "memory");
}
struct RmIdent { int off; __device__ __forceinline__ int operator()(int n) const { return off + n; } };
struct RmWin { __device__ __forceinline__ int operator()(int n) const { return win_phys(n); } };
struct RmGu { int e; __device__ __forceinline__ int operator()(int n) const { return e * 2048 + 256 * ((n & 1023) >> 7) + 128 * (n >> 10) + (n & 127); } };

__device__ __forceinline__ void phase0(const Params& p, LAS unsigned char* lds, int bid, int G) {
    const int tid = threadIdx.x, lane = tid & 63, wave = __builtin_amdgcn_readfirstlane(tid >> 6);
    const int gw = bid * NWAVES + wave, NGW = G * NWAVES;
    unsigned char* ws = p.ws;
    LAS float* scr = (LAS float*)(lds + wave * 16640);
    constexpr int I_GU = NEXP * 16 * 32, I_D = NEXP * 16 * 16, I_IN = 16 * 58, I_A = 8 * 16, I_O = 16 * 16;
    constexpr int NITEMS = I_GU + I_D + I_IN + I_A + I_O;
    for (int it = gw; it < NITEMS; it += NGW) {
        int r = it;
        if (r < I_GU) { const int e = r / 512, q = r % 512; cvt_item(p.w_gu + (size_t)e * 1024 * 2048, 1024, 2048, (bf16_t*)(ws + WS_WGU), scr, q / 32, q % 32, lane, RmGu{e}); continue; } r -= I_GU;
        if (r < I_D) { const int e = r / 256, q = r % 256; cvt_item(p.w_d + (size_t)e * 1024 * 1024, 1024, 1024, (bf16_t*)(ws + WS_WD), scr, q / 16, q % 16, lane, RmIdent{e * 1024}); continue; } r -= I_D;
        if (r < I_IN) { cvt_item(p.w_in, 1024, INW, (bf16_t*)(ws + WS_WIN), scr, r / 58, r % 58, lane, RmWin{}); continue; } r -= I_IN;
        if (r < I_A) { cvt_item(p.w_a, 512, 1024, (bf16_t*)(ws + WS_WA), scr, r / 16, r % 16, lane, RmIdent{0}); continue; } r -= I_A;
        cvt_item(p.w_out, 1024, 1024, (bf16_t*)(ws + WS_WOUT), scr, r / 16, r % 16, lane, RmIdent{0});
    }
    for (int it = gw; it < 16 * 4 * 16; it += NGW) {
        const int nb = it & 15, g = (it >> 4) & 3, cb = it >> 6, n = nb * 64 + lane, c0 = cb * 8;
        float a[8];
#pragma unroll
        for (int q = 0; q < 8; ++q) a[q] = 0.f;
        const float* mix = p.pool_mix + (size_t)g * 128 * 128 + (size_t)c0 * 128;
        for (int d = 0; d < 128; ++d) {
            const float wb = p.pool_scale[g * 128 + d] * p.w_b[(size_t)(g * 128 + d) * 1024 + n];
#pragma unroll
            for (int q = 0; q < 8; ++q) a[q] += mix[q * 128 + d] * wb;
        }
        st8((bf16_t*)(ws + WS_WEFF) + (size_t)n * 512 + g * 128 + c0, a);
    }
    {
        f32x4 gv[4];
#pragma unroll
        for (int j = 0; j < 4; ++j) gv[j] = *(const f32x4*)(p.norm1_g + 4 * lane + 256 * j);
        bf16_t* XN = (bf16_t*)(ws + WS_XN);
        for (int m = gw; m < NTOK; m += NGW) {
            const f32x4* xr = (const f32x4*)(p.x + (size_t)m * D) + lane;
            f32x4 v[4]; float s = 0.f;
#pragma unroll
            for (int j = 0; j < 4; ++j) { v[j] = xr[64 * j]; s += (v[j].x * v[j].x + v[j].y * v[j].y) + (v[j].z * v[j].z + v[j].w * v[j].w); }
            const float rs = 1.0f / sqrtf(wave_sum(s) * (1.0f / D) + NORM_EPS);
#pragma unroll
            for (int j = 0; j < 4; ++j) { const f32x4 o = v[j] * rs * gv[j]; u32x2 w; w.x = cvt_pk_bf16(o.x, o.y); w.y = cvt_pk_bf16(o.z, o.w); *(u32x2*)(XN + (size_t)m * D + 4 * lane + 256 * j) = w; }
        }
    }
    {
        float* cs = (float*)(ws + WS_CS);
        for (int i = bid * NTHREADS + tid; i < NTOK * 48; i += G * NTHREADS) {
            const int row = i / 48, j = i % 48;
            const float ex = (j < 32) ? -(float)j / 32.0f : -(float)(j - 32) / 16.0f;
            const float ang = (float)p.pos[row] * powf(10000.0f, ex);
            float sn, cc; sincosf(ang, &sn, &cc);
            cs[(size_t)row * 96 + j] = cc; cs[(size_t)row * 96 + 48 + j] = sn;
        }
    }
}

__device__ __forceinline__ void pool_phase(const Params& p, int bid, int G) {
    const int tid = threadIdx.x, lane = tid & 63, wave = __builtin_amdgcn_readfirstlane(tid >> 6);
    const int gw = bid * NWAVES + wave, NGW = G * NWAVES;
    const bf16_t* Pool = (const bf16_t*)(p.ws + WS_POOL); bf16_t* Mixed = (bf16_t*)(p.ws + WS_MIXED);
    const int w = 2 << (lane >> 4);
    for (int it = gw; it < NBATCH * 256; it += NGW) {
        const int b = it >> 8, tb = (it & 255) * 16;
        const bf16_t* P = Pool + (size_t)b * SEQ * 512 + 8 * lane;
        float sum[8];
#pragma unroll
        for (int q = 0; q < 8; ++q) sum[q] = 0.f;
        for (int d = 1; d < 16; ++d) if (d < w && tb - d >= 0) { float v[8]; ld8bf(P + (size_t)(tb - d) * 512, v);
#pragma unroll
            for (int q = 0; q < 8; ++q) sum[q] += v[q]; }
        for (int t = tb; t < tb + 16; ++t) {
            float cur[8]; ld8bf(P + (size_t)t * 512, cur);
#pragma unroll
            for (int q = 0; q < 8; ++q) sum[q] += cur[q];
            const float inv = 1.0f / (float)((t + 1 < w) ? t + 1 : w);
            float o[8];
#pragma unroll
            for (int q = 0; q < 8; ++q) o[q] = sum[q] * inv - cur[q];
            st8(Mixed + ((size_t)b * SEQ + t) * 512 + 8 * lane, o);
            if (t - w + 1 >= 0) { float old[8]; ld8bf(P + (size_t)(t - w + 1) * 512, old);
#pragma unroll
                for (int q = 0; q < 8; ++q) sum[q] -= old[q]; }
        }
    }
}

__device__ __forceinline__ int count_ge(const unsigned (&key)[64], int nj, unsigned mid) {
    int cnt = 0;
#pragma unroll
    for (int jb = 0; jb < 8; ++jb) if (jb * 8 < nj) {
#pragma unroll
        for (int q = 0; q < 8; ++q) cnt += __popcll(__ballot(key[jb * 8 + q] >= mid)); }
    return cnt;
}
__device__ __forceinline__ int lane_prefix(unsigned long long m) { return __builtin_amdgcn_mbcnt_hi((unsigned)(m >> 32), __builtin_amdgcn_mbcnt_lo((unsigned)m, 0u)); }

__device__ __forceinline__ void attn_unit(const Params& p, LAS unsigned char* lds, int b, int t0) {
    const int tid = threadIdx.x, lane = tid & 63, wave = __builtin_amdgcn_readfirstlane(tid >> 6);
    const bf16_t* Qb = (const bf16_t*)(p.ws + WS_Q); const bf16_t* Kb = (const bf16_t*)(p.ws + WS_K); const bf16_t* Vb = (const bf16_t*)(p.ws + WS_V);
    const bf16_t* Qi = (const bf16_t*)(p.ws + WS_QI); const bf16_t* Ki = (const bf16_t*)(p.ws + WS_KI); const float* Wi = (const float*)(p.ws + WS_WI);
    bf16_t* Attn = (bf16_t*)(p.ws + WS_ATTN);
    LAS float* SC = (LAS float*)lds;
    const int c = t0 >> 6, nj = c + 1, nk = 64 * nj, ntile = nk >> 5;
    const size_t tok0 = (size_t)b * SEQ + t0;
    {
        const int r = lane & 31, hh = lane >> 5;
        bf16x8 qa[4];
        const bf16_t* qp = Qi + (tok0 + (r >> 2)) * 256 + (r & 3) * 64 + 8 * hh;
#pragma unroll
        for (int ks = 0; ks < 4; ++ks) qa[ks] = *(const bf16x8*)(qp + 16 * ks);
        f32x4 wv[4];
#pragma unroll
        for (int g = 0; g < 4; ++g) wv[g] = *(const f32x4*)(Wi + (tok0 + 2 * g + hh) * 4);
        for (int kt = wave; kt < ntile; kt += NWAVES) {
            const bf16_t* kp = Ki + ((size_t)b * SEQ + kt * 32 + r) * 64 + 8 * hh;
            bf16x8 kb[4];
#pragma unroll
            for (int ks = 0; ks < 4; ++ks) kb[ks] = *(const bf16x8*)(kp + 16 * ks);
            f32x16 acc;
#pragma unroll
            for (int q = 0; q < 16; ++q) acc[q] = 0.f;
#pragma unroll
            for (int ks = 0; ks < 4; ++ks) acc = __builtin_amdgcn_mfma_f32_32x32x16_bf16(qa[ks], kb[ks], acc, 0, 0, 0);
#pragma unroll
            for (int g = 0; g < 4; ++g) {
                float s = fmaf(wv[g][0], fmaxf(acc[4 * g], 0.f), 0.0f);
                s = fmaf(wv[g][1], fmaxf(acc[4 * g + 1], 0.f), s); s = fmaf(wv[g][2], fmaxf(acc[4 * g + 2], 0.f), s); s = fmaf(wv[g][3], fmaxf(acc[4 * g + 3], 0.f), s);
                SC[(2 * g + hh) * 4096 + kt * 32 + r] = s;
            }
        }
    }
    __syncthreads();
    LAS float* row = SC + wave * 4096;
    unsigned key[64];
#pragma unroll
    for (int jb = 0; jb < 8; ++jb) {
#pragma unroll
        for (int q = 0; q < 8; ++q) key[jb * 8 + q] = 0u;
        if (jb * 8 < nj) {
#pragma unroll
            for (int q = 0; q < 8; ++q) { const int j = jb * 8 + q; const unsigned u = __float_as_uint(row[j * 64 + lane]); const unsigned kk = (u & 0x80000000u) ? ~u : (u | 0x80000000u); key[j] = (j < nj) ? kk : 0u; }
        }
    }
    unsigned hiSel = 1u, T = 0u; int rrem = 0;
    if (nk > 256) {
        unsigned km = 0u;
#pragma unroll
        for (int j = 0; j < 64; ++j) km = key[j] > km ? key[j] : km;
#pragma unroll
        for (int o = 1; o < 64; o <<= 1) { const unsigned t = (unsigned)__shfl_xor((int)km, o); km = t > km ? t : km; }
        unsigned lo = 0u, hi = km + 1u; int cnt_hi = 0; bool exact = false;
        while (hi - lo > 1u) {
            const unsigned mid = lo + ((hi - lo) >> 1);
            const int cnt = count_ge(key, nj, mid);
            if (cnt >= 256) { lo = mid; if (cnt == 256) { exact = true; break; } } else { hi = mid; cnt_hi = cnt; }
        }
        if (exact) { hiSel = lo; T = 0u; rrem = 0; } else { hiSel = hi; T = lo; rrem = 256 - cnt_hi; }
    }
    LDS_WAIT();
    LAS int* list = (LAS int*)row;
    int nsel = 0;
#pragma unroll
    for (int j = 0; j < 64; ++j) if ((j & ~7) < nj) {
        const bool eq = (key[j] == T) && (key[j] < hiSel);
        const unsigned long long eqm = __ballot(eq);
        const bool take = eq && (lane_prefix(eqm) < rrem);
        const int ne = __popcll(eqm); rrem = (ne < rrem) ? rrem - ne : 0;
        const bool sel = (key[j] >= hiSel) || take;
        const unsigned long long sm = __ballot(sel);
        if (sel) list[nsel + lane_prefix(sm)] = j * 64 + lane;
        nsel += __popcll(sm);
    }
    LDS_WAIT();
    const size_t tok = tok0 + wave;
    LAS float* Pm = row + 256;
    {
        const int cq = lane & 15, kq = lane >> 4;
        bf16x8 qb[4];
#pragma unroll
        for (int ks = 0; ks < 4; ++ks) { qb[ks] = (bf16x8){0, 0, 0, 0, 0, 0, 0, 0};
            if (cq < 8 && (ks >> 1) == (cq >> 2)) qb[ks] = *(const bf16x8*)(Qb + tok * 512 + cq * 64 + 32 * (ks & 1) + 8 * kq); }
        f32x4 sacc[16];
#pragma unroll
        for (int tg = 0; tg < 4; ++tg) {
            if (tg * 64 < nsel) {
#pragma unroll
                for (int tq = 0; tq < 4; ++tq) { const int tile = tg * 4 + tq;
                    const int ky = list[tile * 16 + cq];
                    const bf16_t* kp = Kb + ((size_t)b * SEQ + ky) * 128 + 8 * kq;
                    f32x4 a = (f32x4){0.f, 0.f, 0.f, 0.f};
#pragma unroll
                    for (int ks = 0; ks < 4; ++ks) a = __builtin_amdgcn_mfma_f32_16x16x32_bf16(*(const bf16x8*)(kp + 32 * ks), qb[ks], a, 0, 0, 0);
                    sacc[tile] = a; }
            } else {
#pragma unroll
                for (int tq = 0; tq < 4; ++tq) sacc[tg * 4 + tq] = (f32x4){-INFINITY, -INFINITY, -INFINITY, -INFINITY};
            }
        }
        float mx = -INFINITY;
#pragma unroll
        for (int t = 0; t < 16; ++t) mx = fmaxf(fmaxf(fmaxf(mx, sacc[t][0]), fmaxf(sacc[t][1], sacc[t][2])), sacc[t][3]);
        mx = fmaxf(mx, __shfl_xor(mx, 16)); mx = fmaxf(mx, __shfl_xor(mx, 32));
        float sm = 0.f;
#pragma unroll
        for (int t = 0; t < 16; ++t)
#pragma unroll
            for (int i = 0; i < 4; ++i) { const float e = __expf(sacc[t][i] - mx); sacc[t][i] = e; sm += e; }
        sm += __shfl_xor(sm, 16); sm += __shfl_xor(sm, 32);
        const float inv = 1.0f / sm;
        if (cq < 8) {
#pragma unroll
            for (int t = 0; t < 16; ++t) if (t * 16 < nsel) {
#pragma unroll
                for (int i = 0; i < 4; ++i) Pm[(t * 16 + 4 * kq + i) * 8 + cq] = sacc[t][i] * inv; }
        }
    }
    LDS_WAIT();
    {
        const int par = lane >> 5, l5 = lane & 31, kvh = l5 >> 4;
        float o[4][4];
#pragma unroll
        for (int h = 0; h < 4; ++h)
#pragma unroll
            for (int d = 0; d < 4; ++d) o[h][d] = 0.f;
        const bf16_t* vbase = Vb + (size_t)b * SEQ * 128 + 4 * l5;
        for (int sp = 0; sp < nsel / 2; sp += 4) {
            u32x2 vv[4]; f32x4 pp[4];
#pragma unroll
            for (int q = 0; q < 4; ++q) { const int slot = 2 * (sp + q) + par; const int ky = list[slot];
                vv[q] = *(const u32x2*)(vbase + (size_t)ky * 128); pp[q] = *(const LAS f32x4*)(Pm + slot * 8 + 4 * kvh); }
#pragma unroll
            for (int q = 0; q < 4; ++q) { const float v0 = bf_lo(vv[q].x), v1 = bf_hi(vv[q].x), v2 = bf_lo(vv[q].y), v3 = bf_hi(vv[q].y);
#pragma unroll
                for (int h = 0; h < 4; ++h) { o[h][0] += pp[q][h] * v0; o[h][1] += pp[q][h] * v1; o[h][2] += pp[q][h] * v2; o[h][3] += pp[q][h] * v3; } }
        }
#pragma unroll
        for (int hh = 0; hh < 2; ++hh) {
            float tot[4];
#pragma unroll
            for (int d = 0; d < 4; ++d) { float x = o[hh][d], y = o[2 + hh][d]; asm volatile("" : "+v"(x), "+v"(y));
                const float keep = par ? y : x, send = par ? x : y; tot[d] = keep + __shfl_xor(send, 32); }
            const float a0 = tot[0], a1 = tot[1], a2 = tot[2], a3 = tot[3];
            u32x2 w; w.x = cvt_pk_bf16(a0, a1); w.y = cvt_pk_bf16(a2, a3);
            *(u32x2*)(Attn + tok * 512 + (4 * kvh + 2 * par + hh) * 64 + 4 * (l5 & 15)) = w;
        }
    }
    __syncthreads();
}

__device__ __forceinline__ void attn_phase(const Params& p, LAS unsigned char* lds, int bid, int G) {
    for (int i = 0;; ++i) {
        int b, r;
        if (G == 256) { if (i >= 16) break; b = bid & 7; const int y = bid >> 3; r = i * 32 + ((i & 1) ? 31 - y : y); }
        else { const int u = bid + i * G; if (u >= NBATCH * 512) break; b = u & 7; r = u >> 3; }
        const int c = 63 - (r >> 3), sx = r & 7;
        attn_unit(p, lds, b, 64 * c + 8 * sx);
    }
}

constexpr int T_TSTART = 0, T_PADSTART = 40, T_BLOCKBASE = 80, T_NE = 112, T_WB = 144  , T_PART = 400  ;
__device__ __forceinline__ void router_phase(const Params& p, LAS unsigned char* lds, int bid, int G) {
    const int tid = threadIdx.x, lane = tid & 63, wave = __builtin_amdgcn_readfirstlane(tid >> 6);
    constexpr int WP = 1028;
    LAS float* WrT = (LAS float*)lds;
    for (int i = tid; i < 1024 * 32 / 4; i += NTHREADS) { const f32x4 v = *(const f32x4*)(p.router_w + 4 * (size_t)i); const int c = i >> 3, e0 = 4 * (i & 7); const float g = p.norm2_g[c];
        WrT[(e0 + 0) * WP + c] = v[0] * g; WrT[(e0 + 1) * WP + c] = v[1] * g; WrT[(e0 + 2) * WP + c] = v[2] * g; WrT[(e0 + 3) * WP + c] = v[3] * g; }
    __syncthreads();
    LAS int* tbl = (LAS int*)(lds + MISC_OFF);
    const float* X1 = p.out; bf16_t* H2 = (bf16_t*)(p.ws + WS_H2);
    int* rec_e = (int*)(p.ws + WS_REC_E); int* rec_pos = (int*)(p.ws + WS_REC_POS); float* rec_gate = (float*)(p.ws + WS_REC_GATE);
    const int ex = lane & 15, kq = lane >> 4;
    const size_t tokw = (size_t)bid * 128 + wave * 16;
    f32x4 acc0 = (f32x4){0.f, 0.f, 0.f, 0.f}, acc1 = acc0; float ssq = 0.f;
    {
        const float* xr = X1 + (tokw + ex) * D + 4 * kq;
        const LAS float* w0 = WrT + ex * WP + 4 * kq; const LAS float* w1 = w0 + 16 * WP;
#pragma unroll 4
        for (int q = 0; q < 64; ++q) {
            const f32x4 a = *(const f32x4*)(xr + 16 * q); const f32x4 b0 = *(const LAS f32x4*)(w0 + 16 * q), b1 = *(const LAS f32x4*)(w1 + 16 * q);
            ssq += (a.x * a.x + a.y * a.y) + (a.z * a.z + a.w * a.w);
#pragma unroll
            for (int k = 0; k < 4; ++k) { acc0 = __builtin_amdgcn_mfma_f32_16x16x4f32(a[k], b0[k], acc0, 0, 0, 0); acc1 = __builtin_amdgcn_mfma_f32_16x16x4f32(a[k], b1[k], acc1, 0, 0, 0); }
        }
    }
    ssq += __shfl_xor(ssq, 16); ssq += __shfl_xor(ssq, 32);
    const float rs = 1.0f / sqrtf(ssq * (1.0f / D) + NORM_EPS);
    const float br0 = p.router_b[ex], br1 = p.router_b[ex + 16];
    float lg0[4], lg1[4];
#pragma unroll
    for (int i = 0; i < 4; ++i) { const float r = __shfl(rs, 4 * kq + i); lg0[i] = acc0[i] * r + br0; lg1[i] = acc1[i] * r + br1; }
    int ti[4][4]; float tv[4][4];
#pragma unroll
    for (int r = 0; r < 4; ++r)
#pragma unroll
        for (int i = 0; i < 4; ++i) {
            float bv = (lg0[i] >= lg1[i]) ? lg0[i] : lg1[i]; int bi = (lg0[i] >= lg1[i]) ? ex : ex + 16;
#pragma unroll
            for (int m = 1; m < 16; m <<= 1) { const float ov = __shfl_xor(bv, m); const int oi = __shfl_xor(bi, m); const bool better = (ov > bv) || (ov == bv && oi < bi); bv = better ? ov : bv; bi = better ? oi : bi; }
            tv[i][r] = bv; ti[i][r] = bi;
            if (bi == ex) lg0[i] = -INFINITY; if (bi == ex + 16) lg1[i] = -INFINITY;
        }
    unsigned M[4];
#pragma unroll
    for (int i = 0; i < 4; ++i) M[i] = (1u << ti[i][0]) | (1u << ti[i][1]) | (1u << ti[i][2]) | (1u << ti[i][3]);
    unsigned Mall[16];
#pragma unroll
    for (int t = 0; t < 16; ++t) Mall[t] = (unsigned)__builtin_amdgcn_readlane((int)M[t & 3], 16 * (t >> 2));
#pragma unroll
    for (int i = 0; i < 4; ++i) {
        const int t = 4 * kq + i;
        const float e1 = __expf(tv[i][1] - tv[i][0]), e2 = __expf(tv[i][2] - tv[i][0]), e3 = __expf(tv[i][3] - tv[i][0]); const float inv = 1.0f / (1.0f + e1 + e2 + e3);
#pragma unroll
        for (int r = 0; r < 4; ++r) {
            const int x = ti[i][r]; int pos = 0;
#pragma unroll
            for (int tp = 0; tp < 16; ++tp) pos += (tp < t) ? (int)((Mall[tp] >> x) & 1u) : 0;
            const float gt = (r == 0 ? 1.0f : (r == 1 ? e1 : (r == 2 ? e2 : e3))) * inv;
            if (ex == r) { rec_e[(tokw + t) * 4 + r] = x; rec_pos[(tokw + t) * 4 + r] = pos; rec_gate[(tokw + t) * 4 + r] = gt; }
        }
    }
    { int cnt = 0;
#pragma unroll
        for (int t = 0; t < 16; ++t) cnt += (int)((Mall[t] >> (lane & 31)) & 1u);
        if (lane < 32) tbl[T_WB + wave * 32 + lane] = cnt; }
    {
        f32x4 g2[4];
#pragma unroll
        for (int j = 0; j < 4; ++j) g2[j] = *(const f32x4*)(p.norm2_g + 4 * lane + 256 * j);
#pragma unroll 4
        for (int t = 0; t < 16; ++t) {
            const float r = __shfl(rs, t);
            const f32x4* xr = (const f32x4*)(X1 + (tokw + t) * D) + lane;
#pragma unroll
            for (int j = 0; j < 4; ++j) { const f32x4 h = xr[64 * j] * r * g2[j]; u32x2 w; w.x = cvt_pk_bf16(h.x, h.y); w.y = cvt_pk_bf16(h.z, h.w); *(u32x2*)(H2 + (tokw + t) * D + 4 * lane + 256 * j) = w; }
        }
    }
    __syncthreads();
    if (tid < 256) ((int*)(p.ws + WS_WCNT))[(size_t)bid * 256 + tid] = tbl[T_WB + tid];
    if (tid < 32) { int sm = 0;
#pragma unroll
        for (int w = 0; w < 8; ++w) sm += tbl[T_WB + w * 32 + tid];
        ((int*)(p.ws + WS_BCNT))[bid * 32 + tid] = sm; }
    __syncthreads();
}

__device__ __forceinline__ void moe_tables(const Params& p, LAS int* tbl, int bid) {
    const int tid = threadIdx.x; const int* bcnt = (const int*)(p.ws + WS_BCNT);
    { const int e = tid & 31, part = tid >> 5; int all = 0, below = 0;
        for (int k = 0; k < 16; ++k) { const int blk = part * 16 + k; const int v = bcnt[blk * 32 + e]; all += v; below += (blk < bid) ? v : 0; }
        tbl[T_PART + part * 32 + e] = all; tbl[T_PART + 512 + part * 32 + e] = below; }
    __syncthreads();
    if (tid < 32) { int all = 0, below = 0;
        for (int q = 0; q < 16; ++q) { all += tbl[T_PART + q * 32 + tid]; below += tbl[T_PART + 512 + q * 32 + tid]; }
        tbl[T_NE + tid] = all; tbl[T_BLOCKBASE + tid] = below; }
    __syncthreads();
    if (tid == 0) { int ps = 0, ts = 0;
        for (int e = 0; e < NEXP; ++e) { tbl[T_PADSTART + e] = ps; tbl[T_TSTART + e] = ts; const int nt = (tbl[T_NE + e] + 255) >> 8; ps += nt * 256; ts += nt; }
        tbl[T_PADSTART + NEXP] = ps; tbl[T_TSTART + NEXP] = ts; }
    __syncthreads();
}

__device__ __forceinline__ void permute_phase(const Params& p, LAS unsigned char* lds, int bid, int G) {
    const int tid = threadIdx.x, lane = tid & 63, wave = __builtin_amdgcn_readfirstlane(tid >> 6);
    LAS int* tbl = (LAS int*)(lds + MISC_OFF);
    moe_tables(p, tbl, bid);
    if (tid < 256) { const int w = tid >> 5, e = tid & 31; int s = 0; const int* wc = (const int*)(p.ws + WS_WCNT) + (size_t)bid * 256;
        for (int q = 0; q < 8; ++q) s += (q < w) ? wc[q * 32 + e] : 0;
        tbl[T_WB + tid] = s; }
    __syncthreads();
    const int* rec_e = (const int*)(p.ws + WS_REC_E); const int* rec_pos = (const int*)(p.ws + WS_REC_POS); const float* rec_gate = (const float*)(p.ws + WS_REC_GATE);
    int* slot_of = (int*)(p.ws + WS_SLOT_OF); float* slot_gate = (float*)(p.ws + WS_SLOT_GATE);
    const bf16_t* H2 = (const bf16_t*)(p.ws + WS_H2); bf16_t* H2S = (bf16_t*)(p.ws + WS_H2S);
    for (int idx = wave; idx < 512; idx += NWAVES) {
        const int tl = idx >> 2, r = idx & 3; const size_t tk = (size_t)bid * 128 + tl;
        const int e = rec_e[tk * 4 + r], pw = rec_pos[tk * 4 + r];
        const int slot = tbl[T_PADSTART + e] + tbl[T_BLOCKBASE + e] + tbl[T_WB + (tl >> 4) * 32 + e] + pw;
        if (lane == 0) { slot_of[tk * 4 + r] = slot; slot_gate[slot] = rec_gate[tk * 4 + r]; }
        const u32x4 v0 = *(const u32x4*)(H2 + tk * D + 8 * lane), v1 = *(const u32x4*)(H2 + tk * D + 512 + 8 * lane);
        *(u32x4*)(H2S + (size_t)slot * D + 8 * lane) = v0; *(u32x4*)(H2S + (size_t)slot * D + 512 + 8 * lane) = v1;
    }
}

__device__ __forceinline__ void combine_phase(const Params& p, int bid, int G) {
    const int tid = threadIdx.x, lane = tid & 63, wave = __builtin_amdgcn_readfirstlane(tid >> 6);
    const int gw = bid * NWAVES + wave, NGW = G * NWAVES;
    const int* slot_of = (const int*)(p.ws + WS_SLOT_OF); const bf16_t* Y = (const bf16_t*)(p.ws + WS_Y);
    for (int tk = gw; tk < NTOK; tk += NGW) {
        int sl[4];
#pragma unroll
        for (int r = 0; r < 4; ++r) sl[r] = slot_of[(size_t)tk * 4 + r];
        float* orow = p.out + (size_t)tk * D;
#pragma unroll
        for (int j = 0; j < 4; ++j) { f32x4 a = *(const f32x4*)(orow + 4 * lane + 256 * j);
#pragma unroll
            for (int r = 0; r < 4; ++r) { const u32x2 y = *(const u32x2*)(Y + (size_t)sl[r] * D + 4 * lane + 256 * j); a.x += bf_lo(y.x); a.y += bf_hi(y.x); a.z += bf_lo(y.y); a.w += bf_hi(y.y); }
            *(f32x4*)(orow + 4 * lane + 256 * j) = a; }
    }
}

constexpr int NPH = 11;
__global__ void __launch_bounds__(NTHREADS, 2) mega(Params p) {
    extern __shared__ __attribute__((aligned(16))) unsigned char lds_raw[];
    LAS unsigned char* lds = (LAS unsigned char*)lds_raw;
    cg::grid_group grid = cg::this_grid();
    const int bid = blockIdx.x, G = gridDim.x;
    unsigned char* ws = p.ws;
#ifndef PH_MASK
#define PH_MASK 0x7ff
#endif
#define IN(k) (((PH_MASK >> (k)) & 1) && p.ph_lo <= (k) && (k) < p.ph_hi)
#define SEAM(k) do { if (IN(k) && IN((k) + 1)) grid.sync(); } while (0)
    if (IN(0)) phase0(p, lds, bid, G);
    SEAM(0);
    if (IN(1)) {
        pg8::Gemm g{(const bf16_t*)(ws + WS_XN), (const bf16_t*)(ws + WS_WIN), NTOK, INWP, D}; pg8::StaticOrder S; S.init(NTOK, INWP, G, bid);
        EpiInProj E{(bf16_t*)(ws + WS_Q), (bf16_t*)(ws + WS_K), (bf16_t*)(ws + WS_V), (bf16_t*)(ws + WS_QI), (bf16_t*)(ws + WS_KI), (bf16_t*)(ws + WS_POOL), (bf16_t*)(ws + WS_GA), (bf16_t*)(ws + WS_GP),
                    (float*)(ws + WS_WI), (const float*)(ws + WS_CS), p.q_norm_g, p.k_norm_g, p.idx_g, p.idx_b};
        pg8::gemm_phase(lds, g, S, E);
    }
    SEAM(1);
    if (IN(2)) { pool_phase(p, bid, G); attn_phase(p, lds, bid, G); }
    SEAM(2);
    if (IN(3)) {
        pg8::Gemm g{(const bf16_t*)(ws + WS_ATTN), (const bf16_t*)(ws + WS_WA), NTOK, D, 512}; pg8::StaticOrder S; S.init(NTOK, D, G, bid);
        EpiGateMul E{(const bf16_t*)(ws + WS_GA), nullptr, (bf16_t*)(ws + WS_TA)};
        pg8::gemm_phase(lds, g, S, E);
    }
    SEAM(3);
    if (IN(4)) {
        pg8::Gemm g{(const bf16_t*)(ws + WS_MIXED), (const bf16_t*)(ws + WS_WEFF), NTOK, D, 512}; pg8::StaticOrder S; S.init(NTOK, D, G, bid);
        EpiGateMul E{(const bf16_t*)(ws + WS_GP), (const bf16_t*)(ws + WS_TA), (bf16_t*)(ws + WS_MERGED)};
        pg8::gemm_phase(lds, g, S, E);
    }
    SEAM(4);
    if (IN(5)) {
        pg8::Gemm g{(const bf16_t*)(ws + WS_MERGED), (const bf16_t*)(ws + WS_WOUT), NTOK, D, D}; pg8::StaticOrder S; S.init(NTOK, D, G, bid);
        EpiResid E{p.x, p.out};
        pg8::gemm_phase(lds, g, S, E);
    }
    SEAM(5);
    if (IN(6)) router_phase(p, lds, bid, G);
    SEAM(6);
    if (IN(7)) permute_phase(p, lds, bid, G);
    SEAM(7);
    if (IN(8)) {
        LAS int* tbl = (LAS int*)(lds + MISC_OFF); moe_tables(p, tbl, bid);
        pg8::Gemm g{(const bf16_t*)(ws + WS_H2S), (const bf16_t*)(ws + WS_WGU), NSLOT, NEXP * 2048, D}; pg8::MoeOrder<8> S{tbl + T_TSTART, G, bid};
        EpiGateUp E{p.b_gu, (bf16_t*)(ws + WS_ACT)};
        pg8::gemm_phase(lds, g, S, E);
    }
    SEAM(8);
    if (IN(9)) {
        LAS int* tbl = (LAS int*)(lds + MISC_OFF); moe_tables(p, tbl, bid);
        pg8::Gemm g{(const bf16_t*)(ws + WS_ACT), (const bf16_t*)(ws + WS_WD), NSLOT, NEXP * 1024, D}; pg8::MoeOrder<4> S{tbl + T_TSTART, G, bid};
        EpiDown E{p.b_d, (const float*)(ws + WS_SLOT_GATE), (bf16_t*)(ws + WS_Y)};
        pg8::gemm_phase(lds, g, S, E);
    }
    SEAM(9);
    if (IN(10)) combine_phase(p, bid, G);
#undef IN
#undef SEAM
}

extern "C" void kernel_launch(void* const* d_in, const int* in_sizes, int n_in, void* d_out, int out_size, void* d_ws, size_t ws_size, hipStream_t stream) {
    static int grid = 0;
    if (grid == 0) {
        if (n_in != 20 || out_size != NTOK * D || ws_size < WS_END) { fprintf(stderr, "kernel_launch: unexpected shapes: n_in %d out %d ws %zu (need %zu)\n", n_in, out_size, ws_size, (size_t)WS_END); grid = -1; return; }
        int dev = 0, cus = 0, per_cu = 0;
        hipGetDevice(&dev); hipDeviceGetAttribute(&cus, hipDeviceAttributeMultiprocessorCount, dev);
        if (hipFuncSetAttribute((const void*)mega, hipFuncAttributeMaxDynamicSharedMemorySize, LDS_BYTES) != hipSuccess) { fprintf(stderr, "kernel_launch: hipFuncSetAttribute failed\n"); grid = -1; return; }
        if (hipOccupancyMaxActiveBlocksPerMultiprocessor(&per_cu, (const void*)mega, NTHREADS, LDS_BYTES) != hipSuccess || per_cu < 1) { fprintf(stderr, "kernel_launch: occupancy query says %d blocks per CU\n", per_cu); per_cu = 1; }
        (void)hipGetLastError();
        grid = cus;
        if (grid != 256) fprintf(stderr, "kernel_launch: %d CUs; the router / permute phases assume a 256-workgroup grid\n", grid);
    }
    if (grid < 0) return;
    Params p{};
    p.x = (const float*)d_in[0]; p.pos = (const int*)d_in[1]; p.norm1_g = (const float*)d_in[2]; p.w_in = (const float*)d_in[3]; p.q_norm_g = (const float*)d_in[4];
    p.k_norm_g = (const float*)d_in[5]; p.idx_g = (const float*)d_in[6]; p.idx_b = (const float*)d_in[7]; p.w_a = (const float*)d_in[8]; p.pool_mix = (const float*)d_in[9];
    p.pool_scale = (const float*)d_in[10]; p.w_b = (const float*)d_in[11]; p.w_out = (const float*)d_in[12]; p.norm2_g = (const float*)d_in[13]; p.router_w = (const float*)d_in[14];
    p.router_b = (const float*)d_in[15]; p.w_gu = (const float*)d_in[16]; p.b_gu = (const float*)d_in[17]; p.w_d = (const float*)d_in[18]; p.b_d = (const float*)d_in[19];
    p.out = (float*)d_out; p.ws = (unsigned char*)d_ws;
#if MK_MODE == 0
    p.ph_lo = 0; p.ph_hi = NPH;
    void* args[] = {&p};
    hipError_t e = hipLaunchCooperativeKernel((const void*)mega, dim3(grid), dim3(NTHREADS), args, LDS_BYTES, stream);
    if (e != hipSuccess) fprintf(stderr, "kernel_launch: cooperative launch failed: %s (grid %d)\n", hipGetErrorString(e), grid);
#else
    for (int k = 0; k < NPH; ++k) { p.ph_lo = k; p.ph_hi = k + 1; hipLaunchKernelGGL(mega, dim3(grid), dim3(NTHREADS), LDS_BYTES, stream, p); }
#endif
}
```

```cpp
#include <hip/hip_runtime.h>
#include <hip/hip_cooperative_groups.h>
#include <cstdio>
#include <cstdint>
#include <cmath>
namespace cg = cooperative_groups;

#ifndef MK_MODE
#define MK_MODE 0
#endif

#define LAS __attribute__((address_space(3)))
typedef unsigned short bf16_t;
typedef short bf16x8 __attribute__((ext_vector_type(8)));
typedef float f32x2 __attribute__((ext_vector_type(2)));
typedef float f32x4 __attribute__((ext_vector_type(4)));
typedef float f32x16 __attribute__((ext_vector_type(16)));
typedef unsigned u32x2 __attribute__((ext_vector_type(2)));
typedef unsigned u32x4 __attribute__((ext_vector_type(4)));

constexpr int D = 1024, NBATCH = 8, SEQ = 4096, NTOK = NBATCH * SEQ;
constexpr int NEXP = 32, TOPK = 4;
constexpr int INW = 3652, INWP = 3840;
constexpr int NSLOT = 139264;
constexpr float NORM_EPS = 1e-6f;
constexpr int NWAVES = 8, NTHREADS = 512;
constexpr int LDS_BYTES = 147456;
constexpr int RING_BYTES = 131072;
constexpr int MISC_OFF = 135168;

constexpr size_t MiB = 1u << 20;
constexpr size_t WS_CTL = 0;
constexpr size_t WS_BCNT = 64 * 1024;
constexpr size_t WS_WCNT = 128 * 1024;
constexpr size_t WS_CS = 2 * MiB;
constexpr size_t WS_WIN = 16 * MiB;
constexpr size_t WS_WA = 24 * MiB;
constexpr size_t WS_WEFF = 25 * MiB;
constexpr size_t WS_WOUT = 26 * MiB;
constexpr size_t WS_WGU = 28 * MiB;
constexpr size_t WS_WD = 156 * MiB;
constexpr size_t WS_REC_E = 220 * MiB;
constexpr size_t WS_REC_POS = 221 * MiB;
constexpr size_t WS_REC_GATE = 222 * MiB;
constexpr size_t WS_SLOT_OF = 223 * MiB;
constexpr size_t WS_SLOT_GATE = 223 * MiB + 512 * 1024;
constexpr size_t WS_XN = 226 * MiB;
constexpr size_t WS_Q = 290 * MiB;
constexpr size_t WS_K = 322 * MiB;
constexpr size_t WS_VT = 330 * MiB;
constexpr size_t WS_QI = 338 * MiB;
constexpr size_t WS_KI = 354 * MiB;
constexpr size_t WS_WI = 358 * MiB;
constexpr size_t WS_POOL = 360 * MiB;
constexpr size_t WS_GA = 392 * MiB;
constexpr size_t WS_GP = 456 * MiB;
constexpr size_t WS_ATTN = 520 * MiB;
constexpr size_t WS_MIXED = 552 * MiB;
constexpr size_t WS_TA = 584 * MiB;
constexpr size_t WS_MASK = WS_TA;
constexpr size_t WS_MERGED = 648 * MiB;
constexpr size_t WS_H2 = WS_XN;
constexpr size_t WS_H2S = 290 * MiB;
constexpr size_t WS_Y = WS_H2S;
constexpr size_t WS_ACT = 562 * MiB;
constexpr size_t WS_END = 834 * MiB;
static_assert(WS_SLOT_GATE + (size_t)NSLOT * 4 <= WS_XN, "ws map");

__device__ __forceinline__ unsigned cvt_pk_bf16(float lo, float hi) { unsigned r; asm volatile("v_cvt_pk_bf16_f32 %0, %1, %2" : "=v"(r) : "v"(lo), "v"(hi)); return r; }
__device__ __forceinline__ float bf_lo(unsigned w) { return __uint_as_float(w << 16); }
__device__ __forceinline__ float bf_hi(unsigned w) { return __uint_as_float(w & 0xffff0000u); }
__device__ __forceinline__ float wave_sum(float v) {
#pragma unroll
    for (int o = 1; o < 64; o <<= 1) v += __shfl_xor(v, o);
    return v;
}
__device__ __forceinline__ float sigmoidf_(float x) { return 1.0f / (1.0f + __expf(-x)); }
#define LDS_WAIT() asm volatile("s_waitcnt lgkmcnt(0)" ::: "memory")

__host__ __device__ __forceinline__ int idx_bj_j(int d, int& bj) {
    int j;
    if (d < 16) { bj = 0; j = d; } else if (d < 32) { bj = 1; j = d - 16; } else if (d < 48) { bj = 0; j = d - 16; } else { bj = 1; j = d - 32; }
    return j;
}
__host__ __device__ __forceinline__ int win_phys(int n) {
    if (n < 512) { const int h = n >> 6, d = n & 63; return 256 * (h >> 2) + 128 * (d >> 5) + 32 * (h & 3) + (d & 31); }
    if (n < 768) { const int h = (n - 512) >> 6, d = n & 63; return 512 + 128 * (d >> 5) + 32 * h + (d & 31); }
    if (n < 1024) { const int h = (n - 768) >> 6, d = n & 63; int bj; const int j = idx_bj_j(d, bj); return 768 + 128 * bj + 32 * h + j; }
    if (n < 1088) { const int d = n - 1024; int bj; const int j = idx_bj_j(d, bj); return 1024 + 128 * bj + j; }
    if (n < 1092) return 1024 + 32 + (n - 1088);
    if (n < 1604) return 1280 + (n - 1092);
    if (n < 2628) return 1792 + (n - 1604);
    return 2816 + (n - 2628);
}

namespace pg8 {
constexpr int BM = 256, BK = 64, HALF = 128, HTB = HALF * BK * 2, STAGE_BYTES = 8 * HTB, NXCD = 8, WGM = 8;
__host__ __device__ __forceinline__ int lds_byte(int r, int c) { const int st = (r >> 4) * 2 + (c >> 5), rr = r & 15, cc = c & 31, ob = rr * 64 + cc * 2; return st * 1024 + (ob ^ (((ob >> 9) & 1) << 5)); }
__host__ __device__ __forceinline__ void stage_rc(int b, int& R, int& C) { const int st = b / 1024, sb = b % 1024, swz = sb ^ (((sb >> 9) & 1) << 5); R = (st >> 1) * 16 + swz / 64; C = (st & 1) * 32 + (swz % 64) / 2; }
__host__ __device__ __forceinline__ int perm32(int rho) { const int n = rho >> 4, i = rho & 15; return 8 * (i >> 2) + 4 * n + (i & 3); }

struct Unit { int pm, pn; };
struct Gemm { const bf16_t* A; const bf16_t* Bt; int M, N, K; };

struct StaticOrder {
    int nM, nN, nwg, G, c;
    __device__ void init(int M, int N, int G_, int c_) { nM = M / BM; nN = N / BM; nwg = nM * nN; G = G_; c = c_; }
    __device__ bool next(int i, Unit& u) const {
        const long L = (long)i * G + c; if (L >= nwg) return false;
        int wgid = (int)L; { const int q = nwg / NXCD, r = nwg % NXCD, xcd = wgid % NXCD, off = wgid / NXCD; wgid = (xcd < r ? xcd * (q + 1) : r * (q + 1) + (xcd - r) * q) + off; }
        const int nig = WGM * nN, gid = wgid / nig, fm = gid * WGM, gsz = (nM - fm) < WGM ? (nM - fm) : WGM;
        u.pm = fm + ((wgid % nig) % gsz); u.pn = (wgid % nig) / gsz; return true;
    }
};
template <int NPN> struct MoeOrder {
    const LAS int* tstart; int G, c;
    __device__ bool next(int i, Unit& u) const {
        const int L = i * G + c; const int ntile = tstart[NEXP];
        if (L >= ntile * NPN) return false;
        const int ti = L / NPN, pn = L % NPN; int e = 0;
#pragma unroll
        for (int k = 1; k < NEXP; ++k) e += (tstart[k] <= ti) ? 1 : 0;
        u.pm = ti; u.pn = e * NPN + pn; return true;
    }
};

template <class Epi, class Sched>
__device__ __forceinline__ void gemm_phase(LAS unsigned char* lds, const Gemm g, const Sched& S, const Epi& E) {
    const int tid = threadIdx.x, wid = __builtin_amdgcn_readfirstlane(tid >> 6), lane = tid & 63, wr = wid >> 2, wc = wid & 3, fr = lane & 15, fq = lane >> 4;
    const int K = g.K, nt = K / BK;
    unsigned voffA[2], voffB[2];
#pragma unroll
    for (int i = 0; i < 2; ++i) { int R, C; stage_rc(tid * 16 + i * 8192, R, C); const int Rb = (R & ~31) + perm32(R & 31);
        voffA[i] = (unsigned)(R * K + C) * 2u; voffB[i] = (unsigned)(Rb * K + C) * 2u; }
    const size_t kstep = (size_t)(BK * 2);
    const size_t hstep = (size_t)HALF * K * 2;
    const size_t tstep = 2 * hstep;
    const unsigned ldsw = (unsigned)wid * 1024u;
    const int aoff = lds_byte(wr * 64 + fr, fq * 8), boff = lds_byte(wc * 32 + fr, fq * 8);
#define PG8_SA(b, h) (((b) * 2 + (h)) * HTB)
#define PG8_SB(b, h) ((4 + (b) * 2 + (h)) * HTB)
#define PG8_STAGE(bufoff, gbase, voff) do { _Pragma("unroll") for (int _i = 0; _i < 2; ++_i) \
        __builtin_amdgcn_global_load_lds((const unsigned*)((const char*)(gbase) + (voff)[_i]), (LAS unsigned*)(lds + (bufoff) + ldsw + _i * 8192), 16, 0, 0); } while (0)
#define PG8_LDA(dst, b, h) do { _Pragma("unroll") for (int m = 0; m < 4; ++m) _Pragma("unroll") for (int k = 0; k < 2; ++k) dst[m][k] = *(const LAS bf16x8*)(lds + PG8_SA(b, h) + aoff + m * 2048 + k * 1024); } while (0)
#define PG8_LDB(dst, b, h) do { _Pragma("unroll") for (int n = 0; n < 2; ++n) _Pragma("unroll") for (int k = 0; k < 2; ++k) dst[n][k] = *(const LAS bf16x8*)(lds + PG8_SB(b, h) + boff + n * 2048 + k * 1024); } while (0)
#define PG8_MMA(ai, bj, At, Bt) do { __builtin_amdgcn_s_setprio(1); _Pragma("unroll") for (int m = 0; m < 4; ++m) _Pragma("unroll") for (int n = 0; n < 2; ++n) _Pragma("unroll") for (int k = 0; k < 2; ++k) \
        acc[ai][bj][m][n] = __builtin_amdgcn_mfma_f32_16x16x32_bf16(Bt[n][k], At[m][k], acc[ai][bj][m][n], 0, 0, 0); __builtin_amdgcn_s_setprio(0); } while (0)
#define PG8_WAIT_V(n) asm volatile("s_waitcnt vmcnt(" #n ")" ::: "memory")
#define PG8_WAIT_L(n) asm volatile("s_waitcnt lgkmcnt(" #n ")" ::: "memory")
#define PG8_BAR __builtin_amdgcn_s_barrier()
#define PG8_SCHED __builtin_amdgcn_sched_barrier(0)
    Unit cur, nxt; int ui = 0;
    if (!S.next(0, cur)) return;
    f32x4 acc[2][2][4][2];
#pragma unroll
    for (int a = 0; a < 2; ++a)
#pragma unroll
        for (int b = 0; b < 2; ++b)
#pragma unroll
            for (int m = 0; m < 4; ++m)
#pragma unroll
                for (int n = 0; n < 2; ++n) acc[a][b][m][n] = (f32x4){0.f, 0.f, 0.f, 0.f};
    bf16x8 At[4][2], B0[2][2], B1[2][2];
    const char* cA = (const char*)g.A + (size_t)cur.pm * tstep; const char* cB = (const char*)g.Bt + (size_t)cur.pn * tstep;
    PG8_STAGE(PG8_SB(0, 0), cB, voffB); PG8_STAGE(PG8_SB(0, 1), cB + hstep, voffB); PG8_STAGE(PG8_SA(0, 0), cA, voffA); PG8_STAGE(PG8_SA(0, 1), cA + hstep, voffA);
    if (wr == 1) PG8_BAR;
    PG8_WAIT_V(2); PG8_BAR;
    PG8_STAGE(PG8_SB(1, 0), cB + kstep, voffB); PG8_STAGE(PG8_SA(1, 0), cA + kstep, voffA); PG8_STAGE(PG8_SB(1, 1), cB + hstep + kstep, voffB);
    PG8_WAIT_V(6); PG8_BAR;
    for (;;) {
        const bool has_next = S.next(ui + 1, nxt);
        const char* nA = has_next ? (const char*)g.A + (size_t)nxt.pm * tstep : cA; const char* nB = has_next ? (const char*)g.Bt + (size_t)nxt.pn * tstep : cB;
        for (int t = 0; t < nt; t += 2) {
            const bool last = (t == nt - 2);
            const char* a1 = cA + (size_t)(t + 1) * kstep;
            const char* a2 = last ? nA : cA + (size_t)(t + 2) * kstep; const char* b2 = last ? nB : cB + (size_t)(t + 2) * kstep;
            const char* a3 = a2 + kstep; const char* b3 = b2 + kstep;
            PG8_LDB(B0, 0, 0); PG8_LDB(B1, 0, 1); PG8_SCHED; PG8_LDA(At, 0, 0); PG8_STAGE(PG8_SA(1, 1), a1 + hstep, voffA);
            PG8_WAIT_V(8); PG8_WAIT_L(0); PG8_BAR; PG8_MMA(0, 0, At, B0); PG8_MMA(0, 1, At, B1); PG8_BAR; PG8_SCHED;
            PG8_LDA(At, 0, 1); PG8_STAGE(PG8_SB(0, 0), b2, voffB); PG8_STAGE(PG8_SB(0, 1), b2 + hstep, voffB); PG8_STAGE(PG8_SA(0, 0), a2, voffA);
            PG8_WAIT_V(8); PG8_WAIT_L(0); PG8_BAR; PG8_MMA(1, 0, At, B0); PG8_MMA(1, 1, At, B1); PG8_BAR; PG8_SCHED;
            PG8_LDB(B0, 1, 0); PG8_LDB(B1, 1, 1); PG8_SCHED; PG8_LDA(At, 1, 0); PG8_STAGE(PG8_SA(0, 1), a2 + hstep, voffA);
            PG8_WAIT_V(8); PG8_WAIT_L(0); PG8_BAR; PG8_MMA(0, 0, At, B0); PG8_MMA(0, 1, At, B1); PG8_BAR; PG8_SCHED;
            PG8_LDA(At, 1, 1); PG8_STAGE(PG8_SB(1, 0), b3, voffB); PG8_STAGE(PG8_SB(1, 1), b3 + hstep, voffB); PG8_STAGE(PG8_SA(1, 0), a3, voffA);
            PG8_WAIT_V(8); PG8_WAIT_L(0); PG8_BAR; PG8_MMA(1, 0, At, B0); PG8_MMA(1, 1, At, B1); PG8_BAR; PG8_SCHED;
        }
        if (wr == 0) PG8_BAR;
        E(acc, cur, wr, wc, fr, fq);
        if (!has_next) break;
#pragma unroll
        for (int a = 0; a < 2; ++a)
#pragma unroll
            for (int b = 0; b < 2; ++b)
#pragma unroll
                for (int m = 0; m < 4; ++m)
#pragma unroll
                    for (int n = 0; n < 2; ++n) acc[a][b][m][n] = (f32x4){0.f, 0.f, 0.f, 0.f};
        cur = nxt; cA = nA; cB = nB; ++ui;
        if (wr == 1) PG8_BAR;
    }
    PG8_WAIT_V(0);
    PG8_BAR;
#undef PG8_SA
#undef PG8_SB
#undef PG8_STAGE
#undef PG8_LDA
#undef PG8_LDB
#undef PG8_MMA
#undef PG8_WAIT_V
#undef PG8_WAIT_L
#undef PG8_BAR
#undef PG8_SCHED
}
}

struct Params {
    const float* x; const int* pos; const float* norm1_g; const float* w_in; const float* q_norm_g; const float* k_norm_g;
    const float* idx_g; const float* idx_b; const float* w_a; const float* pool_mix; const float* pool_scale; const float* w_b;
    const float* w_out; const float* norm2_g; const float* router_w; const float* router_b; const float* w_gu; const float* b_gu;
    const float* w_d; const float* b_d;
    float* out; unsigned char* ws; int ph_lo, ph_hi;
};

using pg8::Unit; using pg8::HALF;
__device__ __forceinline__ void st8(bf16_t* p, const float (&v)[8]) {
    u32x4 w; w.x = cvt_pk_bf16(v[0], v[1]); w.y = cvt_pk_bf16(v[2], v[3]); w.z = cvt_pk_bf16(v[4], v[5]); w.w = cvt_pk_bf16(v[6], v[7]); *(u32x4*)p = w;
}
__device__ __forceinline__ void ld8f(const float* p, float (&v)[8]) { const f32x4 a = *(const f32x4*)p, b = *(const f32x4*)(p + 4); v[0]=a[0]; v[1]=a[1]; v[2]=a[2]; v[3]=a[3]; v[4]=b[0]; v[5]=b[1]; v[6]=b[2]; v[7]=b[3]; }
__device__ __forceinline__ void ld8bf(const bf16_t* p, float (&v)[8]) { const u32x4 w = *(const u32x4*)p; v[0]=bf_lo(w.x); v[1]=bf_hi(w.x); v[2]=bf_lo(w.y); v[3]=bf_hi(w.y); v[4]=bf_lo(w.z); v[5]=bf_hi(w.z); v[6]=bf_lo(w.w); v[7]=bf_hi(w.w); }

struct EpiInProj {
    bf16_t *Q, *Kb, *Vb, *Qi, *Ki, *Pool, *Ga, *Gp; float* Wi; const float* cs; const float *gq, *gk, *lng, *lnb;
    __device__ __forceinline__ void operator()(const f32x4 (&acc)[2][2][4][2], const Unit& u, int wr, int wc, int fr, int fq) const {
        const int pn = u.pn;
#pragma unroll
        for (int ai = 0; ai < 2; ++ai)
#pragma unroll
            for (int m = 0; m < 4; ++m) {
                const int row = u.pm * 256 + ai * HALF + wr * 64 + m * 16 + fr;
                float v0[8], v1[8];
#pragma unroll
                for (int n = 0; n < 2; ++n)
#pragma unroll
                    for (int i = 0; i < 4; ++i) { v0[4 * n + i] = acc[ai][0][m][n][i]; v1[4 * n + i] = acc[ai][1][m][n][i]; }
                if (pn <= 1 || (pn == 2 && wc < 2)) {
                    float ss = 0.f;
#pragma unroll
                    for (int j = 0; j < 8; ++j) ss += v0[j] * v0[j] + v1[j] * v1[j];
                    ss += __shfl_xor(ss, 16); ss += __shfl_xor(ss, 32);
                    const float rs = 1.0f / sqrtf(ss * (1.0f / 64.0f) + NORM_EPS);
                    const float* gg = (pn <= 1) ? gq : gk; const float sc = (pn <= 1) ? 0.18033688011112042f : 1.0f;
                    float g0[8], g1[8], cc[8], sn[8];
                    ld8f(gg + 8 * fq, g0); ld8f(gg + 32 + 8 * fq, g1);
                    ld8f(cs + (size_t)row * 96 + 8 * fq, cc); ld8f(cs + (size_t)row * 96 + 48 + 8 * fq, sn);
                    float o0[8], o1[8];
#pragma unroll
                    for (int j = 0; j < 8; ++j) { const float x1 = v0[j] * rs * g0[j], x2 = v1[j] * rs * g1[j]; o0[j] = (x1 * cc[j] - x2 * sn[j]) * sc; o1[j] = (x2 * cc[j] + x1 * sn[j]) * sc; }
                    if (pn <= 1) { bf16_t* dst = Q + (size_t)row * 512 + (4 * pn + wc) * 64; st8(dst + 8 * fq, o0); st8(dst + 32 + 8 * fq, o1); }
                    else {
                        bf16_t* dst = Kb + ((((size_t)((row >> 12) * 2 + wc) * 128 + ((row & 4095) >> 5)) * 4 + (fq >> 1)) * 64 + ((fq & 1) * 32 + (row & 31))) * 8;
                        st8(dst, o0); st8(dst + 2 * 512, o1); }
                } else if (pn == 2) {
                    const int t = row & 4095, kk = t & 31;
                    bf16_t* dst = Vb + (((size_t)((row >> 12) * 2 + (wc - 2)) * 128 + (t >> 5)) * 4 + (kk >> 4)) * 512 + (((kk >> 2) & 1) * 32 + 8 * fq) * 8 + 4 * ((kk >> 3) & 1) + (kk & 3);
#pragma unroll
                    for (int j = 0; j < 8; ++j) { dst[j * 8] = (bf16_t)(cvt_pk_bf16(v0[j], v0[j]) & 0xffffu); dst[2 * 512 + j * 8] = (bf16_t)(cvt_pk_bf16(v1[j], v1[j]) & 0xffffu); }
                } else if (pn == 3 || (pn == 4 && wc == 0)) {
                    if (pn == 4) {
                        float s = 0.f;
#pragma unroll
                        for (int j = 0; j < 8; ++j) s += v0[j] + v1[j];
                        s += __shfl_xor(s, 16); s += __shfl_xor(s, 32);
                        const float mu = s * (1.0f / 64.0f); float q = 0.f;
#pragma unroll
                        for (int j = 0; j < 8; ++j) { v0[j] -= mu; v1[j] -= mu; q += v0[j] * v0[j] + v1[j] * v1[j]; }
                        q += __shfl_xor(q, 16); q += __shfl_xor(q, 32);
                        const float rs = 1.0f / sqrtf(q * (1.0f / 64.0f) + NORM_EPS);
                        const int d0 = (fq < 2) ? 8 * fq : 8 * fq + 16, d1 = (fq < 2) ? 16 + 8 * fq : 8 * fq + 32;
                        float a0[8], a1[8], b0[8], b1[8];
                        ld8f(lng + d0, a0); ld8f(lng + d1, a1); ld8f(lnb + d0, b0); ld8f(lnb + d1, b1);
#pragma unroll
                        for (int j = 0; j < 8; ++j) { v0[j] = v0[j] * rs * a0[j] + b0[j]; v1[j] = v1[j] * rs * a1[j] + b1[j]; }
                    }
                    bf16_t* dst = Qi + (size_t)row * 256 + wc * 64;
                    bf16_t* kdst = Ki + (((size_t)(row >> 12) * 128 + ((row & 4095) >> 5)) * 4 * 64 + (row & 31)) * 8;
                    if (fq < 2) {
                        float cc[8], sn[8];
                        ld8f(cs + (size_t)row * 96 + 32 + 8 * fq, cc); ld8f(cs + (size_t)row * 96 + 48 + 32 + 8 * fq, sn);
                        float o0[8], o1[8];
#pragma unroll
                        for (int j = 0; j < 8; ++j) { o0[j] = v0[j] * cc[j] - v1[j] * sn[j]; o1[j] = v1[j] * cc[j] + v0[j] * sn[j]; }
                        if (pn == 3) { st8(dst + 8 * fq, o0); st8(dst + 16 + 8 * fq, o1); }
                        else { st8(kdst + (fq * 32) * 8, o0); st8(kdst + (64 + fq * 32) * 8, o1); }
                    } else {
                        if (pn == 3) { st8(dst + 8 * fq + 16, v0); st8(dst + 8 * fq + 32, v1); }
                        else { st8(kdst + (2 * 64 + (fq - 2) * 32) * 8, v0); st8(kdst + (3 * 64 + (fq - 2) * 32) * 8, v1); } }
                } else if (pn == 4) {
                    if (wc == 1 && fq == 0) *(f32x4*)(Wi + (size_t)row * 4) = (f32x4){v0[0] * 0.0625f, v0[1] * 0.0625f, v0[2] * 0.0625f, v0[3] * 0.0625f};
                } else if (pn <= 6) {
                    bf16_t* dst = Pool + (size_t)row * 512 + (pn - 5) * 256 + wc * 32 + 8 * fq;
                    st8(dst, v0); st8(dst + HALF, v1);
                } else {
                    bf16_t* dst = ((pn <= 10) ? Ga + (size_t)row * 1024 + (pn - 7) * 256 : Gp + (size_t)row * 1024 + (pn - 11) * 256) + wc * 32 + 8 * fq;
#pragma unroll
                    for (int j = 0; j < 8; ++j) { v0[j] = sigmoidf_(v0[j]); v1[j] = sigmoidf_(v1[j]); }
                    st8(dst, v0); st8(dst + HALF, v1);
                }
            }
    }
};

struct EpiGateMul {
    const bf16_t* G; const bf16_t* T; bf16_t* O;
    __device__ __forceinline__ void operator()(const f32x4 (&acc)[2][2][4][2], const Unit& u, int wr, int wc, int fr, int fq) const {
#pragma unroll
        for (int ai = 0; ai < 2; ++ai)
#pragma unroll
            for (int m = 0; m < 4; ++m) {
                const size_t off = (size_t)(u.pm * 256 + ai * HALF + wr * 64 + m * 16 + fr) * 1024 + u.pn * 256 + wc * 32 + 8 * fq;
#pragma unroll
                for (int bj = 0; bj < 2; ++bj) {
                    float g[8], o[8]; ld8bf(G + off + bj * HALF, g);
#pragma unroll
                    for (int n = 0; n < 2; ++n)
#pragma unroll
                        for (int i = 0; i < 4; ++i) o[4 * n + i] = g[4 * n + i] * acc[ai][bj][m][n][i];
                    if (T) { float t[8]; ld8bf(T + off + bj * HALF, t);
#pragma unroll
                        for (int j = 0; j < 8; ++j) o[j] += t[j]; }
                    st8(O + off + bj * HALF, o);
                }
            }
    }
};
struct EpiResid {
    const float* X; float* O;
    __device__ __forceinline__ void operator()(const f32x4 (&acc)[2][2][4][2], const Unit& u, int wr, int wc, int fr, int fq) const {
#pragma unroll
        for (int ai = 0; ai < 2; ++ai)
#pragma unroll
            for (int m = 0; m < 4; ++m) {
                const size_t off = (size_t)(u.pm * 256 + ai * HALF + wr * 64 + m * 16 + fr) * 1024 + u.pn * 256 + wc * 32 + 8 * fq;
#pragma unroll
                for (int bj = 0; bj < 2; ++bj)
#pragma unroll
                    for (int n = 0; n < 2; ++n) { const size_t o = off + bj * HALF + 4 * n; *(f32x4*)(O + o) = *(const f32x4*)(X + o) + acc[ai][bj][m][n]; }
            }
    }
};
struct EpiGateUp {
    const float* bias; bf16_t* Act;
    __device__ __forceinline__ void operator()(const f32x4 (&acc)[2][2][4][2], const Unit& u, int wr, int wc, int fr, int fq) const {
        const int e = u.pn >> 3, pnl = u.pn & 7, col = pnl * 128 + wc * 32 + 8 * fq;
        float bg[8], bu[8]; ld8f(bias + (size_t)e * 2048 + col, bg); ld8f(bias + (size_t)e * 2048 + 1024 + col, bu);
#pragma unroll
        for (int ai = 0; ai < 2; ++ai)
#pragma unroll
            for (int m = 0; m < 4; ++m) {
                const size_t row = (size_t)(u.pm * 256 + ai * HALF + wr * 64 + m * 16 + fr);
                float o[8];
#pragma unroll
                for (int n = 0; n < 2; ++n)
#pragma unroll
                    for (int i = 0; i < 4; ++i) { const int j = 4 * n + i;
                        const float gt = fminf(acc[ai][0][m][n][i] + bg[j], 7.0f), up = fminf(fmaxf(acc[ai][1][m][n][i] + bu[j], -7.0f), 7.0f);
                        o[j] = gt * sigmoidf_(1.702f * gt) * (up + 1.0f); }
                st8(Act + row * 1024 + col, o);
            }
    }
};
struct EpiDown {
    const float* bias; const float* sgate; bf16_t* Y;
    __device__ __forceinline__ void operator()(const f32x4 (&acc)[2][2][4][2], const Unit& u, int wr, int wc, int fr, int fq) const {
        const int e = u.pn >> 2, pnl = u.pn & 3, col = pnl * 256 + wc * 32 + 8 * fq;
        float b0[8], b1[8]; ld8f(bias + (size_t)e * 1024 + col, b0); ld8f(bias + (size_t)e * 1024 + col + HALF, b1);
#pragma unroll
        for (int ai = 0; ai < 2; ++ai)
#pragma unroll
            for (int m = 0; m < 4; ++m) {
                const size_t row = (size_t)(u.pm * 256 + ai * HALF + wr * 64 + m * 16 + fr);
                const float gt = sgate[row];
                float o0[8], o1[8];
#pragma unroll
                for (int n = 0; n < 2; ++n)
#pragma unroll
                    for (int i = 0; i < 4; ++i) { const int j = 4 * n + i; o0[j] = (acc[ai][0][m][n][i] + b0[j]) * gt; o1[j] = (acc[ai][1][m][n][i] + b1[j]) * gt; }
                st8(Y + row * 1024 + col, o0); st8(Y + row * 1024 + col + HALF, o1);
            }
    }
};

template <class RowMap>
__device__ __forceinline__ void cvt_item(const float* W, int K, int N, bf16_t* WT, LAS float* scr, int kb, int nb, int lane, const RowMap& rm) {
    const int k0 = kb * 64, n0 = nb * 64, n4 = lane & 15, kr = lane >> 4, n = n0 + 4 * n4;
    f32x4 v[16];
#pragma unroll
    for (int i = 0; i < 16; ++i) v[i] = (n < N) ? *(const f32x4*)(W + (size_t)(k0 + 4 * i + kr) * N + n) : (f32x4){0.f, 0.f, 0.f, 0.f};
#pragma unroll
    for (int i = 0; i < 16; ++i) { LAS float* d = scr + (4 * i + kr) * 65 + 4 * n4; d[0] = v[i][0]; d[1] = v[i][1]; d[2] = v[i][2]; d[3] = v[i][3]; }
    LDS_WAIT(); asm volatile("" ::: "memory");
    const int c8 = lane & 7;
#pragma unroll
    for (int jj = 0; jj < 8; ++jj) { const int nn = (lane >> 3) + 8 * jj; const LAS float* s = scr + (8 * c8) * 65 + nn;
        if (n0 + nn < N) { u32x4 o; o.x = cvt_pk_bf16(s[0], s[65]); o.y = cvt_pk_bf16(s[2 * 65], s[3 * 65]); o.z = cvt_pk_bf16(s[4 * 65], s[5 * 65]); o.w = cvt_pk_bf16(s[6 * 65], s[7 * 65]);
            *(u32x4*)(WT + (size_t)rm(n0 + nn) * K + k0 + 8 * c8) = o; } }
    LDS_WAIT(); asm volatile("" ::: "memory");
}
struct RmIdent { int off; __device__ __forceinline__ int operator()(int n) const { return off + n; } };
struct RmWin { __device__ __forceinline__ int operator()(int n) const { return win_phys(n); } };
struct RmGu { int e; __device__ __forceinline__ int operator()(int n) const { return e * 2048 + 256 * ((n & 1023) >> 7) + 128 * (n >> 10) + (n & 127); } };

__device__ __forceinline__ void phase0(const Params& p, LAS unsigned char* lds, int bid, int G) {
    const int tid = threadIdx.x, lane = tid & 63, wave = __builtin_amdgcn_readfirstlane(tid >> 6);
    const int gw = bid * NWAVES + wave, NGW = G * NWAVES;
    unsigned char* ws = p.ws;
    LAS float* scr = (LAS float*)(lds + wave * 16640);
    constexpr int I_GU = NEXP * 16 * 32, I_D = NEXP * 16 * 16, I_IN = 16 * 58, I_A = 8 * 16, I_O = 16 * 16;
    constexpr int NITEMS = I_GU + I_D + I_IN + I_A + I_O;
    for (int it = gw; it < NITEMS; it += NGW) {
        int r = it;
        if (r < I_GU) { const int e = r / 512, q = r % 512; cvt_item(p.w_gu + (size_t)e * 1024 * 2048, 1024, 2048, (bf16_t*)(ws + WS_WGU), scr, q / 32, q % 32, lane, RmGu{e}); continue; } r -= I_GU;
        if (r < I_D) { const int e = r / 256, q = r % 256; cvt_item(p.w_d + (size_t)e * 1024 * 1024, 1024, 1024, (bf16_t*)(ws + WS_WD), scr, q / 16, q % 16, lane, RmIdent{e * 1024}); continue; } r -= I_D;
        if (r < I_IN) { cvt_item(p.w_in, 1024, INW, (bf16_t*)(ws + WS_WIN), scr, r / 58, r % 58, lane, RmWin{}); continue; } r -= I_IN;
        if (r < I_A) { cvt_item(p.w_a, 512, 1024, (bf16_t*)(ws + WS_WA), scr, r / 16, r % 16, lane, RmIdent{0}); continue; } r -= I_A;
        cvt_item(p.w_out, 1024, 1024, (bf16_t*)(ws + WS_WOUT), scr, r / 16, r % 16, lane, RmIdent{0});
    }
    for (int it = gw; it < 16 * 4 * 16; it += NGW) {
        const int nb = it & 15, g = (it >> 4) & 3, cb = it >> 6, n = nb * 64 + lane, c0 = cb * 8;
        float a[8];
#pragma unroll
        for (int q = 0; q < 8; ++q) a[q] = 0.f;
        const float* mix = p.pool_mix + (size_t)g * 128 * 128 + (size_t)c0 * 128;
        for (int d = 0; d < 128; ++d) {
            const float wb = p.pool_scale[g * 128 + d] * p.w_b[(size_t)(g * 128 + d) * 1024 + n];
#pragma unroll
            for (int q = 0; q < 8; ++q) a[q] += mix[q * 128 + d] * wb;
        }
        st8((bf16_t*)(ws + WS_WEFF) + (size_t)n * 512 + g * 128 + c0, a);
    }
    {
        f32x4 gv[4];
#pragma unroll
        for (int j = 0; j < 4; ++j) gv[j] = *(const f32x4*)(p.norm1_g + 4 * lane + 256 * j);
        bf16_t* XN = (bf16_t*)(ws + WS_XN);
        for (int m = gw; m < NTOK; m += NGW) {
            const f32x4* xr = (const f32x4*)(p.x + (size_t)m * D) + lane;
            f32x4 v[4]; float s = 0.f;
#pragma unroll
            for (int j = 0; j < 4; ++j) { v[j] = xr[64 * j]; s += (v[j].x * v[j].x + v[j].y * v[j].y) + (v[j].z * v[j].z + v[j].w * v[j].w); }
            const float rs = 1.0f / sqrtf(wave_sum(s) * (1.0f / D) + NORM_EPS);
#pragma unroll
            for (int j = 0; j < 4; ++j) { const f32x4 o = v[j] * rs * gv[j]; u32x2 w; w.x = cvt_pk_bf16(o.x, o.y); w.y = cvt_pk_bf16(o.z, o.w); *(u32x2*)(XN + (size_t)m * D + 4 * lane + 256 * j) = w; }
        }
    }
    {
        float* cs = (float*)(ws + WS_CS);
        for (int i = bid * NTHREADS + tid; i < NTOK * 48; i += G * NTHREADS) {
            const int row = i / 48, j = i % 48;
            const float ex = (j < 32) ? -(float)j / 32.0f : -(float)(j - 32) / 16.0f;
            const float ang = (float)p.pos[row] * powf(10000.0f, ex);
            float sn, cc; sincosf(ang, &sn, &cc);
            cs[(size_t)row * 96 + j] = cc; cs[(size_t)row * 96 + 48 + j] = sn;
        }
    }
}

__device__ __forceinline__ void pool_phase(const Params& p, int bid, int G) {
    const int tid = threadIdx.x, lane = tid & 63, wave = __builtin_amdgcn_readfirstlane(tid >> 6);
    const int gw = bid * NWAVES + wave, NGW = G * NWAVES;
    const bf16_t* Pool = (const bf16_t*)(p.ws + WS_POOL); bf16_t* Mixed = (bf16_t*)(p.ws + WS_MIXED);
    const int w = 2 << (lane >> 4);
    for (int it = gw; it < NBATCH * 256; it += NGW) {
        const int b = it >> 8, tb = (it & 255) * 16;
        const bf16_t* P = Pool + (size_t)b * SEQ * 512 + 8 * lane;
        float sum[8];
#pragma unroll
        for (int q = 0; q < 8; ++q) sum[q] = 0.f;
        for (int d = 1; d < 16; ++d) if (d < w && tb - d >= 0) { float v[8]; ld8bf(P + (size_t)(tb - d) * 512, v);
#pragma unroll
            for (int q = 0; q < 8; ++q) sum[q] += v[q]; }
        for (int t = tb; t < tb + 16; ++t) {
            float cur[8]; ld8bf(P + (size_t)t * 512, cur);
#pragma unroll
            for (int q = 0; q < 8; ++q) sum[q] += cur[q];
            const float inv = 1.0f / (float)((t + 1 < w) ? t + 1 : w);
            float o[8];
#pragma unroll
            for (int q = 0; q < 8; ++q) o[q] = sum[q] * inv - cur[q];
            st8(Mixed + ((size_t)b * SEQ + t) * 512 + 8 * lane, o);
            if (t - w + 1 >= 0) { float old[8]; ld8bf(P + (size_t)(t - w + 1) * 512, old);
#pragma unroll
                for (int q = 0; q < 8; ++q) sum[q] -= old[q]; }
        }
    }
}

__device__ __forceinline__ int wave_sum_i(int v) {
    v += __builtin_amdgcn_update_dpp(0, v, 0xB1, 0xF, 0xF, true);
    v += __builtin_amdgcn_update_dpp(0, v, 0x4E, 0xF, 0xF, true);
    v += __builtin_amdgcn_update_dpp(0, v, 0x141, 0xF, 0xF, true);
    v += __builtin_amdgcn_update_dpp(0, v, 0x140, 0xF, 0xF, true);
    v += __builtin_amdgcn_update_dpp(0, v, 0x142, 0xA, 0xF, true);
    v += __builtin_amdgcn_update_dpp(0, v, 0x143, 0xC, 0xF, true);
    return __builtin_amdgcn_readlane(v, 63);
}
__device__ __forceinline__ int count_ge(const unsigned (&key)[64], int nj, unsigned mid) {
    int c0 = 0, c1 = 0, c2 = 0, c3 = 0;
#pragma unroll
    for (int jb = 0; jb < 8; ++jb) if (jb * 8 < nj) {
        c0 += (key[jb * 8 + 0] >= mid) ? 1 : 0; c1 += (key[jb * 8 + 1] >= mid) ? 1 : 0; c2 += (key[jb * 8 + 2] >= mid) ? 1 : 0; c3 += (key[jb * 8 + 3] >= mid) ? 1 : 0;
        c0 += (key[jb * 8 + 4] >= mid) ? 1 : 0; c1 += (key[jb * 8 + 5] >= mid) ? 1 : 0; c2 += (key[jb * 8 + 6] >= mid) ? 1 : 0; c3 += (key[jb * 8 + 7] >= mid) ? 1 : 0; }
    return wave_sum_i((c0 + c1) + (c2 + c3));
}
__device__ __forceinline__ int lane_prefix(unsigned long long m) { return __builtin_amdgcn_mbcnt_hi((unsigned)(m >> 32), __builtin_amdgcn_mbcnt_lo((unsigned)m, 0u)); }
__device__ __forceinline__ unsigned wave_umax(unsigned v) {
#pragma unroll
    for (int o = 1; o < 64; o <<= 1) { const unsigned t = (unsigned)__shfl_xor((int)v, o); v = t > v ? t : v; }
    return (unsigned)__builtin_amdgcn_readfirstlane((int)v);
}
__device__ __forceinline__ unsigned wave_umin(unsigned v) {
#pragma unroll
    for (int o = 1; o < 64; o <<= 1) { const unsigned t = (unsigned)__shfl_xor((int)v, o); v = t < v ? t : v; }
    return (unsigned)__builtin_amdgcn_readfirstlane((int)v);
}

__device__ __forceinline__ void select_unit(const Params& p, LAS unsigned char* lds, int b, int t0) {
    int tid = threadIdx.x; asm volatile("" : "+v"(tid));
    const int lane = tid & 63, wave = __builtin_amdgcn_readfirstlane(tid >> 6);
    unsigned char* wsq = p.ws; asm volatile("" : "+s"(wsq));
    const bf16_t* Qi = (const bf16_t*)(wsq + WS_QI); const bf16_t* Ki = (const bf16_t*)(wsq + WS_KI); const float* Wi = (const float*)(wsq + WS_WI);
    unsigned* M32 = (unsigned*)(wsq + WS_MASK);
    LAS float* SC = (LAS float*)lds;
    const int c = t0 >> 6, nj = c + 1, nk = 64 * nj, ntile = nk >> 5;
    const size_t tok0 = (size_t)b * SEQ + t0;
    {
        const int r = lane & 31, hh = lane >> 5;
        bf16x8 qa[4];
        const bf16_t* qp = Qi + (tok0 + (r >> 2)) * 256 + (r & 3) * 64 + 8 * hh;
#pragma unroll
        for (int ks = 0; ks < 4; ++ks) qa[ks] = *(const bf16x8*)(qp + 16 * ks);
        f32x4 wv[4];
#pragma unroll
        for (int g = 0; g < 4; ++g) wv[g] = *(const f32x4*)(Wi + (tok0 + 2 * g + hh) * 4);
        const bf16_t* kif = Ki + (size_t)b * 128 * 4 * 512 + lane * 8;
        bf16x8 kbA[4][4], kbB[4][4];
#define LOADK(dst, k0) do { _Pragma("unroll") for (int u = 0; u < 4; ++u) { const int kt = ((k0) + u < ntile) ? (k0) + u : (k0); \
            _Pragma("unroll") for (int ks = 0; ks < 4; ++ks) dst[u][ks] = *(const bf16x8*)(kif + (size_t)(kt * 4 + ks) * 512); } } while (0)
#define COMPK(src, k0) do { _Pragma("unroll") for (int u = 0; u < 4; ++u) if ((k0) + u < ntile) { f32x16 acc; \
            _Pragma("unroll") for (int q = 0; q < 16; ++q) acc[q] = 0.f; \
            _Pragma("unroll") for (int ks = 0; ks < 4; ++ks) acc = __builtin_amdgcn_mfma_f32_32x32x16_bf16(qa[ks], src[u][ks], acc, 0, 0, 0); \
            _Pragma("unroll") for (int g = 0; g < 4; ++g) { float sv = fmaf(wv[g][0], fmaxf(acc[4 * g], 0.f), 0.0f); \
                sv = fmaf(wv[g][1], fmaxf(acc[4 * g + 1], 0.f), sv); sv = fmaf(wv[g][2], fmaxf(acc[4 * g + 2], 0.f), sv); sv = fmaf(wv[g][3], fmaxf(acc[4 * g + 3], 0.f), sv); \
                SC[(2 * g + hh) * 4096 + ((k0) + u) * 32 + r] = sv; } } } while (0)
        int kt0 = wave * 4;
        if (kt0 < ntile) {
            LOADK(kbA, kt0);
            for (;;) {
                const int k1 = kt0 + NWAVES * 4; if (k1 < ntile) LOADK(kbB, k1);
                COMPK(kbA, kt0); if (k1 >= ntile) break;
                const int k2 = k1 + NWAVES * 4; if (k2 < ntile) LOADK(kbA, k2);
                COMPK(kbB, k1); if (k2 >= ntile) break;
                kt0 = k2;
            }
        }
#undef LOADK
#undef COMPK
    }
    __syncthreads();
    LAS float* row = SC + wave * 4096;
    unsigned key[64];
#pragma unroll
    for (int jb = 0; jb < 8; ++jb) {
#pragma unroll
        for (int q = 0; q < 8; ++q) key[jb * 8 + q] = 0u;
        if (jb * 8 < nj) {
#pragma unroll
            for (int q = 0; q < 8; ++q) { const int j = jb * 8 + q; const unsigned u = __float_as_uint(row[j * 64 + lane]); const unsigned kk = (u & 0x80000000u) ? ~u : (u | 0x80000000u); key[j] = (j < nj) ? kk : 0u; }
        }
    }
    unsigned hiSel = 1u, T = 0u; int rrem = 0;
    if (nk > 256) {
        unsigned g0 = 0u, g1 = 0u, g2 = 0u, g3 = 0u;
#pragma unroll
        for (int j = 0; j < 64; j += 4) { g0 = key[j] > g0 ? key[j] : g0; g1 = key[j + 1] > g1 ? key[j + 1] : g1; g2 = key[j + 2] > g2 ? key[j + 2] : g2; g3 = key[j + 3] > g3 ? key[j + 3] : g3; }
        const unsigned mx01 = g0 > g1 ? g0 : g1, mx23 = g2 > g3 ? g2 : g3, mn01 = g0 < g1 ? g0 : g1, mn23 = g2 < g3 ? g2 : g3;
        const unsigned km = wave_umax(mx01 > mx23 ? mx01 : mx23);
        unsigned lo = wave_umin(mn01 < mn23 ? mn01 : mn23), hi = km + 1u; int cnt_hi = 0; bool exact = false;
        while (hi - lo > 1u) {
            const unsigned mid = lo + ((hi - lo) >> 1);
            const int cnt = count_ge(key, nj, mid);
            if (cnt >= 256) { lo = mid; if (cnt == 256) { exact = true; break; } } else { hi = mid; cnt_hi = cnt; }
        }
        if (exact) { hiSel = lo; T = 0u; rrem = 0; } else { hiSel = hi; T = lo; rrem = 256 - cnt_hi; }
    }
    unsigned* mrow = M32 + (tok0 + wave) * 128;
#pragma unroll
    for (int j = 0; j < 64; ++j) if ((j & ~7) < nj) {
        const bool eq = (key[j] == T) && (key[j] < hiSel);
        const unsigned long long eqm = __ballot(eq);
        const bool take = eq && (lane_prefix(eqm) < rrem);
        const int ne = __popcll(eqm); rrem = (ne < rrem) ? rrem - ne : 0;
        const bool sel = (key[j] >= hiSel) || take;
        const unsigned long long sm = __ballot(sel);
        if (lane == 0) *(u32x2*)(mrow + 2 * j) = (u32x2){(unsigned)sm, (unsigned)(sm >> 32)};
    }
    __syncthreads();
}

__device__ __forceinline__ void dense_attn_chunk(const Params& p, int b, int c, float negC) {
    int tid = threadIdx.x; asm volatile("" : "+v"(tid));
    const int lane = tid & 63, wave = __builtin_amdgcn_readfirstlane(tid >> 6);
    unsigned char* wsq = p.ws; asm volatile("" : "+s"(wsq));
    const bf16_t* Qb = (const bf16_t*)(wsq + WS_Q); const bf16_t* Kb = (const bf16_t*)(wsq + WS_K); const bf16_t* VT = (const bf16_t*)(wsq + WS_VT);
    const unsigned* M32 = (const unsigned*)(wsq + WS_MASK); bf16_t* Attn = (bf16_t*)(wsq + WS_ATTN);
    const int kvh = wave >> 2, cl = lane & 31, hi = lane >> 5, ntile = 2 * (c + 1);
    const size_t tokc = (size_t)b * SEQ + 64 * c + 16 * (wave & 3);
    bf16x8 qf[2][4]; const unsigned* mrow[2]; size_t tokq[2];
#pragma unroll
    for (int ti = 0; ti < 2; ++ti) { tokq[ti] = tokc + 8 * ti + (cl >> 2); mrow[ti] = M32 + tokq[ti] * 128;
#pragma unroll
        for (int ks = 0; ks < 4; ++ks) qf[ti][ks] = *(const bf16x8*)(Qb + tokq[ti] * 512 + (4 * kvh + (cl & 3)) * 64 + 16 * ks + 8 * hi); }
    f32x16 o[2][2]; float lsum[2] = {0.f, 0.f};
#pragma unroll
    for (int ti = 0; ti < 2; ++ti)
#pragma unroll
        for (int dt = 0; dt < 2; ++dt)
#pragma unroll
            for (int q = 0; q < 16; ++q) o[ti][dt][q] = 0.f;
    const bf16_t* kbase = Kb + (size_t)(b * 2 + kvh) * 128 * 4 * 512 + lane * 8;
    const bf16_t* vbase = VT + (size_t)(b * 2 + kvh) * 128 * 4 * 512 + lane * 8;
    bf16x8 kfA[4], kfB[4], vfA[4], vfB[4]; unsigned mwA[2], mwB[2];
#define LOADT(kf, vf, mw, kt) do { _Pragma("unroll") for (int q = 0; q < 4; ++q) { kf[q] = *(const bf16x8*)(kbase + (size_t)((kt) * 4 + q) * 512); vf[q] = *(const bf16x8*)(vbase + (size_t)((kt) * 4 + q) * 512); } \
        mw[0] = mrow[0][kt]; mw[1] = mrow[1][kt]; } while (0)
#define COMPT(kf, vf, mw) do { _Pragma("unroll") for (int ti = 0; ti < 2; ++ti) { f32x16 sa; const unsigned mwh = mw[ti] >> (4 * hi); \
        _Pragma("unroll") for (int q = 0; q < 16; ++q) sa[q] = negC; \
        _Pragma("unroll") for (int ks = 0; ks < 4; ++ks) sa = __builtin_amdgcn_mfma_f32_32x32x16_bf16(kf[ks], qf[ti][ks], sa, 0, 0, 0); \
        float pv[16]; float ls = 0.f; \
        _Pragma("unroll") for (int r = 0; r < 16; ++r) { const int pos = (r & 3) + 8 * (r >> 2); \
            const float e = __builtin_amdgcn_exp2f(sa[r]); const int m = __builtin_amdgcn_sbfe((int)mwh, pos, 1); \
            pv[r] = __uint_as_float(__float_as_uint(e) & (unsigned)m); ls += pv[r]; } \
        lsum[ti] += ls; \
        _Pragma("unroll") for (int sx = 0; sx < 2; ++sx) { \
            u32x4 pw; pw.x = cvt_pk_bf16(pv[8 * sx], pv[8 * sx + 1]); pw.y = cvt_pk_bf16(pv[8 * sx + 2], pv[8 * sx + 3]); pw.z = cvt_pk_bf16(pv[8 * sx + 4], pv[8 * sx + 5]); pw.w = cvt_pk_bf16(pv[8 * sx + 6], pv[8 * sx + 7]); \
            const bf16x8 pb = __builtin_bit_cast(bf16x8, pw); \
            _Pragma("unroll") for (int dt = 0; dt < 2; ++dt) o[ti][dt] = __builtin_amdgcn_mfma_f32_32x32x16_bf16(vf[dt * 2 + sx], pb, o[ti][dt], 0, 0, 0); } } } while (0)
    LOADT(kfA, vfA, mwA, 0);
    for (int kt = 0; kt < ntile; kt += 2) {
        LOADT(kfB, vfB, mwB, kt + 1);
        COMPT(kfA, vfA, mwA);
        if (kt + 2 < ntile) LOADT(kfA, vfA, mwA, kt + 2);
        COMPT(kfB, vfB, mwB);
    }
#undef LOADT
#undef COMPT
    int lane2 = lane; asm volatile("" : "+v"(lane2));
    const int cl2 = lane2 & 31, hi2 = lane2 >> 5;
#pragma unroll
    for (int ti = 0; ti < 2; ++ti) {
        const float lt = lsum[ti] + __shfl_xor(lsum[ti], 32); const float inv = 1.0f / lt;
        bf16_t* dst = Attn + (tokc + 8 * ti + (cl2 >> 2)) * 512 + (4 * kvh + (cl2 & 3)) * 64 + 4 * hi2;
#pragma unroll
        for (int dt = 0; dt < 2; ++dt)
#pragma unroll
            for (int g4 = 0; g4 < 4; ++g4) { u32x2 w; w.x = cvt_pk_bf16(o[ti][dt][4 * g4] * inv, o[ti][dt][4 * g4 + 1] * inv); w.y = cvt_pk_bf16(o[ti][dt][4 * g4 + 2] * inv, o[ti][dt][4 * g4 + 3] * inv);
                *(u32x2*)(dst + 32 * dt + 8 * g4) = w; }
    }
}

__device__ __forceinline__ void attn_phase(const Params& p, LAS unsigned char* lds, int bid, int G) {
    const int lane = threadIdx.x & 63;
    float mq = fabsf(p.q_norm_g[lane]), mk = fabsf(p.k_norm_g[lane]);
#pragma unroll
    for (int o = 1; o < 64; o <<= 1) { mq = fmaxf(mq, __shfl_xor(mq, o)); mk = fmaxf(mk, __shfl_xor(mk, o)); }
    const float negC = -(8.0f * mq * mk * 1.4426950408889634f * 1.03f);
    for (int u = bid; u < NBATCH * 32; u += G) {
        const int b = u & 7, y = u >> 3;
        for (int half = 0; half < 2; ++half) {
            const int c = half ? 63 - y : y;
            for (int sx = 0; sx < 8; ++sx) select_unit(p, lds, b, 64 * c + 8 * sx);
            asm volatile("s_waitcnt vmcnt(0)" ::: "memory"); __syncthreads();
            dense_attn_chunk(p, b, c, negC);
        }
    }
}

constexpr int T_TSTART = 0, T_PADSTART = 40, T_BLOCKBASE = 80, T_NE = 112, T_WB = 144  , T_PART = 400  ;
__device__ __forceinline__ void router_phase(const Params& p, LAS unsigned char* lds, int bid, int G) {
    const int tid = threadIdx.x, lane = tid & 63, wave = __builtin_amdgcn_readfirstlane(tid >> 6);
    constexpr int WP = 1028;
    LAS float* WrT = (LAS float*)lds;
    for (int i = tid; i < 1024 * 32 / 4; i += NTHREADS) { const f32x4 v = *(const f32x4*)(p.router_w + 4 * (size_t)i); const int c = i >> 3, e0 = 4 * (i & 7); const float g = p.norm2_g[c];
        WrT[(e0 + 0) * WP + c] = v[0] * g; WrT[(e0 + 1) * WP + c] = v[1] * g; WrT[(e0 + 2) * WP + c] = v[2] * g; WrT[(e0 + 3) * WP + c] = v[3] * g; }
    __syncthreads();
    LAS int* tbl = (LAS int*)(lds + MISC_OFF);
    const float* X1 = p.out; bf16_t* H2 = (bf16_t*)(p.ws + WS_H2);
    int* rec_e = (int*)(p.ws + WS_REC_E); int* rec_pos = (int*)(p.ws + WS_REC_POS); float* rec_gate = (float*)(p.ws + WS_REC_GATE);
    const int ex = lane & 15, kq = lane >> 4;
    const size_t tokw = (size_t)bid * 128 + wave * 16;
    f32x4 acc0 = (f32x4){0.f, 0.f, 0.f, 0.f}, acc1 = acc0; float ssq = 0.f;
    {
        const float* xr = X1 + (tokw + ex) * D + 4 * kq;
        const LAS float* w0 = WrT + ex * WP + 4 * kq; const LAS float* w1 = w0 + 16 * WP;
#pragma unroll 4
        for (int q = 0; q < 64; ++q) {
            const f32x4 a = *(const f32x4*)(xr + 16 * q); const f32x4 b0 = *(const LAS f32x4*)(w0 + 16 * q), b1 = *(const LAS f32x4*)(w1 + 16 * q);
            ssq += (a.x * a.x + a.y * a.y) + (a.z * a.z + a.w * a.w);
#pragma unroll
            for (int k = 0; k < 4; ++k) { acc0 = __builtin_amdgcn_mfma_f32_16x16x4f32(a[k], b0[k], acc0, 0, 0, 0); acc1 = __builtin_amdgcn_mfma_f32_16x16x4f32(a[k], b1[k], acc1, 0, 0, 0); }
        }
    }
    ssq += __shfl_xor(ssq, 16); ssq += __shfl_xor(ssq, 32);
    const float rs = 1.0f / sqrtf(ssq * (1.0f / D) + NORM_EPS);
    const float br0 = p.router_b[ex], br1 = p.router_b[ex + 16];
    float lg0[4], lg1[4];
#pragma unroll
    for (int i = 0; i < 4; ++i) { const float r = __shfl(rs, 4 * kq + i); lg0[i] = acc0[i] * r + br0; lg1[i] = acc1[i] * r + br1; }
    int ti[4][4]; float tv[4][4];
#pragma unroll
    for (int r = 0; r < 4; ++r)
#pragma unroll
        for (int i = 0; i < 4; ++i) {
            float bv = (lg0[i] >= lg1[i]) ? lg0[i] : lg1[i]; int bi = (lg0[i] >= lg1[i]) ? ex : ex + 16;
#pragma unroll
            for (int m = 1; m < 16; m <<= 1) { const float ov = __shfl_xor(bv, m); const int oi = __shfl_xor(bi, m); const bool better = (ov > bv) || (ov == bv && oi < bi); bv = better ? ov : bv; bi = better ? oi : bi; }
            tv[i][r] = bv; ti[i][r] = bi;
            if (bi == ex) lg0[i] = -INFINITY; if (bi == ex + 16) lg1[i] = -INFINITY;
        }
    unsigned M[4];
#pragma unroll
    for (int i = 0; i < 4; ++i) M[i] = (1u << ti[i][0]) | (1u << ti[i][1]) | (1u << ti[i][2]) | (1u << ti[i][3]);
    unsigned Mall[16];
#pragma unroll
    for (int t = 0; t < 16; ++t) Mall[t] = (unsigned)__builtin_amdgcn_readlane((int)M[t & 3], 16 * (t >> 2));
#pragma unroll
    for (int i = 0; i < 4; ++i) {
        const int t = 4 * kq + i;
        const float e1 = __expf(tv[i][1] - tv[i][0]), e2 = __expf(tv[i][2] - tv[i][0]), e3 = __expf(tv[i][3] - tv[i][0]); const float inv = 1.0f / (1.0f + e1 + e2 + e3);
#pragma unroll
        for (int r = 0; r < 4; ++r) {
            const int x = ti[i][r]; int pos = 0;
#pragma unroll
            for (int tp = 0; tp < 16; ++tp) pos += (tp < t) ? (int)((Mall[tp] >> x) & 1u) : 0;
            const float gt = (r == 0 ? 1.0f : (r == 1 ? e1 : (r == 2 ? e2 : e3))) * inv;
            if (ex == r) { rec_e[(tokw + t) * 4 + r] = x; rec_pos[(tokw + t) * 4 + r] = pos; rec_gate[(tokw + t) * 4 + r] = gt; }
        }
    }
    { int cnt = 0;
#pragma unroll
        for (int t = 0; t < 16; ++t) cnt += (int)((Mall[t] >> (lane & 31)) & 1u);
        if (lane < 32) tbl[T_WB + wave * 32 + lane] = cnt; }
    {
        f32x4 g2[4];
#pragma unroll
        for (int j = 0; j < 4; ++j) g2[j] = *(const f32x4*)(p.norm2_g + 4 * lane + 256 * j);
#pragma unroll 4
        for (int t = 0; t < 16; ++t) {
            const float r = __shfl(rs, t);
            const f32x4* xr = (const f32x4*)(X1 + (tokw + t) * D) + lane;
#pragma unroll
            for (int j = 0; j < 4; ++j) { const f32x4 h = xr[64 * j] * r * g2[j]; u32x2 w; w.x = cvt_pk_bf16(h.x, h.y); w.y = cvt_pk_bf16(h.z, h.w); *(u32x2*)(H2 + (tokw + t) * D + 4 * lane + 256 * j) = w; }
        }
    }
    __syncthreads();
    if (tid < 256) ((int*)(p.ws + WS_WCNT))[(size_t)bid * 256 + tid] = tbl[T_WB + tid];
    if (tid < 32) { int sm = 0;
#pragma unroll
        for (int w = 0; w < 8; ++w) sm += tbl[T_WB + w * 32 + tid];
        ((int*)(p.ws + WS_BCNT))[bid * 32 + tid] = sm; }
    __syncthreads();
}

__device__ __forceinline__ void moe_tables(const Params& p, LAS int* tbl, int bid) {
    const int tid = threadIdx.x; const int* bcnt = (const int*)(p.ws + WS_BCNT);
    { const int e = tid & 31, part = tid >> 5; int all = 0, below = 0;
        for (int k = 0; k < 16; ++k) { const int blk = part * 16 + k; const int v = bcnt[blk * 32 + e]; all += v; below += (blk < bid) ? v : 0; }
        tbl[T_PART + part * 32 + e] = all; tbl[T_PART + 512 + part * 32 + e] = below; }
    __syncthreads();
    if (tid < 32) { int all = 0, below = 0;
        for (int q = 0; q < 16; ++q) { all += tbl[T_PART + q * 32 + tid]; below += tbl[T_PART + 512 + q * 32 + tid]; }
        tbl[T_NE + tid] = all; tbl[T_BLOCKBASE + tid] = below; }
    __syncthreads();
    if (tid == 0) { int ps = 0, ts = 0;
        for (int e = 0; e < NEXP; ++e) { tbl[T_PADSTART + e] = ps; tbl[T_TSTART + e] = ts; const int nt = (tbl[T_NE + e] + 255) >> 8; ps += nt * 256; ts += nt; }
        tbl[T_PADSTART + NEXP] = ps; tbl[T_TSTART + NEXP] = ts; }
    __syncthreads();
}

__device__ __forceinline__ void permute_phase(const Params& p, LAS unsigned char* lds, int bid, int G) {
    const int tid = threadIdx.x, lane = tid & 63, wave = __builtin_amdgcn_readfirstlane(tid >> 6);
    LAS int* tbl = (LAS int*)(lds + MISC_OFF);
    moe_tables(p, tbl, bid);
    if (tid < 256) { const int w = tid >> 5, e = tid & 31; int s = 0; const int* wc = (const int*)(p.ws + WS_WCNT) + (size_t)bid * 256;
        for (int q = 0; q < 8; ++q) s += (q < w) ? wc[q * 32 + e] : 0;
        tbl[T_WB + tid] = s; }
    __syncthreads();
    const int* rec_e = (const int*)(p.ws + WS_REC_E); const int* rec_pos = (const int*)(p.ws + WS_REC_POS); const float* rec_gate = (const float*)(p.ws + WS_REC_GATE);
    int* slot_of = (int*)(p.ws + WS_SLOT_OF); float* slot_gate = (float*)(p.ws + WS_SLOT_GATE);
    const bf16_t* H2 = (const bf16_t*)(p.ws + WS_H2); bf16_t* H2S = (bf16_t*)(p.ws + WS_H2S);
    for (int bt = 0; bt < 8; ++bt) {
        const int idx = wave * 64 + bt * 8 + (lane & 7); const int tl = idx >> 2; const size_t tk = (size_t)bid * 128 + tl;
        const int e = rec_e[tk * 4 + (idx & 3)], pw = rec_pos[tk * 4 + (idx & 3)];
        const int slot = tbl[T_PADSTART + e] + tbl[T_BLOCKBASE + e] + tbl[T_WB + (tl >> 4) * 32 + e] + pw;
        if (lane < 8) { slot_of[tk * 4 + (idx & 3)] = slot; slot_gate[slot] = rec_gate[tk * 4 + (idx & 3)]; }
        u32x4 v0[8], v1[8];
#pragma unroll
        for (int i = 0; i < 8; ++i) { const size_t tki = (size_t)bid * 128 + ((wave * 64 + bt * 8 + i) >> 2);
            v0[i] = *(const u32x4*)(H2 + tki * D + 8 * lane); v1[i] = *(const u32x4*)(H2 + tki * D + 512 + 8 * lane); }
#pragma unroll
        for (int i = 0; i < 8; ++i) { const int sl = __shfl(slot, i);
            *(u32x4*)(H2S + (size_t)sl * D + 8 * lane) = v0[i]; *(u32x4*)(H2S + (size_t)sl * D + 512 + 8 * lane) = v1[i]; }
    }
}

__device__ __forceinline__ void combine_phase(const Params& p, int bid, int G) {
    const int tid = threadIdx.x, lane = tid & 63, wave = __builtin_amdgcn_readfirstlane(tid >> 6);
    const int gw = bid * NWAVES + wave, NGW = G * NWAVES;
    const int* slot_of = (const int*)(p.ws + WS_SLOT_OF); const bf16_t* Y = (const bf16_t*)(p.ws + WS_Y);
    for (int tk = gw; tk < NTOK; tk += NGW) {
        int sl[4];
#pragma unroll
        for (int r = 0; r < 4; ++r) sl[r] = slot_of[(size_t)tk * 4 + r];
        float* orow = p.out + (size_t)tk * D;
#pragma unroll
        for (int j = 0; j < 4; ++j) { f32x4 a = *(const f32x4*)(orow + 4 * lane + 256 * j);
#pragma unroll
            for (int r = 0; r < 4; ++r) { const u32x2 y = *(const u32x2*)(Y + (size_t)sl[r] * D + 4 * lane + 256 * j); a.x += bf_lo(y.x); a.y += bf_hi(y.x); a.z += bf_lo(y.y); a.w += bf_hi(y.y); }
            *(f32x4*)(orow + 4 * lane + 256 * j) = a; }
    }
}

constexpr int NPH = 11;
__global__ void __launch_bounds__(NTHREADS, 2) mega(Params p) {
    extern __shared__ __attribute__((aligned(16))) unsigned char lds_raw[];
    LAS unsigned char* lds = (LAS unsigned char*)lds_raw;
    cg::grid_group grid = cg::this_grid();
    const int bid = blockIdx.x, G = gridDim.x;
    unsigned char* ws = p.ws;
#ifndef PH_MASK
#define PH_MASK 0x7ff
#endif
#define IN(k) (((PH_MASK >> (k)) & 1) && p.ph_lo <= (k) && (k) < p.ph_hi)
#ifndef PH_DUP
#define PH_DUP 0
#endif
#define DUP(k) (((PH_DUP >> (k)) & 1) ? 2 : 1)
#define SEAM(k) do { if (IN(k) && IN((k) + 1)) grid.sync(); } while (0)
    if (IN(0)) for (int rep = 0; rep < DUP(0); ++rep) { if (rep) grid.sync(); phase0(p, lds, bid, G); }
    SEAM(0);
    if (IN(1)) for (int rep = 0; rep < DUP(1); ++rep) { if (rep) grid.sync();
        pg8::Gemm g{(const bf16_t*)(ws + WS_XN), (const bf16_t*)(ws + WS_WIN), NTOK, INWP, D}; pg8::StaticOrder S; S.init(NTOK, INWP, G, bid);
        EpiInProj E{(bf16_t*)(ws + WS_Q), (bf16_t*)(ws + WS_K), (bf16_t*)(ws + WS_VT), (bf16_t*)(ws + WS_QI), (bf16_t*)(ws + WS_KI), (bf16_t*)(ws + WS_POOL), (bf16_t*)(ws + WS_GA), (bf16_t*)(ws + WS_GP),
                    (float*)(ws + WS_WI), (const float*)(ws + WS_CS), p.q_norm_g, p.k_norm_g, p.idx_g, p.idx_b};
        pg8::gemm_phase(lds, g, S, E);
    }
    SEAM(1);
    if (IN(2)) for (int rep = 0; rep < DUP(2); ++rep) { if (rep) grid.sync(); pool_phase(p, bid, G); attn_phase(p, lds, bid, G); }
    SEAM(2);
    if (IN(3)) for (int rep = 0; rep < DUP(3); ++rep) { if (rep) grid.sync();
        pg8::Gemm g{(const bf16_t*)(ws + WS_ATTN), (const bf16_t*)(ws + WS_WA), NTOK, D, 512}; pg8::StaticOrder S; S.init(NTOK, D, G, bid);
        EpiGateMul E{(const bf16_t*)(ws + WS_GA), nullptr, (bf16_t*)(ws + WS_TA)};
        pg8::gemm_phase(lds, g, S, E);
    }
    SEAM(3);
    if (IN(4)) for (int rep = 0; rep < DUP(4); ++rep) { if (rep) grid.sync();
        pg8::Gemm g{(const bf16_t*)(ws + WS_MIXED), (const bf16_t*)(ws + WS_WEFF), NTOK, D, 512}; pg8::StaticOrder S; S.init(NTOK, D, G, bid);
        EpiGateMul E{(const bf16_t*)(ws + WS_GP), (const bf16_t*)(ws + WS_TA), (bf16_t*)(ws + WS_MERGED)};
        pg8::gemm_phase(lds, g, S, E);
    }
    SEAM(4);
    if (IN(5)) for (int rep = 0; rep < DUP(5); ++rep) { if (rep) grid.sync();
        pg8::Gemm g{(const bf16_t*)(ws + WS_MERGED), (const bf16_t*)(ws + WS_WOUT), NTOK, D, D}; pg8::StaticOrder S; S.init(NTOK, D, G, bid);
        EpiResid E{p.x, p.out};
        pg8::gemm_phase(lds, g, S, E);
    }
    SEAM(5);
    if (IN(6)) for (int rep = 0; rep < DUP(6); ++rep) { if (rep) grid.sync(); router_phase(p, lds, bid, G); }
    SEAM(6);
    if (IN(7)) for (int rep = 0; rep < DUP(7); ++rep) { if (rep) grid.sync(); permute_phase(p, lds, bid, G); }
    SEAM(7);
    if (IN(8)) for (int rep = 0; rep < DUP(8); ++rep) { if (rep) grid.sync();
        LAS int* tbl = (LAS int*)(lds + MISC_OFF); moe_tables(p, tbl, bid);
        pg8::Gemm g{(const bf16_t*)(ws + WS_H2S), (const bf16_t*)(ws + WS_WGU), NSLOT, NEXP * 2048, D}; pg8::MoeOrder<8> S{tbl + T_TSTART, G, bid};
        EpiGateUp E{p.b_gu, (bf16_t*)(ws + WS_ACT)};
        pg8::gemm_phase(lds, g, S, E);
    }
    SEAM(8);
    if (IN(9)) for (int rep = 0; rep < DUP(9); ++rep) { if (rep) grid.sync();
        LAS int* tbl = (LAS int*)(lds + MISC_OFF); moe_tables(p, tbl, bid);
        pg8::Gemm g{(const bf16_t*)(ws + WS_ACT), (const bf16_t*)(ws + WS_WD), NSLOT, NEXP * 1024, D}; pg8::MoeOrder<4> S{tbl + T_TSTART, G, bid};
        EpiDown E{p.b_d, (const float*)(ws + WS_SLOT_GATE), (bf16_t*)(ws + WS_Y)};
        pg8::gemm_phase(lds, g, S, E);
    }
    SEAM(9);
    if (IN(10)) combine_phase(p, bid, G);
#undef IN
#undef SEAM
}

extern "C" void kernel_launch(void* const* d_in, const int* in_sizes, int n_in, void* d_out, int out_size, void* d_ws, size_t ws_size, hipStream_t stream) {
    static int grid = 0;
    if (grid == 0) {
        if (n_in != 20 || out_size != NTOK * D || ws_size < WS_END) { fprintf(stderr, "kernel_launch: unexpected shapes: n_in %d out %d ws %zu (need %zu)\n", n_in, out_size, ws_size, (size_t)WS_END); grid = -1; return; }
        int dev = 0, cus = 0, per_cu = 0;
        hipGetDevice(&dev); hipDeviceGetAttribute(&cus, hipDeviceAttributeMultiprocessorCount, dev);
        if (hipFuncSetAttribute((const void*)mega, hipFuncAttributeMaxDynamicSharedMemorySize, LDS_BYTES) != hipSuccess) { fprintf(stderr, "kernel_launch: hipFuncSetAttribute failed\n"); grid = -1; return; }
        if (hipOccupancyMaxActiveBlocksPerMultiprocessor(&per_cu, (const void*)mega, NTHREADS, LDS_BYTES) != hipSuccess || per_cu < 1) { fprintf(stderr, "kernel_launch: occupancy query says %d blocks per CU\n", per_cu); per_cu = 1; }
        (void)hipGetLastError();
        grid = cus;
        if (grid != 256) fprintf(stderr, "kernel_launch: %d CUs; the router / permute phases assume a 256-workgroup grid\n", grid);
    }
    if (grid < 0) return;
    Params p{};
    p.x = (const float*)d_in[0]; p.pos = (const int*)d_in[1]; p.norm1_g = (const float*)d_in[2]; p.w_in = (const float*)d_in[3]; p.q_norm_g = (const float*)d_in[4];
    p.k_norm_g = (const float*)d_in[5]; p.idx_g = (const float*)d_in[6]; p.idx_b = (const float*)d_in[7]; p.w_a = (const float*)d_in[8]; p.pool_mix = (const float*)d_in[9];
    p.pool_scale = (const float*)d_in[10]; p.w_b = (const float*)d_in[11]; p.w_out = (const float*)d_in[12]; p.norm2_g = (const float*)d_in[13]; p.router_w = (const float*)d_in[14];
    p.router_b = (const float*)d_in[15]; p.w_gu = (const float*)d_in[16]; p.b_gu = (const float*)d_in[17]; p.w_d = (const float*)d_in[18]; p.b_d = (const float*)d_in[19];
    p.out = (float*)d_out; p.ws = (unsigned char*)d_ws;
#if MK_MODE == 0
    p.ph_lo = 0; p.ph_hi = NPH;
    void* args[] = {&p};
    hipError_t e = hipLaunchCooperativeKernel((const void*)mega, dim3(grid), dim3(NTHREADS), args, LDS_BYTES, stream);
    if (e != hipSuccess) fprintf(stderr, "kernel_launch: cooperative launch failed: %s (grid %d)\n", hipGetErrorString(e), grid);
#else
    for (int k = 0; k < NPH; ++k) { p.ph_lo = k; p.ph_hi = k + 1; hipLaunchKernelGGL(mega, dim3(grid), dim3(NTHREADS), LDS_BYTES, stream, p); }
#endif
}
```

```cpp
#include <hip/hip_runtime.h>
#include <hip/hip_cooperative_groups.h>
#include <cstdio>
#include <cstdint>
#include <cmath>
namespace cg = cooperative_groups;

#ifndef MK_MODE
#define MK_MODE 0
#endif

#define LAS __attribute__((address_space(3)))
typedef unsigned short bf16_t;
typedef short bf16x8 __attribute__((ext_vector_type(8)));
typedef float f32x2 __attribute__((ext_vector_type(2)));
typedef float f32x4 __attribute__((ext_vector_type(4)));
typedef float f32x16 __attribute__((ext_vector_type(16)));
typedef unsigned u32x2 __attribute__((ext_vector_type(2)));
typedef unsigned u32x4 __attribute__((ext_vector_type(4)));

constexpr int D = 1024, NBATCH = 8, SEQ = 4096, NTOK = NBATCH * SEQ;
constexpr int NEXP = 32, TOPK = 4;
constexpr int INW = 3652, INWP = 3840;
constexpr int NSLOT = 139264;
constexpr float NORM_EPS = 1e-6f;
constexpr int NWAVES = 8, NTHREADS = 512;
constexpr int LDS_BYTES = 147456;
constexpr int RING_BYTES = 131072;
constexpr int MISC_OFF = 135168;

constexpr size_t MiB = 1u << 20;
constexpr size_t WS_CTL = 0;
constexpr size_t WS_BCNT = 64 * 1024;
constexpr size_t WS_WCNT = 128 * 1024;
constexpr size_t WS_CS = 2 * MiB;
constexpr size_t WS_WIN = 16 * MiB;
constexpr size_t WS_WCAT = 24 * MiB;
constexpr size_t WS_WOUT = 26 * MiB;
constexpr size_t WS_WGU = 28 * MiB;
constexpr size_t WS_WD = 156 * MiB;
constexpr size_t WS_REC_E = 220 * MiB;
constexpr size_t WS_REC_POS = 221 * MiB;
constexpr size_t WS_REC_GATE = 222 * MiB;
constexpr size_t WS_SLOT_OF = 223 * MiB;
constexpr size_t WS_SLOT_GATE = 223 * MiB + 512 * 1024;
constexpr size_t WS_XN = 226 * MiB;
constexpr size_t WS_Q = 290 * MiB;
constexpr size_t WS_K = 322 * MiB;
constexpr size_t WS_VT = 330 * MiB;
constexpr size_t WS_QI = 338 * MiB;
constexpr size_t WS_KI = 354 * MiB;
constexpr size_t WS_WI = 358 * MiB;
constexpr size_t WS_POOL = 360 * MiB;
constexpr size_t WS_GA = 392 * MiB;
constexpr size_t WS_GP = 456 * MiB;
constexpr size_t WS_ACAT = 520 * MiB;
constexpr size_t WS_TA = 584 * MiB;
constexpr size_t WS_MASK = WS_TA;
constexpr size_t WS_MERGED = 648 * MiB;
constexpr size_t WS_H2 = WS_XN;
constexpr size_t WS_H2S = 290 * MiB;
constexpr size_t WS_Y = WS_H2S;
constexpr size_t WS_ACT = 562 * MiB;
constexpr size_t WS_END = 834 * MiB;
static_assert(WS_SLOT_GATE + (size_t)NSLOT * 4 <= WS_XN, "ws map");

__device__ __forceinline__ unsigned cvt_pk_bf16(float lo, float hi) { unsigned r; asm volatile("v_cvt_pk_bf16_f32 %0, %1, %2" : "=v"(r) : "v"(lo), "v"(hi)); return r; }
__device__ __forceinline__ float bf_lo(unsigned w) { return __uint_as_float(w << 16); }
__device__ __forceinline__ float bf_hi(unsigned w) { return __uint_as_float(w & 0xffff0000u); }
__device__ __forceinline__ float wave_sum(float v) {
#pragma unroll
    for (int o = 1; o < 64; o <<= 1) v += __shfl_xor(v, o);
    return v;
}
__device__ __forceinline__ float sigmoidf_(float x) { return 1.0f / (1.0f + __expf(-x)); }
#define LDS_WAIT() asm volatile("s_waitcnt lgkmcnt(0)" ::: "memory")

__host__ __device__ __forceinline__ int idx_bj_j(int d, int& bj) {
    int j;
    if (d < 16) { bj = 0; j = d; } else if (d < 32) { bj = 1; j = d - 16; } else if (d < 48) { bj = 0; j = d - 16; } else { bj = 1; j = d - 32; }
    return j;
}
__host__ __device__ __forceinline__ int win_phys(int n) {
    if (n < 512) { const int h = n >> 6, d = n & 63; return 256 * (h >> 2) + 128 * (d >> 5) + 32 * (h & 3) + (d & 31); }
    if (n < 768) { const int h = (n - 512) >> 6, d = n & 63; return 512 + 128 * (d >> 5) + 32 * h + (d & 31); }
    if (n < 1024) { const int h = (n - 768) >> 6, d = n & 63; int bj; const int j = idx_bj_j(d, bj); return 768 + 128 * bj + 32 * h + j; }
    if (n < 1088) { const int d = n - 1024; int bj; const int j = idx_bj_j(d, bj); return 1024 + 128 * bj + j; }
    if (n < 1092) return 1024 + 32 + (n - 1088);
    if (n < 1604) return 1280 + (n - 1092);
    if (n < 2628) return 1792 + (n - 1604);
    return 2816 + (n - 2628);
}

namespace pg8 {
constexpr int BM = 256, BK = 64, HALF = 128, HTB = HALF * BK * 2, STAGE_BYTES = 8 * HTB, NXCD = 8, WGM = 8;
__host__ __device__ __forceinline__ int lds_byte(int r, int c) { const int st = (r >> 4) * 2 + (c >> 5), rr = r & 15, cc = c & 31, ob = rr * 64 + cc * 2; return st * 1024 + (ob ^ (((ob >> 9) & 1) << 5)); }
__host__ __device__ __forceinline__ void stage_rc(int b, int& R, int& C) { const int st = b / 1024, sb = b % 1024, swz = sb ^ (((sb >> 9) & 1) << 5); R = (st >> 1) * 16 + swz / 64; C = (st & 1) * 32 + (swz % 64) / 2; }
__host__ __device__ __forceinline__ int perm32(int rho) { const int n = rho >> 4, i = rho & 15; return 8 * (i >> 2) + 4 * n + (i & 3); }

struct Unit { int pm, pn; };
struct Gemm { const bf16_t* A; const bf16_t* Bt; int M, N, K; };

struct StaticOrder {
    int nM, nN, nwg, G, c;
    __device__ void init(int M, int N, int G_, int c_) { nM = M / BM; nN = N / BM; nwg = nM * nN; G = G_; c = c_; }
    __device__ bool next(int i, Unit& u) const {
        const long L = (long)i * G + c; if (L >= nwg) return false;
        int wgid = (int)L; { const int q = nwg / NXCD, r = nwg % NXCD, xcd = wgid % NXCD, off = wgid / NXCD; wgid = (xcd < r ? xcd * (q + 1) : r * (q + 1) + (xcd - r) * q) + off; }
        const int nig = WGM * nN, gid = wgid / nig, fm = gid * WGM, gsz = (nM - fm) < WGM ? (nM - fm) : WGM;
        u.pm = fm + ((wgid % nig) % gsz); u.pn = (wgid % nig) / gsz; return true;
    }
};
template <int NPN> struct MoeOrder {
    const LAS int* tstart; int G, c;
    __device__ bool next(int i, Unit& u) const {
        const int L = i * G + c; const int ntile = tstart[NEXP];
        if (L >= ntile * NPN) return false;
        const int ti = L / NPN, pn = L % NPN; int e = 0;
#pragma unroll
        for (int k = 1; k < NEXP; ++k) e += (tstart[k] <= ti) ? 1 : 0;
        u.pm = ti; u.pn = e * NPN + pn; return true;
    }
};

template <class Epi, class Sched>
__device__ __forceinline__ void gemm_phase(LAS unsigned char* lds, const Gemm g, const Sched& S, const Epi& E) {
    const int tid = threadIdx.x, wid = __builtin_amdgcn_readfirstlane(tid >> 6), lane = tid & 63, wr = wid >> 2, wc = wid & 3, fr = lane & 15, fq = lane >> 4;
    const int K = g.K, nt = K / BK;
    unsigned voffA[2], voffB[2];
#pragma unroll
    for (int i = 0; i < 2; ++i) { int R, C; stage_rc(tid * 16 + i * 8192, R, C); const int Rb = (R & ~31) + perm32(R & 31);
        voffA[i] = (unsigned)(R * K + C) * 2u; voffB[i] = (unsigned)(Rb * K + C) * 2u; }
    const size_t kstep = (size_t)(BK * 2);
    const size_t hstep = (size_t)HALF * K * 2;
    const size_t tstep = 2 * hstep;
    const unsigned ldsw = (unsigned)wid * 1024u;
    const int aoff = lds_byte(wr * 64 + fr, fq * 8), boff = lds_byte(wc * 32 + fr, fq * 8);
#define PG8_SA(b, h) (((b) * 2 + (h)) * HTB)
#define PG8_SB(b, h) ((4 + (b) * 2 + (h)) * HTB)
#define PG8_STAGE(bufoff, gbase, voff) do { _Pragma("unroll") for (int _i = 0; _i < 2; ++_i) \
        __builtin_amdgcn_global_load_lds((const unsigned*)((const char*)(gbase) + (voff)[_i]), (LAS unsigned*)(lds + (bufoff) + ldsw + _i * 8192), 16, 0, 0); } while (0)
#define PG8_LDA(dst, b, h) do { _Pragma("unroll") for (int m = 0; m < 4; ++m) _Pragma("unroll") for (int k = 0; k < 2; ++k) dst[m][k] = *(const LAS bf16x8*)(lds + PG8_SA(b, h) + aoff + m * 2048 + k * 1024); } while (0)
#define PG8_LDB(dst, b, h) do { _Pragma("unroll") for (int n = 0; n < 2; ++n) _Pragma("unroll") for (int k = 0; k < 2; ++k) dst[n][k] = *(const LAS bf16x8*)(lds + PG8_SB(b, h) + boff + n * 2048 + k * 1024); } while (0)
#define PG8_MMA(ai, bj, At, Bt) do { __builtin_amdgcn_s_setprio(1); _Pragma("unroll") for (int m = 0; m < 4; ++m) _Pragma("unroll") for (int n = 0; n < 2; ++n) _Pragma("unroll") for (int k = 0; k < 2; ++k) \
        acc[ai][bj][m][n] = __builtin_amdgcn_mfma_f32_16x16x32_bf16(Bt[n][k], At[m][k], acc[ai][bj][m][n], 0, 0, 0); __builtin_amdgcn_s_setprio(0); } while (0)
#define PG8_WAIT_V(n) asm volatile("s_waitcnt vmcnt(" #n ")" ::: "memory")
#define PG8_WAIT_L(n) asm volatile("s_waitcnt lgkmcnt(" #n ")" ::: "memory")
#define PG8_BAR __builtin_amdgcn_s_barrier()
#define PG8_SCHED __builtin_amdgcn_sched_barrier(0)
    Unit cur, nxt; int ui = 0;
    if (!S.next(0, cur)) return;
    f32x4 acc[2][2][4][2];
#pragma unroll
    for (int a = 0; a < 2; ++a)
#pragma unroll
        for (int b = 0; b < 2; ++b)
#pragma unroll
            for (int m = 0; m < 4; ++m)
#pragma unroll
                for (int n = 0; n < 2; ++n) acc[a][b][m][n] = (f32x4){0.f, 0.f, 0.f, 0.f};
    bf16x8 At[4][2], B0[2][2], B1[2][2];
    const char* cA = (const char*)g.A + (size_t)cur.pm * tstep; const char* cB = (const char*)g.Bt + (size_t)cur.pn * tstep;
    PG8_STAGE(PG8_SB(0, 0), cB, voffB); PG8_STAGE(PG8_SB(0, 1), cB + hstep, voffB); PG8_STAGE(PG8_SA(0, 0), cA, voffA); PG8_STAGE(PG8_SA(0, 1), cA + hstep, voffA);
    if (wr == 1) PG8_BAR;
    PG8_WAIT_V(2); PG8_BAR;
    PG8_STAGE(PG8_SB(1, 0), cB + kstep, voffB); PG8_STAGE(PG8_SA(1, 0), cA + kstep, voffA); PG8_STAGE(PG8_SB(1, 1), cB + hstep + kstep, voffB);
    PG8_WAIT_V(6); PG8_BAR;
    for (;;) {
        const bool has_next = S.next(ui + 1, nxt);
        const char* nA = has_next ? (const char*)g.A + (size_t)nxt.pm * tstep : cA; const char* nB = has_next ? (const char*)g.Bt + (size_t)nxt.pn * tstep : cB;
        for (int t = 0; t < nt; t += 2) {
            const bool last = (t == nt - 2);
            const char* a1 = cA + (size_t)(t + 1) * kstep;
            const char* a2 = last ? nA : cA + (size_t)(t + 2) * kstep; const char* b2 = last ? nB : cB + (size_t)(t + 2) * kstep;
            const char* a3 = a2 + kstep; const char* b3 = b2 + kstep;
            PG8_LDB(B0, 0, 0); PG8_LDB(B1, 0, 1); PG8_SCHED; PG8_LDA(At, 0, 0); PG8_STAGE(PG8_SA(1, 1), a1 + hstep, voffA);
            PG8_WAIT_V(8); PG8_WAIT_L(0); PG8_BAR; PG8_MMA(0, 0, At, B0); PG8_MMA(0, 1, At, B1); PG8_BAR; PG8_SCHED;
            PG8_LDA(At, 0, 1); PG8_STAGE(PG8_SB(0, 0), b2, voffB); PG8_STAGE(PG8_SB(0, 1), b2 + hstep, voffB); PG8_STAGE(PG8_SA(0, 0), a2, voffA);
            PG8_WAIT_V(8); PG8_WAIT_L(0); PG8_BAR; PG8_MMA(1, 0, At, B0); PG8_MMA(1, 1, At, B1); PG8_BAR; PG8_SCHED;
            PG8_LDB(B0, 1, 0); PG8_LDB(B1, 1, 1); PG8_SCHED; PG8_LDA(At, 1, 0); PG8_STAGE(PG8_SA(0, 1), a2 + hstep, voffA);
            PG8_WAIT_V(8); PG8_WAIT_L(0); PG8_BAR; PG8_MMA(0, 0, At, B0); PG8_MMA(0, 1, At, B1); PG8_BAR; PG8_SCHED;
            PG8_LDA(At, 1, 1); PG8_STAGE(PG8_SB(1, 0), b3, voffB); PG8_STAGE(PG8_SB(1, 1), b3 + hstep, voffB); PG8_STAGE(PG8_SA(1, 0), a3, voffA);
            PG8_WAIT_V(8); PG8_WAIT_L(0); PG8_BAR; PG8_MMA(1, 0, At, B0); PG8_MMA(1, 1, At, B1); PG8_BAR; PG8_SCHED;
            if constexpr (Epi::MIDK) { if (t == nt / 2 - 2) E.mid(acc, cur, wr, wc, fr, fq); }
        }
        if (wr == 0) PG8_BAR;
        E(acc, cur, wr, wc, fr, fq);
        if (!has_next) break;
#pragma unroll
        for (int a = 0; a < 2; ++a)
#pragma unroll
            for (int b = 0; b < 2; ++b)
#pragma unroll
                for (int m = 0; m < 4; ++m)
#pragma unroll
                    for (int n = 0; n < 2; ++n) acc[a][b][m][n] = (f32x4){0.f, 0.f, 0.f, 0.f};
        cur = nxt; cA = nA; cB = nB; ++ui;
        if (wr == 1) PG8_BAR;
    }
    PG8_WAIT_V(0);
    PG8_BAR;
#undef PG8_SA
#undef PG8_SB
#undef PG8_STAGE
#undef PG8_LDA
#undef PG8_LDB
#undef PG8_MMA
#undef PG8_WAIT_V
#undef PG8_WAIT_L
#undef PG8_BAR
#undef PG8_SCHED
}
}

struct Params {
    const float* x; const int* pos; const float* norm1_g; const float* w_in; const float* q_norm_g; const float* k_norm_g;
    const float* idx_g; const float* idx_b; const float* w_a; const float* pool_mix; const float* pool_scale; const float* w_b;
    const float* w_out; const float* norm2_g; const float* router_w; const float* router_b; const float* w_gu; const float* b_gu;
    const float* w_d; const float* b_d;
    float* out; unsigned char* ws; int ph_lo, ph_hi;
};

using pg8::Unit; using pg8::HALF;
__device__ __forceinline__ void st8(bf16_t* p, const float (&v)[8]) {
    u32x4 w; w.x = cvt_pk_bf16(v[0], v[1]); w.y = cvt_pk_bf16(v[2], v[3]); w.z = cvt_pk_bf16(v[4], v[5]); w.w = cvt_pk_bf16(v[6], v[7]); *(u32x4*)p = w;
}
__device__ __forceinline__ void ld8f(const float* p, float (&v)[8]) { const f32x4 a = *(const f32x4*)p, b = *(const f32x4*)(p + 4); v[0]=a[0]; v[1]=a[1]; v[2]=a[2]; v[3]=a[3]; v[4]=b[0]; v[5]=b[1]; v[6]=b[2]; v[7]=b[3]; }
__device__ __forceinline__ void ld8bf(const bf16_t* p, float (&v)[8]) { const u32x4 w = *(const u32x4*)p; v[0]=bf_lo(w.x); v[1]=bf_hi(w.x); v[2]=bf_lo(w.y); v[3]=bf_hi(w.y); v[4]=bf_lo(w.z); v[5]=bf_hi(w.z); v[6]=bf_lo(w.w); v[7]=bf_hi(w.w); }

struct EpiInProj {
    static constexpr bool MIDK = false;
    bf16_t *Q, *Kb, *Vb, *Qi, *Ki, *Pool, *Ga, *Gp; float* Wi; const float* cs; const float *gq, *gk, *lng, *lnb;
    __device__ __forceinline__ void operator()(const f32x4 (&acc)[2][2][4][2], const Unit& u, int wr, int wc, int fr, int fq) const {
        const int pn = u.pn;
#pragma unroll
        for (int ai = 0; ai < 2; ++ai)
#pragma unroll
            for (int m = 0; m < 4; ++m) {
                const int row = u.pm * 256 + ai * HALF + wr * 64 + m * 16 + fr;
                float v0[8], v1[8];
#pragma unroll
                for (int n = 0; n < 2; ++n)
#pragma unroll
                    for (int i = 0; i < 4; ++i) { v0[4 * n + i] = acc[ai][0][m][n][i]; v1[4 * n + i] = acc[ai][1][m][n][i]; }
                if (pn <= 1 || (pn == 2 && wc < 2)) {
                    float ss = 0.f;
#pragma unroll
                    for (int j = 0; j < 8; ++j) ss += v0[j] * v0[j] + v1[j] * v1[j];
                    ss += __shfl_xor(ss, 16); ss += __shfl_xor(ss, 32);
                    const float rs = 1.0f / sqrtf(ss * (1.0f / 64.0f) + NORM_EPS);
                    const float* gg = (pn <= 1) ? gq : gk; const float sc = (pn <= 1) ? 0.18033688011112042f : 1.0f;
                    float g0[8], g1[8], cc[8], sn[8];
                    ld8f(gg + 8 * fq, g0); ld8f(gg + 32 + 8 * fq, g1);
                    ld8f(cs + (size_t)row * 96 + 8 * fq, cc); ld8f(cs + (size_t)row * 96 + 48 + 8 * fq, sn);
                    float o0[8], o1[8];
#pragma unroll
                    for (int j = 0; j < 8; ++j) { const float x1 = v0[j] * rs * g0[j], x2 = v1[j] * rs * g1[j]; o0[j] = (x1 * cc[j] - x2 * sn[j]) * sc; o1[j] = (x2 * cc[j] + x1 * sn[j]) * sc; }
                    if (pn <= 1) { bf16_t* dst = Q + (size_t)row * 512 + (4 * pn + wc) * 64; st8(dst + 8 * fq, o0); st8(dst + 32 + 8 * fq, o1); }
                    else {
                        bf16_t* dst = Kb + ((((size_t)((row >> 12) * 2 + wc) * 128 + ((row & 4095) >> 5)) * 4 + (fq >> 1)) * 64 + ((fq & 1) * 32 + (row & 31))) * 8;
                        st8(dst, o0); st8(dst + 2 * 512, o1); }
                } else if (pn == 2) {
                    const int t = row & 4095, kk = t & 31;
                    bf16_t* dst = Vb + (((size_t)((row >> 12) * 2 + (wc - 2)) * 128 + (t >> 5)) * 4 + (kk >> 4)) * 512 + (((kk >> 2) & 1) * 32 + 8 * fq) * 8 + 4 * ((kk >> 3) & 1) + (kk & 3);
#pragma unroll
                    for (int j = 0; j < 8; ++j) { dst[j * 8] = (bf16_t)(cvt_pk_bf16(v0[j], v0[j]) & 0xffffu); dst[2 * 512 + j * 8] = (bf16_t)(cvt_pk_bf16(v1[j], v1[j]) & 0xffffu); }
                } else if (pn == 3 || (pn == 4 && wc == 0)) {
                    if (pn == 4) {
                        float s = 0.f;
#pragma unroll
                        for (int j = 0; j < 8; ++j) s += v0[j] + v1[j];
                        s += __shfl_xor(s, 16); s += __shfl_xor(s, 32);
                        const float mu = s * (1.0f / 64.0f); float q = 0.f;
#pragma unroll
                        for (int j = 0; j < 8; ++j) { v0[j] -= mu; v1[j] -= mu; q += v0[j] * v0[j] + v1[j] * v1[j]; }
                        q += __shfl_xor(q, 16); q += __shfl_xor(q, 32);
                        const float rs = 1.0f / sqrtf(q * (1.0f / 64.0f) + NORM_EPS);
                        const int d0 = (fq < 2) ? 8 * fq : 8 * fq + 16, d1 = (fq < 2) ? 16 + 8 * fq : 8 * fq + 32;
                        float a0[8], a1[8], b0[8], b1[8];
                        ld8f(lng + d0, a0); ld8f(lng + d1, a1); ld8f(lnb + d0, b0); ld8f(lnb + d1, b1);
#pragma unroll
                        for (int j = 0; j < 8; ++j) { v0[j] = v0[j] * rs * a0[j] + b0[j]; v1[j] = v1[j] * rs * a1[j] + b1[j]; }
                    }
                    bf16_t* dst = Qi + (size_t)row * 256 + wc * 64;
                    bf16_t* kdst = Ki + (((size_t)(row >> 12) * 128 + ((row & 4095) >> 5)) * 4 * 64 + (row & 31)) * 8;
                    if (fq < 2) {
                        float cc[8], sn[8];
                        ld8f(cs + (size_t)row * 96 + 32 + 8 * fq, cc); ld8f(cs + (size_t)row * 96 + 48 + 32 + 8 * fq, sn);
                        float o0[8], o1[8];
#pragma unroll
                        for (int j = 0; j < 8; ++j) { o0[j] = v0[j] * cc[j] - v1[j] * sn[j]; o1[j] = v1[j] * cc[j] + v0[j] * sn[j]; }
                        if (pn == 3) { st8(dst + 8 * fq, o0); st8(dst + 16 + 8 * fq, o1); }
                        else { st8(kdst + (fq * 32) * 8, o0); st8(kdst + (64 + fq * 32) * 8, o1); }
                    } else {
                        if (pn == 3) { st8(dst + 8 * fq + 16, v0); st8(dst + 8 * fq + 32, v1); }
                        else { st8(kdst + (2 * 64 + (fq - 2) * 32) * 8, v0); st8(kdst + (3 * 64 + (fq - 2) * 32) * 8, v1); } }
                } else if (pn == 4) {
                    if (wc == 1 && fq == 0) *(f32x4*)(Wi + (size_t)row * 4) = (f32x4){v0[0] * 0.0625f, v0[1] * 0.0625f, v0[2] * 0.0625f, v0[3] * 0.0625f};
                } else if (pn <= 6) {
                    bf16_t* dst = Pool + (size_t)row * 512 + (pn - 5) * 256 + wc * 32 + 8 * fq;
                    st8(dst, v0); st8(dst + HALF, v1);
                } else {
                    bf16_t* dst = ((pn <= 10) ? Ga + (size_t)row * 1024 + (pn - 7) * 256 : Gp + (size_t)row * 1024 + (pn - 11) * 256) + wc * 32 + 8 * fq;
#pragma unroll
                    for (int j = 0; j < 8; ++j) { v0[j] = sigmoidf_(v0[j]); v1[j] = sigmoidf_(v1[j]); }
                    st8(dst, v0); st8(dst + HALF, v1);
                }
            }
    }
};

struct EpiGated {
    static constexpr bool MIDK = true;
    const bf16_t* Ga; const bf16_t* Gp; bf16_t* O;
    __device__ __forceinline__ void mid(f32x4 (&acc)[2][2][4][2], const Unit& u, int wr, int wc, int fr, int fq) const {
        asm volatile("" : "+v"(fr), "+v"(fq));
#pragma unroll
        for (int ai = 0; ai < 2; ++ai)
#pragma unroll
            for (int m = 0; m < 4; ++m) {
                const size_t off = (size_t)(u.pm * 256 + ai * HALF + wr * 64 + m * 16 + fr) * 1024 + u.pn * 256 + wc * 32 + 8 * fq;
#pragma unroll
                for (int bj = 0; bj < 2; ++bj) {
                    float ga[8], gp[8]; ld8bf(Ga + off + bj * HALF, ga); ld8bf(Gp + off + bj * HALF, gp);
#pragma unroll
                    for (int n = 0; n < 2; ++n)
#pragma unroll
                        for (int i = 0; i < 4; ++i) acc[ai][bj][m][n][i] *= ga[4 * n + i] * __builtin_amdgcn_rcpf(fmaxf(gp[4 * n + i], 1e-30f));
                }
                if (m & 1) asm volatile("" ::: "memory");
            }
    }
    __device__ __forceinline__ void operator()(const f32x4 (&acc)[2][2][4][2], const Unit& u, int wr, int wc, int fr, int fq) const {
        asm volatile("" : "+v"(fr), "+v"(fq));
#pragma unroll
        for (int ai = 0; ai < 2; ++ai)
#pragma unroll
            for (int m = 0; m < 4; ++m) {
                const size_t off = (size_t)(u.pm * 256 + ai * HALF + wr * 64 + m * 16 + fr) * 1024 + u.pn * 256 + wc * 32 + 8 * fq;
#pragma unroll
                for (int bj = 0; bj < 2; ++bj) {
                    float g[8], o[8]; ld8bf(Gp + off + bj * HALF, g);
#pragma unroll
                    for (int n = 0; n < 2; ++n)
#pragma unroll
                        for (int i = 0; i < 4; ++i) o[4 * n + i] = g[4 * n + i] * acc[ai][bj][m][n][i];
                    st8(O + off + bj * HALF, o);
                }
            }
    }
};
struct EpiResid {
    static constexpr bool MIDK = false;
    const float* X; float* O;
    __device__ __forceinline__ void operator()(const f32x4 (&acc)[2][2][4][2], const Unit& u, int wr, int wc, int fr, int fq) const {
#pragma unroll
        for (int ai = 0; ai < 2; ++ai)
#pragma unroll
            for (int m = 0; m < 4; ++m) {
                const size_t off = (size_t)(u.pm * 256 + ai * HALF + wr * 64 + m * 16 + fr) * 1024 + u.pn * 256 + wc * 32 + 8 * fq;
#pragma unroll
                for (int bj = 0; bj < 2; ++bj)
#pragma unroll
                    for (int n = 0; n < 2; ++n) { const size_t o = off + bj * HALF + 4 * n; *(f32x4*)(O + o) = *(const f32x4*)(X + o) + acc[ai][bj][m][n]; }
            }
    }
};
struct EpiGateUp {
    static constexpr bool MIDK = false;
    const float* bias; bf16_t* Act;
    __device__ __forceinline__ void operator()(const f32x4 (&acc)[2][2][4][2], const Unit& u, int wr, int wc, int fr, int fq) const {
        const int e = u.pn >> 3, pnl = u.pn & 7, col = pnl * 128 + wc * 32 + 8 * fq;
        float bg[8], bu[8]; ld8f(bias + (size_t)e * 2048 + col, bg); ld8f(bias + (size_t)e * 2048 + 1024 + col, bu);
#pragma unroll
        for (int ai = 0; ai < 2; ++ai)
#pragma unroll
            for (int m = 0; m < 4; ++m) {
                const size_t row = (size_t)(u.pm * 256 + ai * HALF + wr * 64 + m * 16 + fr);
                float o[8];
#pragma unroll
                for (int n = 0; n < 2; ++n)
#pragma unroll
                    for (int i = 0; i < 4; ++i) { const int j = 4 * n + i;
                        const float gt = fminf(acc[ai][0][m][n][i] + bg[j], 7.0f), up = fminf(fmaxf(acc[ai][1][m][n][i] + bu[j], -7.0f), 7.0f);
                        o[j] = gt * sigmoidf_(1.702f * gt) * (up + 1.0f); }
                st8(Act + row * 1024 + col, o);
            }
    }
};
struct EpiDown {
    static constexpr bool MIDK = false;
    const float* bias; const float* sgate; bf16_t* Y;
    __device__ __forceinline__ void operator()(const f32x4 (&acc)[2][2][4][2], const Unit& u, int wr, int wc, int fr, int fq) const {
        const int e = u.pn >> 2, pnl = u.pn & 3, col = pnl * 256 + wc * 32 + 8 * fq;
        float b0[8], b1[8]; ld8f(bias + (size_t)e * 1024 + col, b0); ld8f(bias + (size_t)e * 1024 + col + HALF, b1);
#pragma unroll
        for (int ai = 0; ai < 2; ++ai)
#pragma unroll
            for (int m = 0; m < 4; ++m) {
                const size_t row = (size_t)(u.pm * 256 + ai * HALF + wr * 64 + m * 16 + fr);
                const float gt = sgate[row];
                float o0[8], o1[8];
#pragma unroll
                for (int n = 0; n < 2; ++n)
#pragma unroll
                    for (int i = 0; i < 4; ++i) { const int j = 4 * n + i; o0[j] = (acc[ai][0][m][n][i] + b0[j]) * gt; o1[j] = (acc[ai][1][m][n][i] + b1[j]) * gt; }
                st8(Y + row * 1024 + col, o0); st8(Y + row * 1024 + col + HALF, o1);
            }
    }
};

template <class RowMap>
__device__ __forceinline__ void cvt_item(const float* W, int K, int N, bf16_t* WT, LAS float* scr, int kb, int nb, int lane, const RowMap& rm, int ldt = 0) {
    if (ldt == 0) ldt = K;
    const int k0 = kb * 64, n0 = nb * 64, n4 = lane & 15, kr = lane >> 4, n = n0 + 4 * n4;
    f32x4 v[16];
#pragma unroll
    for (int i = 0; i < 16; ++i) v[i] = (n < N) ? *(const f32x4*)(W + (size_t)(k0 + 4 * i + kr) * N + n) : (f32x4){0.f, 0.f, 0.f, 0.f};
#pragma unroll
    for (int i = 0; i < 16; ++i) { LAS float* d = scr + (4 * i + kr) * 65 + 4 * n4; d[0] = v[i][0]; d[1] = v[i][1]; d[2] = v[i][2]; d[3] = v[i][3]; }
    LDS_WAIT(); asm volatile("" ::: "memory");
    const int c8 = lane & 7;
#pragma unroll
    for (int jj = 0; jj < 8; ++jj) { const int nn = (lane >> 3) + 8 * jj; const LAS float* s = scr + (8 * c8) * 65 + nn;
        if (n0 + nn < N) { u32x4 o; o.x = cvt_pk_bf16(s[0], s[65]); o.y = cvt_pk_bf16(s[2 * 65], s[3 * 65]); o.z = cvt_pk_bf16(s[4 * 65], s[5 * 65]); o.w = cvt_pk_bf16(s[6 * 65], s[7 * 65]);
            *(u32x4*)(WT + (size_t)rm(n0 + nn) * ldt + k0 + 8 * c8) = o; } }
    LDS_WAIT(); asm volatile("" ::: "memory");
}
struct RmIdent { int off; __device__ __forceinline__ int operator()(int n) const { return off + n; } };
struct RmWin { __device__ __forceinline__ int operator()(int n) const { return win_phys(n); } };
struct RmGu { int e; __device__ __forceinline__ int operator()(int n) const { return e * 2048 + 256 * ((n & 1023) >> 7) + 128 * (n >> 10) + (n & 127); } };

__device__ __forceinline__ void phase0(const Params& p, LAS unsigned char* lds, int bid, int G) {
    const int tid = threadIdx.x, lane = tid & 63, wave = __builtin_amdgcn_readfirstlane(tid >> 6);
    const int gw = bid * NWAVES + wave, NGW = G * NWAVES;
    unsigned char* ws = p.ws;
    LAS float* scr = (LAS float*)(lds + wave * 16640);
    constexpr int I_GU = NEXP * 16 * 32, I_D = NEXP * 16 * 16, I_IN = 16 * 58, I_A = 8 * 16, I_O = 16 * 16;
    constexpr int NITEMS = I_GU + I_D + I_IN + I_A + I_O;
    for (int it = gw; it < NITEMS; it += NGW) {
        int r = it;
        if (r < I_GU) { const int e = r / 512, q = r % 512; cvt_item(p.w_gu + (size_t)e * 1024 * 2048, 1024, 2048, (bf16_t*)(ws + WS_WGU), scr, q / 32, q % 32, lane, RmGu{e}); continue; } r -= I_GU;
        if (r < I_D) { const int e = r / 256, q = r % 256; cvt_item(p.w_d + (size_t)e * 1024 * 1024, 1024, 1024, (bf16_t*)(ws + WS_WD), scr, q / 16, q % 16, lane, RmIdent{e * 1024}); continue; } r -= I_D;
        if (r < I_IN) { cvt_item(p.w_in, 1024, INW, (bf16_t*)(ws + WS_WIN), scr, r / 58, r % 58, lane, RmWin{}); continue; } r -= I_IN;
        if (r < I_A) { cvt_item(p.w_a, 512, 1024, (bf16_t*)(ws + WS_WCAT), scr, r / 16, r % 16, lane, RmIdent{0}, 1024); continue; } r -= I_A;
        cvt_item(p.w_out, 1024, 1024, (bf16_t*)(ws + WS_WOUT), scr, r / 16, r % 16, lane, RmIdent{0});
    }
    for (int it = gw; it < 16 * 4 * 16; it += NGW) {
        const int nb = it & 15, g = (it >> 4) & 3, cb = it >> 6, n = nb * 64 + lane, c0 = cb * 8;
        float a[8];
#pragma unroll
        for (int q = 0; q < 8; ++q) a[q] = 0.f;
        const float* mix = p.pool_mix + (size_t)g * 128 * 128 + (size_t)c0 * 128;
        for (int d = 0; d < 128; ++d) {
            const float wb = p.pool_scale[g * 128 + d] * p.w_b[(size_t)(g * 128 + d) * 1024 + n];
#pragma unroll
            for (int q = 0; q < 8; ++q) a[q] += mix[q * 128 + d] * wb;
        }
        st8((bf16_t*)(ws + WS_WCAT) + (size_t)n * 1024 + 512 + g * 128 + c0, a);
    }
    {
        f32x4 gv[4];
#pragma unroll
        for (int j = 0; j < 4; ++j) gv[j] = *(const f32x4*)(p.norm1_g + 4 * lane + 256 * j);
        bf16_t* XN = (bf16_t*)(ws + WS_XN);
        for (int m = gw; m < NTOK; m += NGW) {
            const f32x4* xr = (const f32x4*)(p.x + (size_t)m * D) + lane;
            f32x4 v[4]; float s = 0.f;
#pragma unroll
            for (int j = 0; j < 4; ++j) { v[j] = xr[64 * j]; s += (v[j].x * v[j].x + v[j].y * v[j].y) + (v[j].z * v[j].z + v[j].w * v[j].w); }
            const float rs = 1.0f / sqrtf(wave_sum(s) * (1.0f / D) + NORM_EPS);
#pragma unroll
            for (int j = 0; j < 4; ++j) { const f32x4 o = v[j] * rs * gv[j]; u32x2 w; w.x = cvt_pk_bf16(o.x, o.y); w.y = cvt_pk_bf16(o.z, o.w); *(u32x2*)(XN + (size_t)m * D + 4 * lane + 256 * j) = w; }
        }
    }
    {
        float* cs = (float*)(ws + WS_CS);
        for (int i = bid * NTHREADS + tid; i < NTOK * 48; i += G * NTHREADS) {
            const int row = i / 48, j = i % 48;
            const float ex = (j < 32) ? -(float)j / 32.0f : -(float)(j - 32) / 16.0f;
            const float ang = (float)p.pos[row] * powf(10000.0f, ex);
            float sn, cc; sincosf(ang, &sn, &cc);
            cs[(size_t)row * 96 + j] = cc; cs[(size_t)row * 96 + 48 + j] = sn;
        }
    }
}

__device__ __forceinline__ void pool_phase(const Params& p, int bid, int G) {
    const int tid = threadIdx.x, lane = tid & 63, wave = __builtin_amdgcn_readfirstlane(tid >> 6);
    const int gw = bid * NWAVES + wave, NGW = G * NWAVES;
    const bf16_t* Pool = (const bf16_t*)(p.ws + WS_POOL); bf16_t* Mixed = (bf16_t*)(p.ws + WS_ACAT) + 512;
    const int w = 2 << (lane >> 4);
    for (int it = gw; it < NBATCH * 256; it += NGW) {
        const int b = it >> 8, tb = (it & 255) * 16;
        const bf16_t* P = Pool + (size_t)b * SEQ * 512 + 8 * lane;
        float sum[8];
#pragma unroll
        for (int q = 0; q < 8; ++q) sum[q] = 0.f;
        for (int d = 1; d < 16; ++d) if (d < w && tb - d >= 0) { float v[8]; ld8bf(P + (size_t)(tb - d) * 512, v);
#pragma unroll
            for (int q = 0; q < 8; ++q) sum[q] += v[q]; }
        for (int t = tb; t < tb + 16; ++t) {
            float cur[8]; ld8bf(P + (size_t)t * 512, cur);
#pragma unroll
            for (int q = 0; q < 8; ++q) sum[q] += cur[q];
            const float inv = 1.0f / (float)((t + 1 < w) ? t + 1 : w);
            float o[8];
#pragma unroll
            for (int q = 0; q < 8; ++q) o[q] = sum[q] * inv - cur[q];
            st8(Mixed + ((size_t)b * SEQ + t) * 1024 + 8 * lane, o);
            if (t - w + 1 >= 0) { float old[8]; ld8bf(P + (size_t)(t - w + 1) * 512, old);
#pragma unroll
                for (int q = 0; q < 8; ++q) sum[q] -= old[q]; }
        }
    }
}

__device__ __forceinline__ int wave_sum_i(int v) {
    v += __builtin_amdgcn_update_dpp(0, v, 0xB1, 0xF, 0xF, true);
    v += __builtin_amdgcn_update_dpp(0, v, 0x4E, 0xF, 0xF, true);
    v += __builtin_amdgcn_update_dpp(0, v, 0x141, 0xF, 0xF, true);
    v += __builtin_amdgcn_update_dpp(0, v, 0x140, 0xF, 0xF, true);
    v += __builtin_amdgcn_update_dpp(0, v, 0x142, 0xA, 0xF, true);
    v += __builtin_amdgcn_update_dpp(0, v, 0x143, 0xC, 0xF, true);
    return __builtin_amdgcn_readlane(v, 63);
}
__device__ __forceinline__ int count_ge(const unsigned (&key)[64], int nj, unsigned mid) {
    int c0 = 0, c1 = 0, c2 = 0, c3 = 0;
#pragma unroll
    for (int jb = 0; jb < 8; ++jb) if (jb * 8 < nj) {
        c0 += (key[jb * 8 + 0] >= mid) ? 1 : 0; c1 += (key[jb * 8 + 1] >= mid) ? 1 : 0; c2 += (key[jb * 8 + 2] >= mid) ? 1 : 0; c3 += (key[jb * 8 + 3] >= mid) ? 1 : 0;
        c0 += (key[jb * 8 + 4] >= mid) ? 1 : 0; c1 += (key[jb * 8 + 5] >= mid) ? 1 : 0; c2 += (key[jb * 8 + 6] >= mid) ? 1 : 0; c3 += (key[jb * 8 + 7] >= mid) ? 1 : 0; }
    return wave_sum_i((c0 + c1) + (c2 + c3));
}
__device__ __forceinline__ int lane_prefix(unsigned long long m) { return __builtin_amdgcn_mbcnt_hi((unsigned)(m >> 32), __builtin_amdgcn_mbcnt_lo((unsigned)m, 0u)); }
__device__ __forceinline__ unsigned wave_umax(unsigned v) {
#pragma unroll
    for (int o = 1; o < 64; o <<= 1) { const unsigned t = (unsigned)__shfl_xor((int)v, o); v = t > v ? t : v; }
    return (unsigned)__builtin_amdgcn_readfirstlane((int)v);
}
__device__ __forceinline__ unsigned wave_umin(unsigned v) {
#pragma unroll
    for (int o = 1; o < 64; o <<= 1) { const unsigned t = (unsigned)__shfl_xor((int)v, o); v = t < v ? t : v; }
    return (unsigned)__builtin_amdgcn_readfirstlane((int)v);
}

__device__ __forceinline__ void select_unit(const Params& p, LAS unsigned char* lds, int b, int t0) {
    int tid = threadIdx.x; asm volatile("" : "+v"(tid));
    const int lane = tid & 63, wave = __builtin_amdgcn_readfirstlane(tid >> 6);
    unsigned char* wsq = p.ws; asm volatile("" : "+s"(wsq));
    const bf16_t* Qi = (const bf16_t*)(wsq + WS_QI); const bf16_t* Ki = (const bf16_t*)(wsq + WS_KI); const float* Wi = (const float*)(wsq + WS_WI);
    unsigned* M32 = (unsigned*)(wsq + WS_MASK);
    LAS float* SC = (LAS float*)lds;
    const int c = t0 >> 6, nj = c + 1, nk = 64 * nj, ntile = nk >> 5;
    const size_t tok0 = (size_t)b * SEQ + t0;
    {
        const int r = lane & 31, hh = lane >> 5;
        bf16x8 qa[4];
        const bf16_t* qp = Qi + (tok0 + (r >> 2)) * 256 + (r & 3) * 64 + 8 * hh;
#pragma unroll
        for (int ks = 0; ks < 4; ++ks) qa[ks] = *(const bf16x8*)(qp + 16 * ks);
        f32x4 wv[4];
#pragma unroll
        for (int g = 0; g < 4; ++g) wv[g] = *(const f32x4*)(Wi + (tok0 + 2 * g + hh) * 4);
        const bf16_t* kif = Ki + (size_t)b * 128 * 4 * 512 + lane * 8;
        bf16x8 kbA[4][4], kbB[4][4];
#define LOADK(dst, k0) do { _Pragma("unroll") for (int u = 0; u < 4; ++u) { const int kt = ((k0) + u < ntile) ? (k0) + u : (k0); \
            _Pragma("unroll") for (int ks = 0; ks < 4; ++ks) dst[u][ks] = *(const bf16x8*)(kif + (size_t)(kt * 4 + ks) * 512); } } while (0)
#define COMPK(src, k0) do { _Pragma("unroll") for (int u = 0; u < 4; ++u) if ((k0) + u < ntile) { f32x16 acc; \
            _Pragma("unroll") for (int q = 0; q < 16; ++q) acc[q] = 0.f; \
            _Pragma("unroll") for (int ks = 0; ks < 4; ++ks) acc = __builtin_amdgcn_mfma_f32_32x32x16_bf16(qa[ks], src[u][ks], acc, 0, 0, 0); \
            _Pragma("unroll") for (int g = 0; g < 4; ++g) { float sv = fmaf(wv[g][0], fmaxf(acc[4 * g], 0.f), 0.0f); \
                sv = fmaf(wv[g][1], fmaxf(acc[4 * g + 1], 0.f), sv); sv = fmaf(wv[g][2], fmaxf(acc[4 * g + 2], 0.f), sv); sv = fmaf(wv[g][3], fmaxf(acc[4 * g + 3], 0.f), sv); \
                SC[(2 * g + hh) * 4096 + ((k0) + u) * 32 + r] = sv; } } } while (0)
        int kt0 = wave * 4;
        if (kt0 < ntile) {
            LOADK(kbA, kt0);
            for (;;) {
                const int k1 = kt0 + NWAVES * 4; if (k1 < ntile) LOADK(kbB, k1);
                COMPK(kbA, kt0); if (k1 >= ntile) break;
                const int k2 = k1 + NWAVES * 4; if (k2 < ntile) LOADK(kbA, k2);
                COMPK(kbB, k1); if (k2 >= ntile) break;
                kt0 = k2;
            }
        }
#undef LOADK
#undef COMPK
    }
    __syncthreads();
    LAS float* row = SC + wave * 4096;
    unsigned key[64];
#pragma unroll
    for (int jb = 0; jb < 8; ++jb) {
#pragma unroll
        for (int q = 0; q < 8; ++q) key[jb * 8 + q] = 0u;
        if (jb * 8 < nj) {
#pragma unroll
            for (int q = 0; q < 8; ++q) { const int j = jb * 8 + q; const unsigned u = __float_as_uint(row[j * 64 + lane]); const unsigned kk = (u & 0x80000000u) ? ~u : (u | 0x80000000u); key[j] = (j < nj) ? kk : 0u; }
        }
    }
    unsigned hiSel = 1u, T = 0u; int rrem = 0;
    if (nk > 256) {
        unsigned g0 = 0u, g1 = 0u, g2 = 0u, g3 = 0u;
#pragma unroll
        for (int j = 0; j < 64; j += 4) { g0 = key[j] > g0 ? key[j] : g0; g1 = key[j + 1] > g1 ? key[j + 1] : g1; g2 = key[j + 2] > g2 ? key[j + 2] : g2; g3 = key[j + 3] > g3 ? key[j + 3] : g3; }
        const unsigned mx01 = g0 > g1 ? g0 : g1, mx23 = g2 > g3 ? g2 : g3, mn01 = g0 < g1 ? g0 : g1, mn23 = g2 < g3 ? g2 : g3;
        const unsigned km = wave_umax(mx01 > mx23 ? mx01 : mx23);
        unsigned lo = wave_umin(mn01 < mn23 ? mn01 : mn23), hi = km + 1u; int cnt_hi = 0; bool exact = false;
        while (hi - lo > 1u) {
            const unsigned mid = lo + ((hi - lo) >> 1);
            const int cnt = count_ge(key, nj, mid);
            if (cnt >= 256) { lo = mid; if (cnt == 256) { exact = true; break; } } else { hi = mid; cnt_hi = cnt; }
        }
        if (exact) { hiSel = lo; T = 0u; rrem = 0; } else { hiSel = hi; T = lo; rrem = 256 - cnt_hi; }
    }
    unsigned* mrow = M32 + (tok0 + wave) * 128;
#pragma unroll
    for (int j = 0; j < 64; ++j) if ((j & ~7) < nj) {
        const bool eq = (key[j] == T) && (key[j] < hiSel);
        const unsigned long long eqm = __ballot(eq);
        const bool take = eq && (lane_prefix(eqm) < rrem);
        const int ne = __popcll(eqm); rrem = (ne < rrem) ? rrem - ne : 0;
        const bool sel = (key[j] >= hiSel) || take;
        const unsigned long long sm = __ballot(sel);
        if (lane == 0) *(u32x2*)(mrow + 2 * j) = (u32x2){(unsigned)sm, (unsigned)(sm >> 32)};
    }
    __syncthreads();
}

__device__ __forceinline__ void dense_attn_chunk(const Params& p, int b, int c, float negC) {
    int tid = threadIdx.x; asm volatile("" : "+v"(tid));
    const int lane = tid & 63, wave = __builtin_amdgcn_readfirstlane(tid >> 6);
    unsigned char* wsq = p.ws; asm volatile("" : "+s"(wsq));
    const bf16_t* Qb = (const bf16_t*)(wsq + WS_Q); const bf16_t* Kb = (const bf16_t*)(wsq + WS_K); const bf16_t* VT = (const bf16_t*)(wsq + WS_VT);
    const unsigned* M32 = (const unsigned*)(wsq + WS_MASK); bf16_t* Attn = (bf16_t*)(wsq + WS_ACAT);
    const int kvh = wave >> 2, cl = lane & 31, hi = lane >> 5, ntile = 2 * (c + 1);
    const size_t tokc = (size_t)b * SEQ + 64 * c + 16 * (wave & 3);
    bf16x8 qf[2][4]; const unsigned* mrow[2]; size_t tokq[2];
#pragma unroll
    for (int ti = 0; ti < 2; ++ti) { tokq[ti] = tokc + 8 * ti + (cl >> 2); mrow[ti] = M32 + tokq[ti] * 128;
#pragma unroll
        for (int ks = 0; ks < 4; ++ks) qf[ti][ks] = *(const bf16x8*)(Qb + tokq[ti] * 512 + (4 * kvh + (cl & 3)) * 64 + 16 * ks + 8 * hi); }
    f32x16 o[2][2]; float lsum[2] = {0.f, 0.f};
#pragma unroll
    for (int ti = 0; ti < 2; ++ti)
#pragma unroll
        for (int dt = 0; dt < 2; ++dt)
#pragma unroll
            for (int q = 0; q < 16; ++q) o[ti][dt][q] = 0.f;
    const bf16_t* kbase = Kb + (size_t)(b * 2 + kvh) * 128 * 4 * 512 + lane * 8;
    const bf16_t* vbase = VT + (size_t)(b * 2 + kvh) * 128 * 4 * 512 + lane * 8;
    bf16x8 kfA[4], kfB[4], vfA[4], vfB[4]; unsigned mwA[2], mwB[2];
#define LOADT(kf, vf, mw, kt) do { _Pragma("unroll") for (int q = 0; q < 4; ++q) { kf[q] = *(const bf16x8*)(kbase + (size_t)((kt) * 4 + q) * 512); vf[q] = *(const bf16x8*)(vbase + (size_t)((kt) * 4 + q) * 512); } \
        mw[0] = mrow[0][kt]; mw[1] = mrow[1][kt]; } while (0)
#define COMPT(kf, vf, mw) do { _Pragma("unroll") for (int ti = 0; ti < 2; ++ti) { f32x16 sa; const unsigned mwh = mw[ti] >> (4 * hi); \
        _Pragma("unroll") for (int q = 0; q < 16; ++q) sa[q] = negC; \
        _Pragma("unroll") for (int ks = 0; ks < 4; ++ks) sa = __builtin_amdgcn_mfma_f32_32x32x16_bf16(kf[ks], qf[ti][ks], sa, 0, 0, 0); \
        float pv[16]; float ls = 0.f; \
        _Pragma("unroll") for (int r = 0; r < 16; ++r) { const int pos = (r & 3) + 8 * (r >> 2); \
            const float e = __builtin_amdgcn_exp2f(sa[r]); const int m = __builtin_amdgcn_sbfe((int)mwh, pos, 1); \
            pv[r] = __uint_as_float(__float_as_uint(e) & (unsigned)m); ls += pv[r]; } \
        lsum[ti] += ls; \
        _Pragma("unroll") for (int sx = 0; sx < 2; ++sx) { \
            u32x4 pw; pw.x = cvt_pk_bf16(pv[8 * sx], pv[8 * sx + 1]); pw.y = cvt_pk_bf16(pv[8 * sx + 2], pv[8 * sx + 3]); pw.z = cvt_pk_bf16(pv[8 * sx + 4], pv[8 * sx + 5]); pw.w = cvt_pk_bf16(pv[8 * sx + 6], pv[8 * sx + 7]); \
            const bf16x8 pb = __builtin_bit_cast(bf16x8, pw); \
            _Pragma("unroll") for (int dt = 0; dt < 2; ++dt) o[ti][dt] = __builtin_amdgcn_mfma_f32_32x32x16_bf16(vf[dt * 2 + sx], pb, o[ti][dt], 0, 0, 0); } } } while (0)
    LOADT(kfA, vfA, mwA, 0);
    for (int kt = 0; kt < ntile; kt += 2) {
        LOADT(kfB, vfB, mwB, kt + 1);
        COMPT(kfA, vfA, mwA);
        if (kt + 2 < ntile) LOADT(kfA, vfA, mwA, kt + 2);
        COMPT(kfB, vfB, mwB);
    }
#undef LOADT
#undef COMPT
    int lane2 = lane; asm volatile("" : "+v"(lane2));
    const int cl2 = lane2 & 31, hi2 = lane2 >> 5;
#pragma unroll
    for (int ti = 0; ti < 2; ++ti) {
        const float lt = lsum[ti] + __shfl_xor(lsum[ti], 32); const float inv = 1.0f / lt;
        bf16_t* dst = Attn + (tokc + 8 * ti + (cl2 >> 2)) * 1024 + (4 * kvh + (cl2 & 3)) * 64 + 4 * hi2;
#pragma unroll
        for (int dt = 0; dt < 2; ++dt)
#pragma unroll
            for (int g4 = 0; g4 < 4; ++g4) { u32x2 w; w.x = cvt_pk_bf16(o[ti][dt][4 * g4] * inv, o[ti][dt][4 * g4 + 1] * inv); w.y = cvt_pk_bf16(o[ti][dt][4 * g4 + 2] * inv, o[ti][dt][4 * g4 + 3] * inv);
                *(u32x2*)(dst + 32 * dt + 8 * g4) = w; }
    }
}

__device__ __forceinline__ void attn_phase(const Params& p, LAS unsigned char* lds, int bid, int G) {
    const int lane = threadIdx.x & 63;
    float mq = fabsf(p.q_norm_g[lane]), mk = fabsf(p.k_norm_g[lane]);
#pragma unroll
    for (int o = 1; o < 64; o <<= 1) { mq = fmaxf(mq, __shfl_xor(mq, o)); mk = fmaxf(mk, __shfl_xor(mk, o)); }
    const float negC = -(8.0f * mq * mk * 1.4426950408889634f * 1.03f);
    for (int u = bid; u < NBATCH * 32; u += G) {
        const int b = u & 7, y = u >> 3;
        for (int half = 0; half < 2; ++half) {
            const int c = half ? 63 - y : y;
            for (int sx = 0; sx < 8; ++sx) select_unit(p, lds, b, 64 * c + 8 * sx);
            asm volatile("s_waitcnt vmcnt(0)" ::: "memory"); __syncthreads();
            dense_attn_chunk(p, b, c, negC);
        }
    }
}

constexpr int T_TSTART = 0, T_PADSTART = 40, T_BLOCKBASE = 80, T_NE = 112, T_WB = 144  , T_PART = 400  ;
__device__ __forceinline__ void router_phase(const Params& p, LAS unsigned char* lds, int bid, int G) {
    const int tid = threadIdx.x, lane = tid & 63, wave = __builtin_amdgcn_readfirstlane(tid >> 6);
    constexpr int WP = 1028;
    LAS float* WrT = (LAS float*)lds;
    for (int i = tid; i < 1024 * 32 / 4; i += NTHREADS) { const f32x4 v = *(const f32x4*)(p.router_w + 4 * (size_t)i); const int c = i >> 3, e0 = 4 * (i & 7); const float g = p.norm2_g[c];
        WrT[(e0 + 0) * WP + c] = v[0] * g; WrT[(e0 + 1) * WP + c] = v[1] * g; WrT[(e0 + 2) * WP + c] = v[2] * g; WrT[(e0 + 3) * WP + c] = v[3] * g; }
    __syncthreads();
    LAS int* tbl = (LAS int*)(lds + MISC_OFF);
    const float* X1 = p.out; bf16_t* H2 = (bf16_t*)(p.ws + WS_H2);
    int* rec_e = (int*)(p.ws + WS_REC_E); int* rec_pos = (int*)(p.ws + WS_REC_POS); float* rec_gate = (float*)(p.ws + WS_REC_GATE);
    const int ex = lane & 15, kq = lane >> 4;
    const size_t tokw = (size_t)bid * 128 + wave * 16;
    f32x4 acc0 = (f32x4){0.f, 0.f, 0.f, 0.f}, acc1 = acc0; float ssq = 0.f;
    {
        const float* xr = X1 + (tokw + ex) * D + 4 * kq;
        const LAS float* w0 = WrT + ex * WP + 4 * kq; const LAS float* w1 = w0 + 16 * WP;
#pragma unroll 4
        for (int q = 0; q < 64; ++q) {
            const f32x4 a = *(const f32x4*)(xr + 16 * q); const f32x4 b0 = *(const LAS f32x4*)(w0 + 16 * q), b1 = *(const LAS f32x4*)(w1 + 16 * q);
            ssq += (a.x * a.x + a.y * a.y) + (a.z * a.z + a.w * a.w);
#pragma unroll
            for (int k = 0; k < 4; ++k) { acc0 = __builtin_amdgcn_mfma_f32_16x16x4f32(a[k], b0[k], acc0, 0, 0, 0); acc1 = __builtin_amdgcn_mfma_f32_16x16x4f32(a[k], b1[k], acc1, 0, 0, 0); }
        }
    }
    ssq += __shfl_xor(ssq, 16); ssq += __shfl_xor(ssq, 32);
    const float rs = 1.0f / sqrtf(ssq * (1.0f / D) + NORM_EPS);
    const float br0 = p.router_b[ex], br1 = p.router_b[ex + 16];
    float lg0[4], lg1[4];
#pragma unroll
    for (int i = 0; i < 4; ++i) { const float r = __shfl(rs, 4 * kq + i); lg0[i] = acc0[i] * r + br0; lg1[i] = acc1[i] * r + br1; }
    int ti[4][4]; float tv[4][4];
#pragma unroll
    for (int r = 0; r < 4; ++r)
#pragma unroll
        for (int i = 0; i < 4; ++i) {
            float bv = (lg0[i] >= lg1[i]) ? lg0[i] : lg1[i]; int bi = (lg0[i] >= lg1[i]) ? ex : ex + 16;
#pragma unroll
            for (int m = 1; m < 16; m <<= 1) { const float ov = __shfl_xor(bv, m); const int oi = __shfl_xor(bi, m); const bool better = (ov > bv) || (ov == bv && oi < bi); bv = better ? ov : bv; bi = better ? oi : bi; }
            tv[i][r] = bv; ti[i][r] = bi;
            if (bi == ex) lg0[i] = -INFINITY; if (bi == ex + 16) lg1[i] = -INFINITY;
        }
    unsigned M[4];
#pragma unroll
    for (int i = 0; i < 4; ++i) M[i] = (1u << ti[i][0]) | (1u << ti[i][1]) | (1u << ti[i][2]) | (1u << ti[i][3]);
    unsigned Mall[16];
#pragma unroll
    for (int t = 0; t < 16; ++t) Mall[t] = (unsigned)__builtin_amdgcn_readlane((int)M[t & 3], 16 * (t >> 2));
#pragma unroll
    for (int i = 0; i < 4; ++i) {
        const int t = 4 * kq + i;
        const float e1 = __expf(tv[i][1] - tv[i][0]), e2 = __expf(tv[i][2] - tv[i][0]), e3 = __expf(tv[i][3] - tv[i][0]); const float inv = 1.0f / (1.0f + e1 + e2 + e3);
#pragma unroll
        for (int r = 0; r < 4; ++r) {
            const int x = ti[i][r]; int pos = 0;
#pragma unroll
            for (int tp = 0; tp < 16; ++tp) pos += (tp < t) ? (int)((Mall[tp] >> x) & 1u) : 0;
            const float gt = (r == 0 ? 1.0f : (r == 1 ? e1 : (r == 2 ? e2 : e3))) * inv;
            if (ex == r) { rec_e[(tokw + t) * 4 + r] = x; rec_pos[(tokw + t) * 4 + r] = pos; rec_gate[(tokw + t) * 4 + r] = gt; }
        }
    }
    { int cnt = 0;
#pragma unroll
        for (int t = 0; t < 16; ++t) cnt += (int)((Mall[t] >> (lane & 31)) & 1u);
        if (lane < 32) tbl[T_WB + wave * 32 + lane] = cnt; }
    {
        f32x4 g2[4];
#pragma unroll
        for (int j = 0; j < 4; ++j) g2[j] = *(const f32x4*)(p.norm2_g + 4 * lane + 256 * j);
#pragma unroll 4
        for (int t = 0; t < 16; ++t) {
            const float r = __shfl(rs, t);
            const f32x4* xr = (const f32x4*)(X1 + (tokw + t) * D) + lane;
#pragma unroll
            for (int j = 0; j < 4; ++j) { const f32x4 h = xr[64 * j] * r * g2[j]; u32x2 w; w.x = cvt_pk_bf16(h.x, h.y); w.y = cvt_pk_bf16(h.z, h.w); *(u32x2*)(H2 + (tokw + t) * D + 4 * lane + 256 * j) = w; }
        }
    }
    __syncthreads();
    if (tid < 256) ((int*)(p.ws + WS_WCNT))[(size_t)bid * 256 + tid] = tbl[T_WB + tid];
    if (tid < 32) { int sm = 0;
#pragma unroll
        for (int w = 0; w < 8; ++w) sm += tbl[T_WB + w * 32 + tid];
        ((int*)(p.ws + WS_BCNT))[bid * 32 + tid] = sm; }
    __syncthreads();
}

__device__ __forceinline__ void moe_tables(const Params& p, LAS int* tbl, int bid) {
    const int tid = threadIdx.x; const int* bcnt = (const int*)(p.ws + WS_BCNT);
    { const int e = tid & 31, part = tid >> 5; int all = 0, below = 0;
        for (int k = 0; k < 16; ++k) { const int blk = part * 16 + k; const int v = bcnt[blk * 32 + e]; all += v; below += (blk < bid) ? v : 0; }
        tbl[T_PART + part * 32 + e] = all; tbl[T_PART + 512 + part * 32 + e] = below; }
    __syncthreads();
    if (tid < 32) { int all = 0, below = 0;
        for (int q = 0; q < 16; ++q) { all += tbl[T_PART + q * 32 + tid]; below += tbl[T_PART + 512 + q * 32 + tid]; }
        tbl[T_NE + tid] = all; tbl[T_BLOCKBASE + tid] = below; }
    __syncthreads();
    if (tid == 0) { int ps = 0, ts = 0;
        for (int e = 0; e < NEXP; ++e) { tbl[T_PADSTART + e] = ps; tbl[T_TSTART + e] = ts; const int nt = (tbl[T_NE + e] + 255) >> 8; ps += nt * 256; ts += nt; }
        tbl[T_PADSTART + NEXP] = ps; tbl[T_TSTART + NEXP] = ts; }
    __syncthreads();
}

__device__ __forceinline__ void permute_phase(const Params& p, LAS unsigned char* lds, int bid, int G) {
    const int tid = threadIdx.x, lane = tid & 63, wave = __builtin_amdgcn_readfirstlane(tid >> 6);
    LAS int* tbl = (LAS int*)(lds + MISC_OFF);
    moe_tables(p, tbl, bid);
    if (tid < 256) { const int w = tid >> 5, e = tid & 31; int s = 0; const int* wc = (const int*)(p.ws + WS_WCNT) + (size_t)bid * 256;
        for (int q = 0; q < 8; ++q) s += (q < w) ? wc[q * 32 + e] : 0;
        tbl[T_WB + tid] = s; }
    __syncthreads();
    const int* rec_e = (const int*)(p.ws + WS_REC_E); const int* rec_pos = (const int*)(p.ws + WS_REC_POS); const float* rec_gate = (const float*)(p.ws + WS_REC_GATE);
    int* slot_of = (int*)(p.ws + WS_SLOT_OF); float* slot_gate = (float*)(p.ws + WS_SLOT_GATE);
    const bf16_t* H2 = (const bf16_t*)(p.ws + WS_H2); bf16_t* H2S = (bf16_t*)(p.ws + WS_H2S);
    for (int bt = 0; bt < 8; ++bt) {
        const int idx = wave * 64 + bt * 8 + (lane & 7); const int tl = idx >> 2; const size_t tk = (size_t)bid * 128 + tl;
        const int e = rec_e[tk * 4 + (idx & 3)], pw = rec_pos[tk * 4 + (idx & 3)];
        const int slot = tbl[T_PADSTART + e] + tbl[T_BLOCKBASE + e] + tbl[T_WB + (tl >> 4) * 32 + e] + pw;
        if (lane < 8) { slot_of[tk * 4 + (idx & 3)] = slot; slot_gate[slot] = rec_gate[tk * 4 + (idx & 3)]; }
        u32x4 v0[8], v1[8];
#pragma unroll
        for (int i = 0; i < 8; ++i) { const size_t tki = (size_t)bid * 128 + ((wave * 64 + bt * 8 + i) >> 2);
            v0[i] = *(const u32x4*)(H2 + tki * D + 8 * lane); v1[i] = *(const u32x4*)(H2 + tki * D + 512 + 8 * lane); }
#pragma unroll
        for (int i = 0; i < 8; ++i) { const int sl = __shfl(slot, i);
            *(u32x4*)(H2S + (size_t)sl * D + 8 * lane) = v0[i]; *(u32x4*)(H2S + (size_t)sl * D + 512 + 8 * lane) = v1[i]; }
    }
}

__device__ __forceinline__ void combine_phase(const Params& p, int bid, int G) {
    const int tid = threadIdx.x, lane = tid & 63, wave = __builtin_amdgcn_readfirstlane(tid >> 6);
    const int gw = bid * NWAVES + wave, NGW = G * NWAVES;
    const int* slot_of = (const int*)(p.ws + WS_SLOT_OF); const bf16_t* Y = (const bf16_t*)(p.ws + WS_Y);
    for (int tk = gw; tk < NTOK; tk += NGW) {
        int sl[4];
#pragma unroll
        for (int r = 0; r < 4; ++r) sl[r] = slot_of[(size_t)tk * 4 + r];
        float* orow = p.out + (size_t)tk * D;
#pragma unroll
        for (int j = 0; j < 4; ++j) { f32x4 a = *(const f32x4*)(orow + 4 * lane + 256 * j);
#pragma unroll
            for (int r = 0; r < 4; ++r) { const u32x2 y = *(const u32x2*)(Y + (size_t)sl[r] * D + 4 * lane + 256 * j); a.x += bf_lo(y.x); a.y += bf_hi(y.x); a.z += bf_lo(y.y); a.w += bf_hi(y.y); }
            *(f32x4*)(orow + 4 * lane + 256 * j) = a; }
    }
}

constexpr int NPH = 11;
__global__ void __launch_bounds__(NTHREADS, 2) mega(Params p) {
    extern __shared__ __attribute__((aligned(16))) unsigned char lds_raw[];
    LAS unsigned char* lds = (LAS unsigned char*)lds_raw;
    cg::grid_group grid = cg::this_grid();
    const int bid = blockIdx.x, G = gridDim.x;
    unsigned char* ws = p.ws;
#ifndef PH_MASK
#define PH_MASK 0x7ff
#endif
#define IN(k) (((PH_MASK >> (k)) & 1) && p.ph_lo <= (k) && (k) < p.ph_hi)
#ifndef PH_DUP
#define PH_DUP 0
#endif
#define DUP(k) (((PH_DUP >> (k)) & 1) ? 2 : 1)
#define SEAM(k) do { if (IN(k) && IN((k) + 1)) grid.sync(); } while (0)
    if (IN(0)) { phase0(p, lds, bid, G); }
    SEAM(0);
    if (IN(1)) {
        pg8::Gemm g{(const bf16_t*)(ws + WS_XN), (const bf16_t*)(ws + WS_WIN), NTOK, INWP, D}; pg8::StaticOrder S; S.init(NTOK, INWP, G, bid);
        EpiInProj E{(bf16_t*)(ws + WS_Q), (bf16_t*)(ws + WS_K), (bf16_t*)(ws + WS_VT), (bf16_t*)(ws + WS_QI), (bf16_t*)(ws + WS_KI), (bf16_t*)(ws + WS_POOL), (bf16_t*)(ws + WS_GA), (bf16_t*)(ws + WS_GP),
                    (float*)(ws + WS_WI), (const float*)(ws + WS_CS), p.q_norm_g, p.k_norm_g, p.idx_g, p.idx_b};
        pg8::gemm_phase(lds, g, S, E);
    }
    SEAM(1);
    if (IN(2)) { pool_phase(p, bid, G); attn_phase(p, lds, bid, G); }
    SEAM(2);
    if (IN(3)) {
        pg8::Gemm g{(const bf16_t*)(ws + WS_ACAT), (const bf16_t*)(ws + WS_WCAT), NTOK, D, D}; pg8::StaticOrder S; S.init(NTOK, D, G, bid);
        EpiGated E{(const bf16_t*)(ws + WS_GA), (const bf16_t*)(ws + WS_GP), (bf16_t*)(ws + WS_MERGED)};
        pg8::gemm_phase(lds, g, S, E);
    }
    SEAM(4);
    if (IN(5)) {
        pg8::Gemm g{(const bf16_t*)(ws + WS_MERGED), (const bf16_t*)(ws + WS_WOUT), NTOK, D, D}; pg8::StaticOrder S; S.init(NTOK, D, G, bid);
        EpiResid E{p.x, p.out};
        pg8::gemm_phase(lds, g, S, E);
    }
    SEAM(5);
    if (IN(6)) { router_phase(p, lds, bid, G); }
    SEAM(6);
    if (IN(7)) { permute_phase(p, lds, bid, G); }
    SEAM(7);
    if (IN(8)) {
        LAS int* tbl = (LAS int*)(lds + MISC_OFF); moe_tables(p, tbl, bid);
        pg8::Gemm g{(const bf16_t*)(ws + WS_H2S), (const bf16_t*)(ws + WS_WGU), NSLOT, NEXP * 2048, D}; pg8::MoeOrder<8> S{tbl + T_TSTART, G, bid};
        EpiGateUp E{p.b_gu, (bf16_t*)(ws + WS_ACT)};
        pg8::gemm_phase(lds, g, S, E);
    }
    SEAM(8);
    if (IN(9)) {
        LAS int* tbl = (LAS int*)(lds + MISC_OFF); moe_tables(p, tbl, bid);
        pg8::Gemm g{(const bf16_t*)(ws + WS_ACT), (const bf16_t*)(ws + WS_WD), NSLOT, NEXP * 1024, D}; pg8::MoeOrder<4> S{tbl + T_TSTART, G, bid};
        EpiDown E{p.b_d, (const float*)(ws + WS_SLOT_GATE), (bf16_t*)(ws + WS_Y)};
        pg8::gemm_phase(lds, g, S, E);
    }
    SEAM(9);
    if (IN(10)) combine_phase(p, bid, G);
#undef IN
#undef SEAM
}

extern "C" void kernel_launch(void* const* d_in, const int* in_sizes, int n_in, void* d_out, int out_size, void* d_ws, size_t ws_size, hipStream_t stream) {
    static int grid = 0;
    if (grid == 0) {
        if (n_in != 20 || out_size != NTOK * D || ws_size < WS_END) { fprintf(stderr, "kernel_launch: unexpected shapes: n_in %d out %d ws %zu (need %zu)\n", n_in, out_size, ws_size, (size_t)WS_END); grid = -1; return; }
        int dev = 0, cus = 0, per_cu = 0;
        hipGetDevice(&dev); hipDeviceGetAttribute(&cus, hipDeviceAttributeMultiprocessorCount, dev);
        if (hipFuncSetAttribute((const void*)mega, hipFuncAttributeMaxDynamicSharedMemorySize, LDS_BYTES) != hipSuccess) { fprintf(stderr, "kernel_launch: hipFuncSetAttribute failed\n"); grid = -1; return; }
        if (hipOccupancyMaxActiveBlocksPerMultiprocessor(&per_cu, (const void*)mega, NTHREADS, LDS_BYTES) != hipSuccess || per_cu < 1) { fprintf(stderr, "kernel_launch: occupancy query says %d blocks per CU\n", per_cu); per_cu = 1; }
        (void)hipGetLastError();
        grid = cus;
        if (grid != 256) fprintf(stderr, "kernel_launch: %d CUs; the router / permute phases assume a 256-workgroup grid\n", grid);
    }
    if (grid < 0) return;
    Params p{};
    p.x = (const float*)d_in[0]; p.pos = (const int*)d_in[1]; p.norm1_g = (const float*)d_in[2]; p.w_in = (const float*)d_in[3]; p.q_norm_g = (const float*)d_in[4];
    p.k_norm_g = (const float*)d_in[5]; p.idx_g = (const float*)d_in[6]; p.idx_b = (const float*)d_in[7]; p.w_a = (const float*)d_in[8]; p.pool_mix = (const float*)d_in[9];
    p.pool_scale = (const float*)d_in[10]; p.w_b = (const float*)d_in[11]; p.w_out = (const float*)d_in[12]; p.norm2_g = (const float*)d_in[13]; p.router_w = (const float*)d_in[14];
    p.router_b = (const float*)d_in[15]; p.w_gu = (const float*)d_in[16]; p.b_gu = (const float*)d_in[17]; p.w_d = (const float*)d_in[18]; p.b_d = (const float*)d_in[19];
    p.out = (float*)d_out; p.ws = (unsigned char*)d_ws;
#if MK_MODE == 0
    p.ph_lo = 0; p.ph_hi = NPH;
    void* args[] = {&p};
    hipError_t e = hipLaunchCooperativeKernel((const void*)mega, dim3(grid), dim3(NTHREADS), args, LDS_BYTES, stream);
    if (e != hipSuccess) fprintf(stderr, "kernel_launch: cooperative launch failed: %s (grid %d)\n", hipGetErrorString(e), grid);
#else
    for (int k = 0; k < NPH; ++k) { p.ph_lo = k; p.ph_hi = k + 1; hipLaunchKernelGGL(mega, dim3(grid), dim3(NTHREADS), LDS_BYTES, stream, p); }
#endif
}
```

```cpp
#include <hip/hip_runtime.h>
#include <hip/hip_cooperative_groups.h>
#include <cstdio>
#include <cstdint>
#include <cmath>
namespace cg = cooperative_groups;

#ifndef MK_MODE
#define MK_MODE 0
#endif

#define LAS __attribute__((address_space(3)))
typedef unsigned short bf16_t;
typedef short bf16x8 __attribute__((ext_vector_type(8)));
typedef float f32x2 __attribute__((ext_vector_type(2)));
typedef float f32x4 __attribute__((ext_vector_type(4)));
typedef float f32x16 __attribute__((ext_vector_type(16)));
typedef unsigned u32x2 __attribute__((ext_vector_type(2)));
typedef unsigned u32x4 __attribute__((ext_vector_type(4)));

constexpr int D = 1024, NBATCH = 8, SEQ = 4096, NTOK = NBATCH * SEQ;
constexpr int NEXP = 32, TOPK = 4;
constexpr int INW = 3652, INWP = 3840;
constexpr int NSLOT = 139264;
constexpr float NORM_EPS = 1e-6f;
constexpr float MOE_WSCALE = 64.0f, MOE_WINV = 1.0f / 64.0f;
constexpr int NWAVES = 8, NTHREADS = 512;
constexpr int LDS_BYTES = 147456;
constexpr int RING_BYTES = 131072;
constexpr int MISC_OFF = 135168;

constexpr size_t MiB = 1u << 20;
constexpr size_t WS_CTL = 0;
constexpr size_t WS_BCNT = 64 * 1024;
constexpr size_t WS_WCNT = 128 * 1024;
constexpr size_t WS_CS = 2 * MiB;
constexpr size_t WS_WIN = 16 * MiB;
constexpr size_t WS_WCAT = 24 * MiB;
constexpr size_t WS_WOUT = 26 * MiB;
constexpr size_t WS_WGU = 28 * MiB;
constexpr size_t WS_WD = 156 * MiB;
constexpr size_t WS_REC_E = 220 * MiB;
constexpr size_t WS_REC_POS = 221 * MiB;
constexpr size_t WS_REC_GATE = 222 * MiB;
constexpr size_t WS_SLOT_OF = 223 * MiB;
constexpr size_t WS_SLOT_GATE = 223 * MiB + 512 * 1024;
constexpr size_t WS_XN = 226 * MiB;
constexpr size_t WS_Q = 290 * MiB;
constexpr size_t WS_K = 322 * MiB;
constexpr size_t WS_VT = 330 * MiB;
constexpr size_t WS_QI = 338 * MiB;
constexpr size_t WS_KI = 354 * MiB;
constexpr size_t WS_WI = 358 * MiB;
constexpr size_t WS_POOL = 360 * MiB;
constexpr size_t WS_GA = 392 * MiB;
constexpr size_t WS_GP = 456 * MiB;
constexpr size_t WS_ACAT = 520 * MiB;
constexpr size_t WS_TA = 584 * MiB;
constexpr size_t WS_MASK = WS_TA;
constexpr size_t WS_MERGED = 648 * MiB;
constexpr size_t WS_H2 = WS_XN;
constexpr size_t WS_H2S = 290 * MiB;
constexpr size_t WS_Y = WS_H2S;
constexpr size_t WS_ACT = 562 * MiB;
constexpr size_t WS_END = 834 * MiB;
static_assert(WS_SLOT_GATE + (size_t)NSLOT * 4 <= WS_XN, "ws map");

__device__ __forceinline__ unsigned cvt_pk_bf16(float lo, float hi) { unsigned r; asm volatile("v_cvt_pk_bf16_f32 %0, %1, %2" : "=v"(r) : "v"(lo), "v"(hi)); return r; }
__device__ __forceinline__ unsigned pk4_fp8(float a, float b, float c, float d) { int w = __builtin_amdgcn_cvt_pk_fp8_f32(a, b, 0, false); w = __builtin_amdgcn_cvt_pk_fp8_f32(c, d, w, true); return (unsigned)w; }
__device__ __forceinline__ float bf_lo(unsigned w) { return __uint_as_float(w << 16); }
__device__ __forceinline__ float bf_hi(unsigned w) { return __uint_as_float(w & 0xffff0000u); }
__device__ __forceinline__ float wave_sum(float v) {
#pragma unroll
    for (int o = 1; o < 64; o <<= 1) v += __shfl_xor(v, o);
    return v;
}
__device__ __forceinline__ float sigmoidf_(float x) { return 1.0f / (1.0f + __expf(-x)); }
#define LDS_WAIT() asm volatile("s_waitcnt lgkmcnt(0)" ::: "memory")

__host__ __device__ __forceinline__ int idx_bj_j(int d, int& bj) {
    int j;
    if (d < 16) { bj = 0; j = d; } else if (d < 32) { bj = 1; j = d - 16; } else if (d < 48) { bj = 0; j = d - 16; } else { bj = 1; j = d - 32; }
    return j;
}
__host__ __device__ __forceinline__ int win_phys(int n) {
    if (n < 512) { const int h = n >> 6, d = n & 63; return 256 * (h >> 2) + 128 * (d >> 5) + 32 * (h & 3) + (d & 31); }
    if (n < 768) { const int h = (n - 512) >> 6, d = n & 63; return 512 + 128 * (d >> 5) + 32 * h + (d & 31); }
    if (n < 1024) { const int h = (n - 768) >> 6, d = n & 63; int bj; const int j = idx_bj_j(d, bj); return 768 + 128 * bj + 32 * h + j; }
    if (n < 1088) { const int d = n - 1024; int bj; const int j = idx_bj_j(d, bj); return 1024 + 128 * bj + j; }
    if (n < 1092) return 1024 + 32 + (n - 1088);
    if (n < 1604) return 1280 + (n - 1092);
    if (n < 2628) return 1792 + (n - 1604);
    return 2816 + (n - 2628);
}

namespace pg8 {
constexpr int BM = 256, BK = 64, HALF = 128, HTB = HALF * BK * 2, STAGE_BYTES = 8 * HTB, NXCD = 8, WGM = 8;
__host__ __device__ __forceinline__ int lds_byte(int r, int c) { const int st = (r >> 4) * 2 + (c >> 5), rr = r & 15, cc = c & 31, ob = rr * 64 + cc * 2; return st * 1024 + (ob ^ (((ob >> 9) & 1) << 5)); }
__host__ __device__ __forceinline__ void stage_rc(int b, int& R, int& C) { const int st = b / 1024, sb = b % 1024, swz = sb ^ (((sb >> 9) & 1) << 5); R = (st >> 1) * 16 + swz / 64; C = (st & 1) * 32 + (swz % 64) / 2; }
__host__ __device__ __forceinline__ int perm32(int rho) { const int n = rho >> 4, i = rho & 15; return 8 * (i >> 2) + 4 * n + (i & 3); }

struct Unit { int pm, pn; };
struct Gemm { const bf16_t* A; const bf16_t* Bt; int M, N, K; };

struct StaticOrder {
    int nM, nN, nwg, G, c;
    __device__ void init(int M, int N, int G_, int c_) { nM = M / BM; nN = N / BM; nwg = nM * nN; G = G_; c = c_; }
    __device__ bool next(int i, Unit& u) const {
        const long L = (long)i * G + c; if (L >= nwg) return false;
        int wgid = (int)L; { const int q = nwg / NXCD, r = nwg % NXCD, xcd = wgid % NXCD, off = wgid / NXCD; wgid = (xcd < r ? xcd * (q + 1) : r * (q + 1) + (xcd - r) * q) + off; }
        const int nig = WGM * nN, gid = wgid / nig, fm = gid * WGM, gsz = (nM - fm) < WGM ? (nM - fm) : WGM;
        u.pm = fm + ((wgid % nig) % gsz); u.pn = (wgid % nig) / gsz; return true;
    }
};
constexpr int T_TILE_E_REL = 1500;
template <int NPN> struct MoeOrder {
    const LAS int* tstart; int G, c;
    __device__ bool next(int i, Unit& u) const {
        const int L = i * G + c; const int ntile = __builtin_amdgcn_readfirstlane(tstart[NEXP]);
        if (L >= ntile * NPN) return false;
        const int ti = L / NPN, pn = L % NPN; const int e = tstart[T_TILE_E_REL + ti];
        u.pm = __builtin_amdgcn_readfirstlane(ti); u.pn = __builtin_amdgcn_readfirstlane(e * NPN + pn); return true;
    }
};

typedef int i32x8 __attribute__((ext_vector_type(8)));
__device__ __forceinline__ i32x8 pk32(bf16x8 a, bf16x8 b) { typedef int i32x4 __attribute__((ext_vector_type(4))); const i32x4 x = __builtin_bit_cast(i32x4, a), y = __builtin_bit_cast(i32x4, b); return __builtin_shufflevector(x, y, 0, 1, 2, 3, 4, 5, 6, 7); }
__device__ __forceinline__ void mfma_f8_inplace(f32x4& acc, i32x8 a, i32x8 b, int one) {
    asm volatile("v_mfma_scale_f32_16x16x128_f8f6f4 %0, %1, %2, %0, %3, %3 op_sel_hi:[0,0,0]" : "+v"(acc) : "v"(a), "v"(b), "v"(one));
}
template <class Epi, class Sched, bool F8 = false>
__device__ __forceinline__ void gemm_phase(LAS unsigned char* lds, const Gemm g, const Sched& S, const Epi& E) {
    const int tid = threadIdx.x, wid = __builtin_amdgcn_readfirstlane(tid >> 6), lane = tid & 63, wr = wid >> 2, wc = wid & 3, fr = lane & 15, fq = lane >> 4;
    constexpr int ES = F8 ? 1 : 2;
    const int K = g.K, RB = K * ES, nt = RB / 128;
    unsigned voffA[2], voffB[2];
    { int R, C; stage_rc(tid * 16, R, C); const int Rb = (R & ~31) + perm32(R & 31);
        voffA[0] = (unsigned)(R * RB + C * 2); voffB[0] = (unsigned)(Rb * RB + C * 2); voffA[1] = 64u * (unsigned)RB; voffB[1] = 64u * (unsigned)RB; }
    const size_t kstep = (size_t)(BK * 2);
    const size_t hstep = (size_t)HALF * RB;
    const size_t tstep = 2 * hstep;
    const unsigned ldsw = (unsigned)wid * 1024u;
    const int aoff = lds_byte(wr * 64 + fr, F8 ? fq * 16 : fq * 8), boff = lds_byte(wc * 32 + fr, F8 ? fq * 16 : fq * 8);
    constexpr int PSTEP = F8 ? 16 : 1024;
#define PG8_SA(b, h) (((b) * 2 + (h)) * HTB)
#define PG8_SB(b, h) ((4 + (b) * 2 + (h)) * HTB)
#define PG8_STAGE(bufoff, gbase, voff) do { _Pragma("unroll") for (int _i = 0; _i < 2; ++_i) \
        __builtin_amdgcn_global_load_lds((const unsigned*)((const char*)(gbase) + (size_t)(_i ? (voff)[1] : 0u) + (voff)[0]), (LAS unsigned*)(lds + (bufoff) + ldsw + _i * 8192), 16, 0, 0); } while (0)
#define PG8_LDA(dst, b, h) do { _Pragma("unroll") for (int m = 0; m < 4; ++m) _Pragma("unroll") for (int k = 0; k < 2; ++k) dst[m][k] = *(const LAS bf16x8*)(lds + PG8_SA(b, h) + aoff + m * 2048 + k * PSTEP); } while (0)
#define PG8_LDB(dst, b, h) do { _Pragma("unroll") for (int n = 0; n < 2; ++n) _Pragma("unroll") for (int k = 0; k < 2; ++k) dst[n][k] = *(const LAS bf16x8*)(lds + PG8_SB(b, h) + boff + n * 2048 + k * PSTEP); } while (0)
#define PG8_MMA(ai, bj, At, Bt) do { __builtin_amdgcn_s_setprio(1); \
        if constexpr (F8) { _Pragma("unroll") for (int m = 0; m < 4; ++m) _Pragma("unroll") for (int n = 0; n < 2; ++n) \
            mfma_f8_inplace(acc[ai][bj][m][n], pk32(Bt[n][0], Bt[n][1]), pk32(At[m][0], At[m][1]), one_scale); \
            asm volatile("s_nop 15\n\ts_nop 15" ::: ); } \
        else { _Pragma("unroll") for (int m = 0; m < 4; ++m) _Pragma("unroll") for (int n = 0; n < 2; ++n) _Pragma("unroll") for (int k = 0; k < 2; ++k) \
            acc[ai][bj][m][n] = __builtin_amdgcn_mfma_f32_16x16x32_bf16(Bt[n][k], At[m][k], acc[ai][bj][m][n], 0, 0, 0); } \
        __builtin_amdgcn_s_setprio(0); } while (0)
#define PG8_WAIT_V(n) asm volatile("s_waitcnt vmcnt(" #n ")" ::: "memory")
#define PG8_WAIT_L(n) asm volatile("s_waitcnt lgkmcnt(" #n ")" ::: "memory")
#define PG8_BAR __builtin_amdgcn_s_barrier()
#define PG8_SCHED __builtin_amdgcn_sched_barrier(0)
    int one_scale = 0x7F7F7F7F; asm volatile("" : "+v"(one_scale));
    Unit cur, nxt; int ui = 0;
    if (!S.next(0, cur)) return;
    cur.pm = __builtin_amdgcn_readfirstlane(cur.pm); cur.pn = __builtin_amdgcn_readfirstlane(cur.pn);
    f32x4 acc[2][2][4][2];
#pragma unroll
    for (int a = 0; a < 2; ++a)
#pragma unroll
        for (int b = 0; b < 2; ++b)
#pragma unroll
            for (int m = 0; m < 4; ++m)
#pragma unroll
                for (int n = 0; n < 2; ++n) acc[a][b][m][n] = (f32x4){0.f, 0.f, 0.f, 0.f};
    bf16x8 At[4][2], B0[2][2], B1[2][2];
    const char* cA = (const char*)g.A + (size_t)cur.pm * tstep; const char* cB = (const char*)g.Bt + (size_t)cur.pn * tstep;
    PG8_STAGE(PG8_SB(0, 0), cB, voffB); PG8_STAGE(PG8_SB(0, 1), cB + hstep, voffB); PG8_STAGE(PG8_SA(0, 0), cA, voffA); PG8_STAGE(PG8_SA(0, 1), cA + hstep, voffA);
    if (wr == 1) PG8_BAR;
    PG8_WAIT_V(2); PG8_BAR;
    PG8_STAGE(PG8_SB(1, 0), cB + kstep, voffB); PG8_STAGE(PG8_SA(1, 0), cA + kstep, voffA); PG8_STAGE(PG8_SB(1, 1), cB + hstep + kstep, voffB);
    PG8_WAIT_V(6); PG8_BAR;
    for (;;) {
        const bool has_next = S.next(ui + 1, nxt); nxt.pm = __builtin_amdgcn_readfirstlane(nxt.pm); nxt.pn = __builtin_amdgcn_readfirstlane(nxt.pn);
        const char* nA = has_next ? (const char*)g.A + (size_t)nxt.pm * tstep : cA; const char* nB = has_next ? (const char*)g.Bt + (size_t)nxt.pn * tstep : cB;
#pragma unroll 1
        for (int t = 0; t < nt; t += 2) {
            const bool last = (t == nt - 2);
            const char* a1 = cA + (size_t)(t + 1) * kstep;
            const char* a2 = last ? nA : cA + (size_t)(t + 2) * kstep; const char* b2 = last ? nB : cB + (size_t)(t + 2) * kstep;
            const char* a3 = a2 + kstep; const char* b3 = b2 + kstep;
            PG8_LDB(B0, 0, 0); PG8_LDB(B1, 0, 1); PG8_SCHED; PG8_LDA(At, 0, 0); PG8_STAGE(PG8_SA(1, 1), a1 + hstep, voffA);
            PG8_WAIT_V(8); PG8_WAIT_L(0); PG8_BAR; PG8_MMA(0, 0, At, B0); PG8_MMA(0, 1, At, B1); PG8_BAR; PG8_SCHED;
            PG8_LDA(At, 0, 1); PG8_STAGE(PG8_SB(0, 0), b2, voffB); PG8_STAGE(PG8_SB(0, 1), b2 + hstep, voffB); PG8_STAGE(PG8_SA(0, 0), a2, voffA);
            PG8_WAIT_V(8); PG8_WAIT_L(0); PG8_BAR; PG8_MMA(1, 0, At, B0); PG8_MMA(1, 1, At, B1); PG8_BAR; PG8_SCHED;
            PG8_LDB(B0, 1, 0); PG8_LDB(B1, 1, 1); PG8_SCHED; PG8_LDA(At, 1, 0); PG8_STAGE(PG8_SA(0, 1), a2 + hstep, voffA);
            PG8_WAIT_V(8); PG8_WAIT_L(0); PG8_BAR; PG8_MMA(0, 0, At, B0); PG8_MMA(0, 1, At, B1); PG8_BAR; PG8_SCHED;
            PG8_LDA(At, 1, 1); PG8_STAGE(PG8_SB(1, 0), b3, voffB); PG8_STAGE(PG8_SB(1, 1), b3 + hstep, voffB); PG8_STAGE(PG8_SA(1, 0), a3, voffA);
            PG8_WAIT_V(8); PG8_WAIT_L(0); PG8_BAR; PG8_MMA(1, 0, At, B0); PG8_MMA(1, 1, At, B1); PG8_BAR; PG8_SCHED;
            if constexpr (Epi::MIDK) { if (t == nt / 2 - 2) E.mid(acc, cur, wr, wc, fr, fq); }
        }
        if (wr == 0) PG8_BAR;
        E(acc, cur, wr, wc, fr, fq);
        if (!has_next) break;
#pragma unroll
        for (int a = 0; a < 2; ++a)
#pragma unroll
            for (int b = 0; b < 2; ++b)
#pragma unroll
                for (int m = 0; m < 4; ++m)
#pragma unroll
                    for (int n = 0; n < 2; ++n) acc[a][b][m][n] = (f32x4){0.f, 0.f, 0.f, 0.f};
        cur = nxt; cA = nA; cB = nB; ++ui;
        if (wr == 1) PG8_BAR;
    }
    PG8_WAIT_V(0);
    PG8_BAR;
#undef PG8_SA
#undef PG8_SB
#undef PG8_STAGE
#undef PG8_LDA
#undef PG8_LDB
#undef PG8_MMA
#undef PG8_WAIT_V
#undef PG8_WAIT_L
#undef PG8_BAR
#undef PG8_SCHED
}
}

struct Params {
    const float* x; const int* pos; const float* norm1_g; const float* w_in; const float* q_norm_g; const float* k_norm_g;
    const float* idx_g; const float* idx_b; const float* w_a; const float* pool_mix; const float* pool_scale; const float* w_b;
    const float* w_out; const float* norm2_g; const float* router_w; const float* router_b; const float* w_gu; const float* b_gu;
    const float* w_d; const float* b_d;
    float* out; unsigned char* ws; int ph_lo, ph_hi;
};

using pg8::Unit; using pg8::HALF;
__device__ __forceinline__ void st8(bf16_t* p, const float (&v)[8]) {
    u32x4 w; w.x = cvt_pk_bf16(v[0], v[1]); w.y = cvt_pk_bf16(v[2], v[3]); w.z = cvt_pk_bf16(v[4], v[5]); w.w = cvt_pk_bf16(v[6], v[7]); *(u32x4*)p = w;
}
__device__ __forceinline__ void ld8f(const float* p, float (&v)[8]) { const f32x4 a = *(const f32x4*)p, b = *(const f32x4*)(p + 4); v[0]=a[0]; v[1]=a[1]; v[2]=a[2]; v[3]=a[3]; v[4]=b[0]; v[5]=b[1]; v[6]=b[2]; v[7]=b[3]; }
__device__ __forceinline__ void ld8bf(const bf16_t* p, float (&v)[8]) { const u32x4 w = *(const u32x4*)p; v[0]=bf_lo(w.x); v[1]=bf_hi(w.x); v[2]=bf_lo(w.y); v[3]=bf_hi(w.y); v[4]=bf_lo(w.z); v[5]=bf_hi(w.z); v[6]=bf_lo(w.w); v[7]=bf_hi(w.w); }

struct EpiInProj {
    static constexpr bool MIDK = false;
    bf16_t *Q, *Kb, *Vb, *Qi, *Ki, *Pool, *Ga, *Gp; float* Wi; const float* cs; const float *gq, *gk, *lng, *lnb;
    __device__ __forceinline__ void operator()(const f32x4 (&acc)[2][2][4][2], const Unit& u, int wr, int wc, int fr, int fq) const {
        const int pn = u.pn;
#pragma unroll
        for (int ai = 0; ai < 2; ++ai)
#pragma unroll
            for (int m = 0; m < 4; ++m) {
                const int row = u.pm * 256 + ai * HALF + wr * 64 + m * 16 + fr;
                float v0[8], v1[8];
#pragma unroll
                for (int n = 0; n < 2; ++n)
#pragma unroll
                    for (int i = 0; i < 4; ++i) { v0[4 * n + i] = acc[ai][0][m][n][i]; v1[4 * n + i] = acc[ai][1][m][n][i]; }
                if (pn <= 1 || (pn == 2 && wc < 2)) {
                    float ss = 0.f;
#pragma unroll
                    for (int j = 0; j < 8; ++j) ss += v0[j] * v0[j] + v1[j] * v1[j];
                    ss += __shfl_xor(ss, 16); ss += __shfl_xor(ss, 32);
                    const float rs = 1.0f / sqrtf(ss * (1.0f / 64.0f) + NORM_EPS);
                    const float* gg = (pn <= 1) ? gq : gk; const float sc = (pn <= 1) ? 0.18033688011112042f : 1.0f;
                    float g0[8], g1[8], cc[8], sn[8];
                    ld8f(gg + 8 * fq, g0); ld8f(gg + 32 + 8 * fq, g1);
                    ld8f(cs + (size_t)row * 96 + 8 * fq, cc); ld8f(cs + (size_t)row * 96 + 48 + 8 * fq, sn);
                    float o0[8], o1[8];
#pragma unroll
                    for (int j = 0; j < 8; ++j) { const float x1 = v0[j] * rs * g0[j], x2 = v1[j] * rs * g1[j]; o0[j] = (x1 * cc[j] - x2 * sn[j]) * sc; o1[j] = (x2 * cc[j] + x1 * sn[j]) * sc; }
                    if (pn <= 1) { bf16_t* dst = Q + (size_t)row * 512 + (4 * pn + wc) * 64; st8(dst + 8 * fq, o0); st8(dst + 32 + 8 * fq, o1); }
                    else {
                        bf16_t* dst = Kb + ((((size_t)((row >> 12) * 2 + wc) * 128 + ((row & 4095) >> 5)) * 4 + (fq >> 1)) * 64 + ((fq & 1) * 32 + (row & 31))) * 8;
                        st8(dst, o0); st8(dst + 2 * 512, o1); }
                } else if (pn == 2) {
                    const int t = row & 4095, kk = t & 31;
                    bf16_t* dst = Vb + (((size_t)((row >> 12) * 2 + (wc - 2)) * 128 + (t >> 5)) * 4 + (kk >> 4)) * 512 + (((kk >> 2) & 1) * 32 + 8 * fq) * 8 + 4 * ((kk >> 3) & 1) + (kk & 3);
#pragma unroll
                    for (int j = 0; j < 8; ++j) { dst[j * 8] = (bf16_t)(cvt_pk_bf16(v0[j], v0[j]) & 0xffffu); dst[2 * 512 + j * 8] = (bf16_t)(cvt_pk_bf16(v1[j], v1[j]) & 0xffffu); }
                } else if (pn == 3 || (pn == 4 && wc == 0)) {
                    if (pn == 4) {
                        float s = 0.f;
#pragma unroll
                        for (int j = 0; j < 8; ++j) s += v0[j] + v1[j];
                        s += __shfl_xor(s, 16); s += __shfl_xor(s, 32);
                        const float mu = s * (1.0f / 64.0f); float q = 0.f;
#pragma unroll
                        for (int j = 0; j < 8; ++j) { v0[j] -= mu; v1[j] -= mu; q += v0[j] * v0[j] + v1[j] * v1[j]; }
                        q += __shfl_xor(q, 16); q += __shfl_xor(q, 32);
                        const float rs = 1.0f / sqrtf(q * (1.0f / 64.0f) + NORM_EPS);
                        const int d0 = (fq < 2) ? 8 * fq : 8 * fq + 16, d1 = (fq < 2) ? 16 + 8 * fq : 8 * fq + 32;
                        float a0[8], a1[8], b0[8], b1[8];
                        ld8f(lng + d0, a0); ld8f(lng + d1, a1); ld8f(lnb + d0, b0); ld8f(lnb + d1, b1);
#pragma unroll
                        for (int j = 0; j < 8; ++j) { v0[j] = v0[j] * rs * a0[j] + b0[j]; v1[j] = v1[j] * rs * a1[j] + b1[j]; }
                    }
                    bf16_t* dst = Qi + (size_t)row * 256 + wc * 64;
                    bf16_t* kdst = Ki + (((size_t)(row >> 12) * 128 + ((row & 4095) >> 5)) * 4 * 64 + (row & 31)) * 8;
                    if (fq < 2) {
                        float cc[8], sn[8];
                        ld8f(cs + (size_t)row * 96 + 32 + 8 * fq, cc); ld8f(cs + (size_t)row * 96 + 48 + 32 + 8 * fq, sn);
                        float o0[8], o1[8];
#pragma unroll
                        for (int j = 0; j < 8; ++j) { o0[j] = v0[j] * cc[j] - v1[j] * sn[j]; o1[j] = v1[j] * cc[j] + v0[j] * sn[j]; }
                        if (pn == 3) { st8(dst + 8 * fq, o0); st8(dst + 16 + 8 * fq, o1); }
                        else { st8(kdst + (fq * 32) * 8, o0); st8(kdst + (64 + fq * 32) * 8, o1); }
                    } else {
                        if (pn == 3) { st8(dst + 8 * fq + 16, v0); st8(dst + 8 * fq + 32, v1); }
                        else { st8(kdst + (2 * 64 + (fq - 2) * 32) * 8, v0); st8(kdst + (3 * 64 + (fq - 2) * 32) * 8, v1); } }
                } else if (pn == 4) {
                    if (wc == 1 && fq == 0) *(f32x4*)(Wi + (size_t)row * 4) = (f32x4){v0[0] * 0.0625f, v0[1] * 0.0625f, v0[2] * 0.0625f, v0[3] * 0.0625f};
                } else if (pn <= 6) {
                    bf16_t* dst = Pool + (size_t)row * 512 + (pn - 5) * 256 + wc * 32 + 8 * fq;
                    st8(dst, v0); st8(dst + HALF, v1);
                } else {
                    bf16_t* dst = ((pn <= 10) ? Ga + (size_t)row * 1024 + (pn - 7) * 256 : Gp + (size_t)row * 1024 + (pn - 11) * 256) + wc * 32 + 8 * fq;
#pragma unroll
                    for (int j = 0; j < 8; ++j) { v0[j] = sigmoidf_(v0[j]); v1[j] = sigmoidf_(v1[j]); }
                    st8(dst, v0); st8(dst + HALF, v1);
                }
            }
    }
};

struct EpiGated {
    static constexpr bool MIDK = true;
    const bf16_t* Ga; const bf16_t* Gp; bf16_t* O;
    __device__ __forceinline__ void mid(f32x4 (&acc)[2][2][4][2], const Unit& u, int wr, int wc, int fr, int fq) const {
        asm volatile("" : "+v"(fr), "+v"(fq));
#pragma unroll
        for (int ai = 0; ai < 2; ++ai)
#pragma unroll
            for (int m = 0; m < 4; ++m) {
                const size_t off = (size_t)(u.pm * 256 + ai * HALF + wr * 64 + m * 16 + fr) * 1024 + u.pn * 256 + wc * 32 + 8 * fq;
#pragma unroll
                for (int bj = 0; bj < 2; ++bj) {
                    float ga[8], gp[8]; ld8bf(Ga + off + bj * HALF, ga); ld8bf(Gp + off + bj * HALF, gp);
#pragma unroll
                    for (int n = 0; n < 2; ++n)
#pragma unroll
                        for (int i = 0; i < 4; ++i) acc[ai][bj][m][n][i] *= ga[4 * n + i] * __builtin_amdgcn_rcpf(fmaxf(gp[4 * n + i], 1e-30f));
                }
                if (m & 1) asm volatile("" ::: "memory");
            }
    }
    __device__ __forceinline__ void operator()(const f32x4 (&acc)[2][2][4][2], const Unit& u, int wr, int wc, int fr, int fq) const {
        asm volatile("" : "+v"(fr), "+v"(fq));
#pragma unroll
        for (int ai = 0; ai < 2; ++ai)
#pragma unroll
            for (int m = 0; m < 4; ++m) {
                const size_t off = (size_t)(u.pm * 256 + ai * HALF + wr * 64 + m * 16 + fr) * 1024 + u.pn * 256 + wc * 32 + 8 * fq;
#pragma unroll
                for (int bj = 0; bj < 2; ++bj) {
                    float g[8], o[8]; ld8bf(Gp + off + bj * HALF, g);
#pragma unroll
                    for (int n = 0; n < 2; ++n)
#pragma unroll
                        for (int i = 0; i < 4; ++i) o[4 * n + i] = g[4 * n + i] * acc[ai][bj][m][n][i];
                    st8(O + off + bj * HALF, o);
                }
            }
    }
};
struct EpiResid {
    static constexpr bool MIDK = false;
    const float* X; float* O;
    __device__ __forceinline__ void operator()(const f32x4 (&acc)[2][2][4][2], const Unit& u, int wr, int wc, int fr, int fq) const {
#pragma unroll
        for (int ai = 0; ai < 2; ++ai)
#pragma unroll
            for (int m = 0; m < 4; ++m) {
                const size_t off = (size_t)(u.pm * 256 + ai * HALF + wr * 64 + m * 16 + fr) * 1024 + u.pn * 256 + wc * 32 + 8 * fq;
#pragma unroll
                for (int bj = 0; bj < 2; ++bj)
#pragma unroll
                    for (int n = 0; n < 2; ++n) { const size_t o = off + bj * HALF + 4 * n; *(f32x4*)(O + o) = *(const f32x4*)(X + o) + acc[ai][bj][m][n]; }
            }
    }
};
struct EpiGateUp {
    static constexpr bool MIDK = false;
    const float* bias; unsigned char* Act;
    __device__ __forceinline__ void operator()(const f32x4 (&acc)[2][2][4][2], const Unit& u, int wr, int wc, int fr, int fq) const {
        { int t_ = threadIdx.x; asm volatile("" : "+v"(t_)); fr = t_ & 15; fq = (t_ >> 4) & 3; }
        const int e = u.pn >> 3, pnl = u.pn & 7, col = pnl * 128 + wc * 32 + 8 * fq;
        float bg[8], bu[8]; ld8f(bias + (size_t)e * 2048 + col, bg); ld8f(bias + (size_t)e * 2048 + 1024 + col, bu);
#pragma unroll
        for (int ai = 0; ai < 2; ++ai)
#pragma unroll
            for (int m = 0; m < 4; ++m) {
                const size_t row = (size_t)(u.pm * 256 + ai * HALF + wr * 64 + m * 16 + fr);
                float o[8];
#pragma unroll
                for (int n = 0; n < 2; ++n)
#pragma unroll
                    for (int i = 0; i < 4; ++i) { const int j = 4 * n + i;
                        const float gt = fminf(acc[ai][0][m][n][i] * MOE_WINV + bg[j], 7.0f), up = fminf(fmaxf(acc[ai][1][m][n][i] * MOE_WINV + bu[j], -7.0f), 7.0f);
                        o[j] = __builtin_amdgcn_fmed3f(gt * sigmoidf_(1.702f * gt) * (up + 1.0f), -448.0f, 448.0f); }
                u32x2 w; w.x = pk4_fp8(o[0], o[1], o[2], o[3]); w.y = pk4_fp8(o[4], o[5], o[6], o[7]);
                *(u32x2*)(Act + row * 1024 + col) = w;
            }
    }
};
struct EpiDown {
    static constexpr bool MIDK = false;
    const float* bias; const float* sgate; bf16_t* Y;
    __device__ __forceinline__ void operator()(const f32x4 (&acc)[2][2][4][2], const Unit& u, int wr, int wc, int fr, int fq) const {
        { int t_ = threadIdx.x; asm volatile("" : "+v"(t_)); fr = t_ & 15; fq = (t_ >> 4) & 3; }
        const int e = u.pn >> 2, pnl = u.pn & 3, col = pnl * 256 + wc * 32 + 8 * fq;
        float b0[8], b1[8]; ld8f(bias + (size_t)e * 1024 + col, b0); ld8f(bias + (size_t)e * 1024 + col + HALF, b1);
#pragma unroll
        for (int ai = 0; ai < 2; ++ai)
#pragma unroll
            for (int m = 0; m < 4; ++m) {
                const size_t row = (size_t)(u.pm * 256 + ai * HALF + wr * 64 + m * 16 + fr);
                const float gt = sgate[row];
                float o0[8], o1[8];
#pragma unroll
                for (int n = 0; n < 2; ++n)
#pragma unroll
                    for (int i = 0; i < 4; ++i) { const int j = 4 * n + i; o0[j] = (acc[ai][0][m][n][i] * MOE_WINV + b0[j]) * gt; o1[j] = (acc[ai][1][m][n][i] * MOE_WINV + b1[j]) * gt; }
                st8(Y + row * 1024 + col, o0); st8(Y + row * 1024 + col + HALF, o1);
            }
    }
};

template <class RowMap>
__device__ __forceinline__ void cvt_item(const float* W, int K, int N, bf16_t* WT, LAS float* scr, int kb, int nb, int lane, const RowMap& rm, int ldt = 0) {
    if (ldt == 0) ldt = K;
    const int k0 = kb * 64, n0 = nb * 64, n4 = lane & 15, kr = lane >> 4, n = n0 + 4 * n4;
    f32x4 v[16];
#pragma unroll
    for (int i = 0; i < 16; ++i) v[i] = (n < N) ? *(const f32x4*)(W + (size_t)(k0 + 4 * i + kr) * N + n) : (f32x4){0.f, 0.f, 0.f, 0.f};
#pragma unroll
    for (int i = 0; i < 16; ++i) { LAS float* d = scr + (4 * i + kr) * 65 + 4 * n4; d[0] = v[i][0]; d[1] = v[i][1]; d[2] = v[i][2]; d[3] = v[i][3]; }
    LDS_WAIT(); asm volatile("" ::: "memory");
    const int c8 = lane & 7;
#pragma unroll
    for (int jj = 0; jj < 8; ++jj) { const int nn = (lane >> 3) + 8 * jj; const LAS float* s = scr + (8 * c8) * 65 + nn;
        if (n0 + nn < N) { u32x4 o; o.x = cvt_pk_bf16(s[0], s[65]); o.y = cvt_pk_bf16(s[2 * 65], s[3 * 65]); o.z = cvt_pk_bf16(s[4 * 65], s[5 * 65]); o.w = cvt_pk_bf16(s[6 * 65], s[7 * 65]);
            *(u32x4*)(WT + (size_t)rm(n0 + nn) * ldt + k0 + 8 * c8) = o; } }
    LDS_WAIT(); asm volatile("" ::: "memory");
}
template <class RowMap>
__device__ __forceinline__ void cvt_item_f8(const float* W, int K, int N, unsigned char* WT, LAS float* scr, int kb, int nb, int lane, const RowMap& rm, float scale) {
    const int k0 = kb * 64, n0 = nb * 64, n4 = lane & 15, kr = lane >> 4, n = n0 + 4 * n4;
    f32x4 v[16];
#pragma unroll
    for (int i = 0; i < 16; ++i) v[i] = *(const f32x4*)(W + (size_t)(k0 + 4 * i + kr) * N + n);
#pragma unroll
    for (int i = 0; i < 16; ++i) { LAS float* d = scr + (4 * i + kr) * 65 + 4 * n4; d[0] = v[i][0] * scale; d[1] = v[i][1] * scale; d[2] = v[i][2] * scale; d[3] = v[i][3] * scale; }
    LDS_WAIT(); asm volatile("" ::: "memory");
    const int c8 = lane & 7;
#pragma unroll
    for (int jj = 0; jj < 8; ++jj) { const int nn = (lane >> 3) + 8 * jj; const LAS float* sp = scr + (8 * c8) * 65 + nn;
        u32x2 o; o.x = pk4_fp8(sp[0], sp[65], sp[2 * 65], sp[3 * 65]); o.y = pk4_fp8(sp[4 * 65], sp[5 * 65], sp[6 * 65], sp[7 * 65]);
        *(u32x2*)(WT + (size_t)rm(n0 + nn) * K + k0 + 8 * c8) = o; }
    LDS_WAIT(); asm volatile("" ::: "memory");
}
struct RmIdent { int off; __device__ __forceinline__ int operator()(int n) const { return off + n; } };
struct RmWin { __device__ __forceinline__ int operator()(int n) const { return win_phys(n); } };
struct RmGu { int e; __device__ __forceinline__ int operator()(int n) const { return e * 2048 + 256 * ((n & 1023) >> 7) + 128 * (n >> 10) + (n & 127); } };

__device__ __forceinline__ void phase0(const Params& p, LAS unsigned char* lds, int bid, int G) {
    const int tid = threadIdx.x, lane = tid & 63, wave = __builtin_amdgcn_readfirstlane(tid >> 6);
    const int gw = bid * NWAVES + wave, NGW = G * NWAVES;
    unsigned char* ws = p.ws;
    LAS float* scr = (LAS float*)(lds + wave * 16640);
    constexpr int I_GU = NEXP * 16 * 32, I_D = NEXP * 16 * 16, I_IN = 16 * 58, I_A = 8 * 16, I_O = 16 * 16;
    constexpr int NITEMS = I_GU + I_D + I_IN + I_A + I_O;
    for (int it = gw; it < NITEMS; it += NGW) {
        int r = it;
        if (r < I_GU) { const int e = r / 512, q = r % 512; cvt_item_f8(p.w_gu + (size_t)e * 1024 * 2048, 1024, 2048, ws + WS_WGU, scr, q / 32, q % 32, lane, RmGu{e}, MOE_WSCALE); continue; } r -= I_GU;
        if (r < I_D) { const int e = r / 256, q = r % 256; cvt_item_f8(p.w_d + (size_t)e * 1024 * 1024, 1024, 1024, ws + WS_WD, scr, q / 16, q % 16, lane, RmIdent{e * 1024}, MOE_WSCALE); continue; } r -= I_D;
        if (r < I_IN) { cvt_item(p.w_in, 1024, INW, (bf16_t*)(ws + WS_WIN), scr, r / 58, r % 58, lane, RmWin{}); continue; } r -= I_IN;
        if (r < I_A) { cvt_item(p.w_a, 512, 1024, (bf16_t*)(ws + WS_WCAT), scr, r / 16, r % 16, lane, RmIdent{0}, 1024); continue; } r -= I_A;
        cvt_item(p.w_out, 1024, 1024, (bf16_t*)(ws + WS_WOUT), scr, r / 16, r % 16, lane, RmIdent{0});
    }
    for (int it = gw; it < 16 * 4 * 16; it += NGW) {
        const int nb = it & 15, g = (it >> 4) & 3, cb = it >> 6, n = nb * 64 + lane, c0 = cb * 8;
        float a[8];
#pragma unroll
        for (int q = 0; q < 8; ++q) a[q] = 0.f;
        const float* mix = p.pool_mix + (size_t)g * 128 * 128 + (size_t)c0 * 128;
        for (int d = 0; d < 128; ++d) {
            const float wb = p.pool_scale[g * 128 + d] * p.w_b[(size_t)(g * 128 + d) * 1024 + n];
#pragma unroll
            for (int q = 0; q < 8; ++q) a[q] += mix[q * 128 + d] * wb;
        }
        st8((bf16_t*)(ws + WS_WCAT) + (size_t)n * 1024 + 512 + g * 128 + c0, a);
    }
    {
        f32x4 gv[4];
#pragma unroll
        for (int j = 0; j < 4; ++j) gv[j] = *(const f32x4*)(p.norm1_g + 4 * lane + 256 * j);
        bf16_t* XN = (bf16_t*)(ws + WS_XN);
        for (int m = gw; m < NTOK; m += NGW) {
            const f32x4* xr = (const f32x4*)(p.x + (size_t)m * D) + lane;
            f32x4 v[4]; float s = 0.f;
#pragma unroll
            for (int j = 0; j < 4; ++j) { v[j] = xr[64 * j]; s += (v[j].x * v[j].x + v[j].y * v[j].y) + (v[j].z * v[j].z + v[j].w * v[j].w); }
            const float rs = 1.0f / sqrtf(wave_sum(s) * (1.0f / D) + NORM_EPS);
#pragma unroll
            for (int j = 0; j < 4; ++j) { const f32x4 o = v[j] * rs * gv[j]; u32x2 w; w.x = cvt_pk_bf16(o.x, o.y); w.y = cvt_pk_bf16(o.z, o.w); *(u32x2*)(XN + (size_t)m * D + 4 * lane + 256 * j) = w; }
        }
    }
    {
        float* cs = (float*)(ws + WS_CS);
        for (int i = bid * NTHREADS + tid; i < NTOK * 48; i += G * NTHREADS) {
            const int row = i / 48, j = i % 48;
            const float ex = (j < 32) ? -(float)j / 32.0f : -(float)(j - 32) / 16.0f;
            const float ang = (float)p.pos[row] * powf(10000.0f, ex);
            float sn, cc; sincosf(ang, &sn, &cc);
            cs[(size_t)row * 96 + j] = cc; cs[(size_t)row * 96 + 48 + j] = sn;
        }
    }
}

__device__ __forceinline__ void pool_phase(const Params& p, int bid, int G) {
    const int tid = threadIdx.x, lane = tid & 63, wave = __builtin_amdgcn_readfirstlane(tid >> 6);
    const int gw = bid * NWAVES + wave, NGW = G * NWAVES;
    const bf16_t* Pool = (const bf16_t*)(p.ws + WS_POOL); bf16_t* Mixed = (bf16_t*)(p.ws + WS_ACAT) + 512;
    const int w = 2 << (lane >> 4);
    for (int it = gw; it < NBATCH * 256; it += NGW) {
        const int b = it >> 8, tb = (it & 255) * 16;
        const bf16_t* P = Pool + (size_t)b * SEQ * 512 + 8 * lane;
        float sum[8];
#pragma unroll
        for (int q = 0; q < 8; ++q) sum[q] = 0.f;
        for (int d = 1; d < 16; ++d) if (d < w && tb - d >= 0) { float v[8]; ld8bf(P + (size_t)(tb - d) * 512, v);
#pragma unroll
            for (int q = 0; q < 8; ++q) sum[q] += v[q]; }
        for (int t = tb; t < tb + 16; ++t) {
            float cur[8]; ld8bf(P + (size_t)t * 512, cur);
#pragma unroll
            for (int q = 0; q < 8; ++q) sum[q] += cur[q];
            const float inv = 1.0f / (float)((t + 1 < w) ? t + 1 : w);
            float o[8];
#pragma unroll
            for (int q = 0; q < 8; ++q) o[q] = sum[q] * inv - cur[q];
            st8(Mixed + ((size_t)b * SEQ + t) * 1024 + 8 * lane, o);
            if (t - w + 1 >= 0) { float old[8]; ld8bf(P + (size_t)(t - w + 1) * 512, old);
#pragma unroll
                for (int q = 0; q < 8; ++q) sum[q] -= old[q]; }
        }
    }
}

__device__ __forceinline__ int wave_sum_i(int v) {
    v += __builtin_amdgcn_update_dpp(0, v, 0xB1, 0xF, 0xF, true);
    v += __builtin_amdgcn_update_dpp(0, v, 0x4E, 0xF, 0xF, true);
    v += __builtin_amdgcn_update_dpp(0, v, 0x141, 0xF, 0xF, true);
    v += __builtin_amdgcn_update_dpp(0, v, 0x140, 0xF, 0xF, true);
    v += __builtin_amdgcn_update_dpp(0, v, 0x142, 0xA, 0xF, true);
    v += __builtin_amdgcn_update_dpp(0, v, 0x143, 0xC, 0xF, true);
    return __builtin_amdgcn_readlane(v, 63);
}
__device__ __forceinline__ int count_ge(const unsigned (&key)[64], int nj, unsigned mid) {
    int c0 = 0, c1 = 0, c2 = 0, c3 = 0;
#pragma unroll
    for (int jb = 0; jb < 8; ++jb) if (jb * 8 < nj) {
        c0 += (key[jb * 8 + 0] >= mid) ? 1 : 0; c1 += (key[jb * 8 + 1] >= mid) ? 1 : 0; c2 += (key[jb * 8 + 2] >= mid) ? 1 : 0; c3 += (key[jb * 8 + 3] >= mid) ? 1 : 0;
        c0 += (key[jb * 8 + 4] >= mid) ? 1 : 0; c1 += (key[jb * 8 + 5] >= mid) ? 1 : 0; c2 += (key[jb * 8 + 6] >= mid) ? 1 : 0; c3 += (key[jb * 8 + 7] >= mid) ? 1 : 0; }
    return wave_sum_i((c0 + c1) + (c2 + c3));
}
__device__ __forceinline__ int lane_prefix(unsigned long long m) { return __builtin_amdgcn_mbcnt_hi((unsigned)(m >> 32), __builtin_amdgcn_mbcnt_lo((unsigned)m, 0u)); }
__device__ __forceinline__ unsigned wave_umax(unsigned v) {
#pragma unroll
    for (int o = 1; o < 64; o <<= 1) { const unsigned t = (unsigned)__shfl_xor((int)v, o); v = t > v ? t : v; }
    return (unsigned)__builtin_amdgcn_readfirstlane((int)v);
}
__device__ __forceinline__ unsigned wave_umin(unsigned v) {
#pragma unroll
    for (int o = 1; o < 64; o <<= 1) { const unsigned t = (unsigned)__shfl_xor((int)v, o); v = t < v ? t : v; }
    return (unsigned)__builtin_amdgcn_readfirstlane((int)v);
}

__device__ __forceinline__ void select_unit(const Params& p, LAS unsigned char* lds, int b, int t0) {
    int tid = threadIdx.x; asm volatile("" : "+v"(tid));
    const int lane = tid & 63, wave = __builtin_amdgcn_readfirstlane(tid >> 6);
    unsigned char* wsq = p.ws; asm volatile("" : "+s"(wsq));
    const bf16_t* Qi = (const bf16_t*)(wsq + WS_QI); const bf16_t* Ki = (const bf16_t*)(wsq + WS_KI); const float* Wi = (const float*)(wsq + WS_WI);
    unsigned* M32 = (unsigned*)(wsq + WS_MASK);
    LAS float* SC = (LAS float*)lds;
    const int c = t0 >> 6, nj = c + 1, nk = 64 * nj, ntile = nk >> 5;
    const size_t tok0 = (size_t)b * SEQ + t0;
    {
        const int r = lane & 31, hh = lane >> 5;
        bf16x8 qa[4];
        const bf16_t* qp = Qi + (tok0 + (r >> 2)) * 256 + (r & 3) * 64 + 8 * hh;
#pragma unroll
        for (int ks = 0; ks < 4; ++ks) qa[ks] = *(const bf16x8*)(qp + 16 * ks);
        f32x4 wv[4];
#pragma unroll
        for (int g = 0; g < 4; ++g) wv[g] = *(const f32x4*)(Wi + (tok0 + 2 * g + hh) * 4);
        const bf16_t* kif = Ki + (size_t)b * 128 * 4 * 512 + lane * 8;
        bf16x8 kbA[4][4], kbB[4][4];
#define LOADK(dst, k0) do { _Pragma("unroll") for (int u = 0; u < 4; ++u) { const int kt = ((k0) + u < ntile) ? (k0) + u : (k0); \
            _Pragma("unroll") for (int ks = 0; ks < 4; ++ks) dst[u][ks] = *(const bf16x8*)(kif + (size_t)(kt * 4 + ks) * 512); } } while (0)
#define COMPK(src, k0) do { _Pragma("unroll") for (int u = 0; u < 4; ++u) if ((k0) + u < ntile) { f32x16 acc; \
            _Pragma("unroll") for (int q = 0; q < 16; ++q) acc[q] = 0.f; \
            _Pragma("unroll") for (int ks = 0; ks < 4; ++ks) acc = __builtin_amdgcn_mfma_f32_32x32x16_bf16(qa[ks], src[u][ks], acc, 0, 0, 0); \
            _Pragma("unroll") for (int g = 0; g < 4; ++g) { float sv = fmaf(wv[g][0], fmaxf(acc[4 * g], 0.f), 0.0f); \
                sv = fmaf(wv[g][1], fmaxf(acc[4 * g + 1], 0.f), sv); sv = fmaf(wv[g][2], fmaxf(acc[4 * g + 2], 0.f), sv); sv = fmaf(wv[g][3], fmaxf(acc[4 * g + 3], 0.f), sv); \
                SC[(2 * g + hh) * 4096 + ((k0) + u) * 32 + r] = sv; } } } while (0)
        int kt0 = wave * 4;
        if (kt0 < ntile) {
            LOADK(kbA, kt0);
            for (;;) {
                const int k1 = kt0 + NWAVES * 4; if (k1 < ntile) LOADK(kbB, k1);
                COMPK(kbA, kt0); if (k1 >= ntile) break;
                const int k2 = k1 + NWAVES * 4; if (k2 < ntile) LOADK(kbA, k2);
                COMPK(kbB, k1); if (k2 >= ntile) break;
                kt0 = k2;
            }
        }
#undef LOADK
#undef COMPK
    }
    __syncthreads();
    LAS float* row = SC + wave * 4096;
    unsigned key[64];
#pragma unroll
    for (int jb = 0; jb < 8; ++jb) {
#pragma unroll
        for (int q = 0; q < 8; ++q) key[jb * 8 + q] = 0u;
        if (jb * 8 < nj) {
#pragma unroll
            for (int q = 0; q < 8; ++q) { const int j = jb * 8 + q; const unsigned u = __float_as_uint(row[j * 64 + lane]); const unsigned kk = (u & 0x80000000u) ? ~u : (u | 0x80000000u); key[j] = (j < nj) ? kk : 0u; }
        }
    }
    unsigned hiSel = 1u, T = 0u; int rrem = 0;
    if (nk > 256) {
        unsigned g0 = 0u, g1 = 0u, g2 = 0u, g3 = 0u;
#pragma unroll
        for (int j = 0; j < 64; j += 4) { g0 = key[j] > g0 ? key[j] : g0; g1 = key[j + 1] > g1 ? key[j + 1] : g1; g2 = key[j + 2] > g2 ? key[j + 2] : g2; g3 = key[j + 3] > g3 ? key[j + 3] : g3; }
        const unsigned mx01 = g0 > g1 ? g0 : g1, mx23 = g2 > g3 ? g2 : g3, mn01 = g0 < g1 ? g0 : g1, mn23 = g2 < g3 ? g2 : g3;
        const unsigned km = wave_umax(mx01 > mx23 ? mx01 : mx23);
        unsigned lo = wave_umin(mn01 < mn23 ? mn01 : mn23), hi = km + 1u; int cnt_hi = 0; bool exact = false;
        while (hi - lo > 1u) {
            const unsigned mid = lo + ((hi - lo) >> 1);
            const int cnt = count_ge(key, nj, mid);
            if (cnt >= 256) { lo = mid; if (cnt == 256) { exact = true; break; } } else { hi = mid; cnt_hi = cnt; }
        }
        if (exact) { hiSel = lo; T = 0u; rrem = 0; } else { hiSel = hi; T = lo; rrem = 256 - cnt_hi; }
    }
    unsigned* mrow = M32 + (tok0 + wave) * 128;
#pragma unroll
    for (int j = 0; j < 64; ++j) if ((j & ~7) < nj) {
        const bool eq = (key[j] == T) && (key[j] < hiSel);
        const unsigned long long eqm = __ballot(eq);
        const bool take = eq && (lane_prefix(eqm) < rrem);
        const int ne = __popcll(eqm); rrem = (ne < rrem) ? rrem - ne : 0;
        const bool sel = (key[j] >= hiSel) || take;
        const unsigned long long sm = __ballot(sel);
        if (lane == 0) *(u32x2*)(mrow + 2 * j) = (u32x2){(unsigned)sm, (unsigned)(sm >> 32)};
    }
    __syncthreads();
}

__device__ __forceinline__ void dense_attn_chunk(const Params& p, int b, int c, float negC) {
    int tid = threadIdx.x; asm volatile("" : "+v"(tid));
    const int lane = tid & 63, wave = __builtin_amdgcn_readfirstlane(tid >> 6);
    unsigned char* wsq = p.ws; asm volatile("" : "+s"(wsq));
    const bf16_t* Qb = (const bf16_t*)(wsq + WS_Q); const bf16_t* Kb = (const bf16_t*)(wsq + WS_K); const bf16_t* VT = (const bf16_t*)(wsq + WS_VT);
    const unsigned* M32 = (const unsigned*)(wsq + WS_MASK); bf16_t* Attn = (bf16_t*)(wsq + WS_ACAT);
    const int kvh = wave >> 2, cl = lane & 31, hi = lane >> 5, ntile = 2 * (c + 1);
    const size_t tokc = (size_t)b * SEQ + 64 * c + 16 * (wave & 3);
    bf16x8 qf[2][4]; const unsigned* mrow[2]; size_t tokq[2];
#pragma unroll
    for (int ti = 0; ti < 2; ++ti) { tokq[ti] = tokc + 8 * ti + (cl >> 2); mrow[ti] = M32 + tokq[ti] * 128;
#pragma unroll
        for (int ks = 0; ks < 4; ++ks) qf[ti][ks] = *(const bf16x8*)(Qb + tokq[ti] * 512 + (4 * kvh + (cl & 3)) * 64 + 16 * ks + 8 * hi); }
    f32x16 o[2][2]; float lsum[2] = {0.f, 0.f};
#pragma unroll
    for (int ti = 0; ti < 2; ++ti)
#pragma unroll
        for (int dt = 0; dt < 2; ++dt)
#pragma unroll
            for (int q = 0; q < 16; ++q) o[ti][dt][q] = 0.f;
    const bf16_t* kbase = Kb + (size_t)(b * 2 + kvh) * 128 * 4 * 512 + lane * 8;
    const bf16_t* vbase = VT + (size_t)(b * 2 + kvh) * 128 * 4 * 512 + lane * 8;
    bf16x8 kfA[4], kfB[4], vfA[4], vfB[4]; unsigned mwA[2], mwB[2];
#define LOADT(kf, vf, mw, kt) do { _Pragma("unroll") for (int q = 0; q < 4; ++q) { kf[q] = *(const bf16x8*)(kbase + (size_t)((kt) * 4 + q) * 512); vf[q] = *(const bf16x8*)(vbase + (size_t)((kt) * 4 + q) * 512); } \
        mw[0] = mrow[0][kt]; mw[1] = mrow[1][kt]; } while (0)
#define COMPT(kf, vf, mw) do { _Pragma("unroll") for (int ti = 0; ti < 2; ++ti) { f32x16 sa; const unsigned mwh = mw[ti] >> (4 * hi); \
        _Pragma("unroll") for (int q = 0; q < 16; ++q) sa[q] = negC; \
        _Pragma("unroll") for (int ks = 0; ks < 4; ++ks) sa = __builtin_amdgcn_mfma_f32_32x32x16_bf16(kf[ks], qf[ti][ks], sa, 0, 0, 0); \
        float pv[16]; float ls = 0.f; \
        _Pragma("unroll") for (int r = 0; r < 16; ++r) { const int pos = (r & 3) + 8 * (r >> 2); \
            const float e = __builtin_amdgcn_exp2f(sa[r]); const int m = __builtin_amdgcn_sbfe((int)mwh, pos, 1); \
            pv[r] = __uint_as_float(__float_as_uint(e) & (unsigned)m); ls += pv[r]; } \
        lsum[ti] += ls; \
        _Pragma("unroll") for (int sx = 0; sx < 2; ++sx) { \
            u32x4 pw; pw.x = cvt_pk_bf16(pv[8 * sx], pv[8 * sx + 1]); pw.y = cvt_pk_bf16(pv[8 * sx + 2], pv[8 * sx + 3]); pw.z = cvt_pk_bf16(pv[8 * sx + 4], pv[8 * sx + 5]); pw.w = cvt_pk_bf16(pv[8 * sx + 6], pv[8 * sx + 7]); \
            const bf16x8 pb = __builtin_bit_cast(bf16x8, pw); \
            _Pragma("unroll") for (int dt = 0; dt < 2; ++dt) o[ti][dt] = __builtin_amdgcn_mfma_f32_32x32x16_bf16(vf[dt * 2 + sx], pb, o[ti][dt], 0, 0, 0); } } } while (0)
    LOADT(kfA, vfA, mwA, 0);
    for (int kt = 0; kt < ntile; kt += 2) {
        LOADT(kfB, vfB, mwB, kt + 1);
        COMPT(kfA, vfA, mwA);
        if (kt + 2 < ntile) LOADT(kfA, vfA, mwA, kt + 2);
        COMPT(kfB, vfB, mwB);
    }
#undef LOADT
#undef COMPT
    int lane2 = lane; asm volatile("" : "+v"(lane2));
    const int cl2 = lane2 & 31, hi2 = lane2 >> 5;
#pragma unroll
    for (int ti = 0; ti < 2; ++ti) {
        const float lt = lsum[ti] + __shfl_xor(lsum[ti], 32); const float inv = 1.0f / lt;
        bf16_t* dst = Attn + (tokc + 8 * ti + (cl2 >> 2)) * 1024 + (4 * kvh + (cl2 & 3)) * 64 + 4 * hi2;
#pragma unroll
        for (int dt = 0; dt < 2; ++dt)
#pragma unroll
            for (int g4 = 0; g4 < 4; ++g4) { u32x2 w; w.x = cvt_pk_bf16(o[ti][dt][4 * g4] * inv, o[ti][dt][4 * g4 + 1] * inv); w.y = cvt_pk_bf16(o[ti][dt][4 * g4 + 2] * inv, o[ti][dt][4 * g4 + 3] * inv);
                *(u32x2*)(dst + 32 * dt + 8 * g4) = w; }
    }
}

__device__ __forceinline__ void attn_phase(const Params& p, LAS unsigned char* lds, int bid, int G) {
    const int lane = threadIdx.x & 63;
    float mq = fabsf(p.q_norm_g[lane]), mk = fabsf(p.k_norm_g[lane]);
#pragma unroll
    for (int o = 1; o < 64; o <<= 1) { mq = fmaxf(mq, __shfl_xor(mq, o)); mk = fmaxf(mk, __shfl_xor(mk, o)); }
    const float negC = -(8.0f * mq * mk * 1.4426950408889634f * 1.03f);
    for (int u = bid; u < NBATCH * 32; u += G) {
        const int b = u & 7, y = u >> 3;
        for (int half = 0; half < 2; ++half) {
            const int c = half ? 63 - y : y;
            for (int sx = 0; sx < 8; ++sx) select_unit(p, lds, b, 64 * c + 8 * sx);
            asm volatile("s_waitcnt vmcnt(0)" ::: "memory"); __syncthreads();
            dense_attn_chunk(p, b, c, negC);
        }
    }
}

constexpr int T_TSTART = 0, T_PADSTART = 40, T_BLOCKBASE = 80, T_NE = 112, T_WB = 144  , T_PART = 400  ;
__device__ __forceinline__ void router_phase(const Params& p, LAS unsigned char* lds, int bid, int G) {
    const int tid = threadIdx.x, lane = tid & 63, wave = __builtin_amdgcn_readfirstlane(tid >> 6);
    constexpr int WP = 1028;
    LAS float* WrT = (LAS float*)lds;
    for (int i = tid; i < 1024 * 32 / 4; i += NTHREADS) { const f32x4 v = *(const f32x4*)(p.router_w + 4 * (size_t)i); const int c = i >> 3, e0 = 4 * (i & 7); const float g = p.norm2_g[c];
        WrT[(e0 + 0) * WP + c] = v[0] * g; WrT[(e0 + 1) * WP + c] = v[1] * g; WrT[(e0 + 2) * WP + c] = v[2] * g; WrT[(e0 + 3) * WP + c] = v[3] * g; }
    __syncthreads();
    LAS int* tbl = (LAS int*)(lds + MISC_OFF);
    const float* X1 = p.out; unsigned char* H2 = p.ws + WS_H2;
    int* rec_e = (int*)(p.ws + WS_REC_E); int* rec_pos = (int*)(p.ws + WS_REC_POS); float* rec_gate = (float*)(p.ws + WS_REC_GATE);
    const int ex = lane & 15, kq = lane >> 4;
    const size_t tokw = (size_t)bid * 128 + wave * 16;
    f32x4 acc0 = (f32x4){0.f, 0.f, 0.f, 0.f}, acc1 = acc0; float ssq = 0.f;
    {
        const float* xr = X1 + (tokw + ex) * D + 4 * kq;
        const LAS float* w0 = WrT + ex * WP + 4 * kq; const LAS float* w1 = w0 + 16 * WP;
#pragma unroll 4
        for (int q = 0; q < 64; ++q) {
            const f32x4 a = *(const f32x4*)(xr + 16 * q); const f32x4 b0 = *(const LAS f32x4*)(w0 + 16 * q), b1 = *(const LAS f32x4*)(w1 + 16 * q);
            ssq += (a.x * a.x + a.y * a.y) + (a.z * a.z + a.w * a.w);
#pragma unroll
            for (int k = 0; k < 4; ++k) { acc0 = __builtin_amdgcn_mfma_f32_16x16x4f32(a[k], b0[k], acc0, 0, 0, 0); acc1 = __builtin_amdgcn_mfma_f32_16x16x4f32(a[k], b1[k], acc1, 0, 0, 0); }
        }
    }
    ssq += __shfl_xor(ssq, 16); ssq += __shfl_xor(ssq, 32);
    const float rs = 1.0f / sqrtf(ssq * (1.0f / D) + NORM_EPS);
    const float br0 = p.router_b[ex], br1 = p.router_b[ex + 16];
    float lg0[4], lg1[4];
#pragma unroll
    for (int i = 0; i < 4; ++i) { const float r = __shfl(rs, 4 * kq + i); lg0[i] = acc0[i] * r + br0; lg1[i] = acc1[i] * r + br1; }
    int ti[4][4]; float tv[4][4];
#pragma unroll
    for (int r = 0; r < 4; ++r)
#pragma unroll
        for (int i = 0; i < 4; ++i) {
            float bv = (lg0[i] >= lg1[i]) ? lg0[i] : lg1[i]; int bi = (lg0[i] >= lg1[i]) ? ex : ex + 16;
#pragma unroll
            for (int m = 1; m < 16; m <<= 1) { const float ov = __shfl_xor(bv, m); const int oi = __shfl_xor(bi, m); const bool better = (ov > bv) || (ov == bv && oi < bi); bv = better ? ov : bv; bi = better ? oi : bi; }
            tv[i][r] = bv; ti[i][r] = bi;
            if (bi == ex) lg0[i] = -INFINITY; if (bi == ex + 16) lg1[i] = -INFINITY;
        }
    unsigned M[4];
#pragma unroll
    for (int i = 0; i < 4; ++i) M[i] = (1u << ti[i][0]) | (1u << ti[i][1]) | (1u << ti[i][2]) | (1u << ti[i][3]);
    unsigned Mall[16];
#pragma unroll
    for (int t = 0; t < 16; ++t) Mall[t] = (unsigned)__builtin_amdgcn_readlane((int)M[t & 3], 16 * (t >> 2));
#pragma unroll
    for (int i = 0; i < 4; ++i) {
        const int t = 4 * kq + i;
        const float e1 = __expf(tv[i][1] - tv[i][0]), e2 = __expf(tv[i][2] - tv[i][0]), e3 = __expf(tv[i][3] - tv[i][0]); const float inv = 1.0f / (1.0f + e1 + e2 + e3);
#pragma unroll
        for (int r = 0; r < 4; ++r) {
            const int x = ti[i][r]; int pos = 0;
#pragma unroll
            for (int tp = 0; tp < 16; ++tp) pos += (tp < t) ? (int)((Mall[tp] >> x) & 1u) : 0;
            const float gt = (r == 0 ? 1.0f : (r == 1 ? e1 : (r == 2 ? e2 : e3))) * inv;
            if (ex == r) { rec_e[(tokw + t) * 4 + r] = x; rec_pos[(tokw + t) * 4 + r] = pos; rec_gate[(tokw + t) * 4 + r] = gt; }
        }
    }
    { int cnt = 0;
#pragma unroll
        for (int t = 0; t < 16; ++t) cnt += (int)((Mall[t] >> (lane & 31)) & 1u);
        if (lane < 32) tbl[T_WB + wave * 32 + lane] = cnt; }
    {
        f32x4 g2[4];
#pragma unroll
        for (int j = 0; j < 4; ++j) g2[j] = *(const f32x4*)(p.norm2_g + 4 * lane + 256 * j);
#pragma unroll 4
        for (int t = 0; t < 16; ++t) {
            const float r = __shfl(rs, t);
            const f32x4* xr = (const f32x4*)(X1 + (tokw + t) * D) + lane;
#pragma unroll
            for (int j = 0; j < 4; ++j) { const f32x4 h = xr[64 * j] * r * g2[j]; *(unsigned*)(H2 + (tokw + t) * D + 4 * lane + 256 * j) = pk4_fp8(h.x, h.y, h.z, h.w); }
        }
    }
    __syncthreads();
    if (tid < 256) ((int*)(p.ws + WS_WCNT))[(size_t)bid * 256 + tid] = tbl[T_WB + tid];
    if (tid < 32) { int sm = 0;
#pragma unroll
        for (int w = 0; w < 8; ++w) sm += tbl[T_WB + w * 32 + tid];
        ((int*)(p.ws + WS_BCNT))[bid * 32 + tid] = sm; }
    __syncthreads();
}

__device__ __forceinline__ void moe_tables(const Params& p, LAS int* tbl, int bid) {
    const int tid = threadIdx.x; const int* bcnt = (const int*)(p.ws + WS_BCNT);
    { const int e = tid & 31, part = tid >> 5; int all = 0, below = 0;
        for (int k = 0; k < 16; ++k) { const int blk = part * 16 + k; const int v = bcnt[blk * 32 + e]; all += v; below += (blk < bid) ? v : 0; }
        tbl[T_PART + part * 32 + e] = all; tbl[T_PART + 512 + part * 32 + e] = below; }
    __syncthreads();
    if (tid < 32) { int all = 0, below = 0;
        for (int q = 0; q < 16; ++q) { all += tbl[T_PART + q * 32 + tid]; below += tbl[T_PART + 512 + q * 32 + tid]; }
        tbl[T_NE + tid] = all; tbl[T_BLOCKBASE + tid] = below; }
    __syncthreads();
    if (tid == 0) { int ps = 0, ts = 0;
        for (int e = 0; e < NEXP; ++e) { tbl[T_PADSTART + e] = ps; tbl[T_TSTART + e] = ts; const int nt = (tbl[T_NE + e] + 255) >> 8; ps += nt * 256; ts += nt; }
        tbl[T_PADSTART + NEXP] = ps; tbl[T_TSTART + NEXP] = ts; }
    __syncthreads();
    for (int ti = tid; ti < tbl[T_TSTART + NEXP]; ti += NTHREADS) { int e = 0;
#pragma unroll
        for (int k = 1; k < NEXP; ++k) e += (tbl[T_TSTART + k] <= ti) ? 1 : 0;
        tbl[T_TSTART + pg8::T_TILE_E_REL + ti] = e; }
    __syncthreads();
}

__device__ __forceinline__ void permute_phase(const Params& p, LAS unsigned char* lds, int bid, int G) {
    const int tid = threadIdx.x, lane = tid & 63, wave = __builtin_amdgcn_readfirstlane(tid >> 6);
    LAS int* tbl = (LAS int*)(lds + MISC_OFF);
    moe_tables(p, tbl, bid);
    if (tid < 256) { const int w = tid >> 5, e = tid & 31; int s = 0; const int* wc = (const int*)(p.ws + WS_WCNT) + (size_t)bid * 256;
        for (int q = 0; q < 8; ++q) s += (q < w) ? wc[q * 32 + e] : 0;
        tbl[T_WB + tid] = s; }
    __syncthreads();
    const int* rec_e = (const int*)(p.ws + WS_REC_E); const int* rec_pos = (const int*)(p.ws + WS_REC_POS); const float* rec_gate = (const float*)(p.ws + WS_REC_GATE);
    int* slot_of = (int*)(p.ws + WS_SLOT_OF); float* slot_gate = (float*)(p.ws + WS_SLOT_GATE);
    const unsigned char* H2 = p.ws + WS_H2; unsigned char* H2S = p.ws + WS_H2S;
    for (int bt = 0; bt < 4; ++bt) {
        const int idx = wave * 64 + bt * 16 + (lane & 15); const int tl = idx >> 2; const size_t tk = (size_t)bid * 128 + tl;
        const int e = rec_e[tk * 4 + (idx & 3)], pw = rec_pos[tk * 4 + (idx & 3)];
        const int slot = tbl[T_PADSTART + e] + tbl[T_BLOCKBASE + e] + tbl[T_WB + (tl >> 4) * 32 + e] + pw;
        if (lane < 16) { slot_of[tk * 4 + (idx & 3)] = slot; slot_gate[slot] = rec_gate[tk * 4 + (idx & 3)]; }
        u32x4 v0[16];
#pragma unroll
        for (int i = 0; i < 16; ++i) { const size_t tki = (size_t)bid * 128 + ((wave * 64 + bt * 16 + i) >> 2); v0[i] = *(const u32x4*)(H2 + tki * D + 16 * lane); }
#pragma unroll
        for (int i = 0; i < 16; ++i) { const int sl = __shfl(slot, i); *(u32x4*)(H2S + (size_t)sl * D + 16 * lane) = v0[i]; }
    }
}

__device__ __forceinline__ void combine_phase(const Params& p, int bid, int G) {
    const int tid = threadIdx.x, lane = tid & 63, wave = __builtin_amdgcn_readfirstlane(tid >> 6);
    const int gw = bid * NWAVES + wave, NGW = G * NWAVES;
    const int* slot_of = (const int*)(p.ws + WS_SLOT_OF); const bf16_t* Y = (const bf16_t*)(p.ws + WS_Y);
    for (int tk = gw; tk < NTOK; tk += NGW) {
        int sl[4];
#pragma unroll
        for (int r = 0; r < 4; ++r) sl[r] = slot_of[(size_t)tk * 4 + r];
        float* orow = p.out + (size_t)tk * D;
#pragma unroll
        for (int j = 0; j < 4; ++j) { f32x4 a = *(const f32x4*)(orow + 4 * lane + 256 * j);
#pragma unroll
            for (int r = 0; r < 4; ++r) { const u32x2 y = *(const u32x2*)(Y + (size_t)sl[r] * D + 4 * lane + 256 * j); a.x += bf_lo(y.x); a.y += bf_hi(y.x); a.z += bf_lo(y.y); a.w += bf_hi(y.y); }
            *(f32x4*)(orow + 4 * lane + 256 * j) = a; }
    }
}

constexpr int NPH = 11;
__global__ void __launch_bounds__(NTHREADS, 2) mega(Params p) {
    extern __shared__ __attribute__((aligned(16))) unsigned char lds_raw[];
    LAS unsigned char* lds = (LAS unsigned char*)lds_raw;
    cg::grid_group grid = cg::this_grid();
    const int bid = blockIdx.x, G = gridDim.x;
    unsigned char* ws = p.ws;
#ifndef PH_MASK
#define PH_MASK 0x7ff
#endif
#define IN(k) (((PH_MASK >> (k)) & 1) && p.ph_lo <= (k) && (k) < p.ph_hi)
#ifndef PH_DUP
#define PH_DUP 0
#endif
#define DUP(k) (((PH_DUP >> (k)) & 1) ? 2 : 1)
#define SEAM(k) do { if (IN(k) && IN((k) + 1)) grid.sync(); } while (0)
    if (IN(0)) { phase0(p, lds, bid, G); }
    SEAM(0);
    if (IN(1)) {
        pg8::Gemm g{(const bf16_t*)(ws + WS_XN), (const bf16_t*)(ws + WS_WIN), NTOK, INWP, D}; pg8::StaticOrder S; S.init(NTOK, INWP, G, bid);
        EpiInProj E{(bf16_t*)(ws + WS_Q), (bf16_t*)(ws + WS_K), (bf16_t*)(ws + WS_VT), (bf16_t*)(ws + WS_QI), (bf16_t*)(ws + WS_KI), (bf16_t*)(ws + WS_POOL), (bf16_t*)(ws + WS_GA), (bf16_t*)(ws + WS_GP),
                    (float*)(ws + WS_WI), (const float*)(ws + WS_CS), p.q_norm_g, p.k_norm_g, p.idx_g, p.idx_b};
        pg8::gemm_phase(lds, g, S, E);
    }
    SEAM(1);
    if (IN(2)) { pool_phase(p, bid, G); attn_phase(p, lds, bid, G); }
    SEAM(2);
    if (IN(3)) {
        pg8::Gemm g{(const bf16_t*)(ws + WS_ACAT), (const bf16_t*)(ws + WS_WCAT), NTOK, D, D}; pg8::StaticOrder S; S.init(NTOK, D, G, bid);
        EpiGated E{(const bf16_t*)(ws + WS_GA), (const bf16_t*)(ws + WS_GP), (bf16_t*)(ws + WS_MERGED)};
        pg8::gemm_phase(lds, g, S, E);
    }
    SEAM(4);
    if (IN(5)) {
        pg8::Gemm g{(const bf16_t*)(ws + WS_MERGED), (const bf16_t*)(ws + WS_WOUT), NTOK, D, D}; pg8::StaticOrder S; S.init(NTOK, D, G, bid);
        EpiResid E{p.x, p.out};
        pg8::gemm_phase(lds, g, S, E);
    }
    SEAM(5);
    if (IN(6)) { router_phase(p, lds, bid, G); }
    SEAM(6);
    if (IN(7)) { permute_phase(p, lds, bid, G); }
    SEAM(7);
    if (IN(8)) {
        LAS int* tbl = (LAS int*)(lds + MISC_OFF); moe_tables(p, tbl, bid);
        pg8::Gemm g{(const bf16_t*)(ws + WS_H2S), (const bf16_t*)(ws + WS_WGU), NSLOT, NEXP * 2048, D}; pg8::MoeOrder<8> S{tbl + T_TSTART, G, bid};
        EpiGateUp E{p.b_gu, ws + WS_ACT};
        pg8::gemm_phase<EpiGateUp, pg8::MoeOrder<8>, true>(lds, g, S, E);
    }
    SEAM(8);
    if (IN(9)) {
        LAS int* tbl = (LAS int*)(lds + MISC_OFF); moe_tables(p, tbl, bid);
        pg8::Gemm g{(const bf16_t*)(ws + WS_ACT), (const bf16_t*)(ws + WS_WD), NSLOT, NEXP * 1024, D}; pg8::MoeOrder<4> S{tbl + T_TSTART, G, bid};
        EpiDown E{p.b_d, (const float*)(ws + WS_SLOT_GATE), (bf16_t*)(ws + WS_Y)};
        pg8::gemm_phase<EpiDown, pg8::MoeOrder<4>, true>(lds, g, S, E);
    }
    SEAM(9);
    if (IN(10)) combine_phase(p, bid, G);
#undef IN
#undef SEAM
}

extern "C" void kernel_launch(void* const* d_in, const int* in_sizes, int n_in, void* d_out, int out_size, void* d_ws, size_t ws_size, hipStream_t stream) {
    static int grid = 0;
    if (grid == 0) {
        if (n_in != 20 || out_size != NTOK * D || ws_size < WS_END) { fprintf(stderr, "kernel_launch: unexpected shapes: n_in %d out %d ws %zu (need %zu)\n", n_in, out_size, ws_size, (size_t)WS_END); grid = -1; return; }
        int dev = 0, cus = 0, per_cu = 0;
        hipGetDevice(&dev); hipDeviceGetAttribute(&cus, hipDeviceAttributeMultiprocessorCount, dev);
        if (hipFuncSetAttribute((const void*)mega, hipFuncAttributeMaxDynamicSharedMemorySize, LDS_BYTES) != hipSuccess) { fprintf(stderr, "kernel_launch: hipFuncSetAttribute failed\n"); grid = -1; return; }
        if (hipOccupancyMaxActiveBlocksPerMultiprocessor(&per_cu, (const void*)mega, NTHREADS, LDS_BYTES) != hipSuccess || per_cu < 1) { fprintf(stderr, "kernel_launch: occupancy query says %d blocks per CU\n", per_cu); per_cu = 1; }
        (void)hipGetLastError();
        grid = cus;
        if (grid != 256) fprintf(stderr, "kernel_launch: %d CUs; the router / permute phases assume a 256-workgroup grid\n", grid);
    }
    if (grid < 0) return;
    Params p{};
    p.x = (const float*)d_in[0]; p.pos = (const int*)d_in[1]; p.norm1_g = (const float*)d_in[2]; p.w_in = (const float*)d_in[3]; p.q_norm_g = (const float*)d_in[4];
    p.k_norm_g = (const float*)d_in[5]; p.idx_g = (const float*)d_in[6]; p.idx_b = (const float*)d_in[7]; p.w_a = (const float*)d_in[8]; p.pool_mix = (const float*)d_in[9];
    p.pool_scale = (const float*)d_in[10]; p.w_b = (const float*)d_in[11]; p.w_out = (const float*)d_in[12]; p.norm2_g = (const float*)d_in[13]; p.router_w = (const float*)d_in[14];
    p.router_b = (const float*)d_in[15]; p.w_gu = (const float*)d_in[16]; p.b_gu = (const float*)d_in[17]; p.w_d = (const float*)d_in[18]; p.b_d = (const float*)d_in[19];
    p.out = (float*)d_out; p.ws = (unsigned char*)d_ws;
#if MK_MODE == 0
    p.ph_lo = 0; p.ph_hi = NPH;
    void* args[] = {&p};
    hipError_t e = hipLaunchCooperativeKernel((const void*)mega, dim3(grid), dim3(NTHREADS), args, LDS_BYTES, stream);
    if (e != hipSuccess) fprintf(stderr, "kernel_launch: cooperative launch failed: %s (grid %d)\n", hipGetErrorString(e), grid);
#else
    for (int k = 0; k < NPH; ++k) { p.ph_lo = k; p.ph_hi = k + 1; hipLaunchKernelGGL(mega, dim3(grid), dim3(NTHREADS), LDS_BYTES, stream, p); }
#endif
}
```

```cpp
#include <hip/hip_runtime.h>
#include <hip/hip_cooperative_groups.h>
#include <cstdio>
#include <cstdint>
#include <cmath>
namespace cg = cooperative_groups;

#ifndef MK_MODE
#define MK_MODE 0
#endif

#define LAS __attribute__((address_space(3)))
typedef unsigned short bf16_t;
typedef short bf16x8 __attribute__((ext_vector_type(8)));
typedef float f32x2 __attribute__((ext_vector_type(2)));
typedef float f32x4 __attribute__((ext_vector_type(4)));
typedef float f32x16 __attribute__((ext_vector_type(16)));
typedef unsigned u32x2 __attribute__((ext_vector_type(2)));
typedef unsigned u32x4 __attribute__((ext_vector_type(4)));

constexpr int D = 1024, NBATCH = 8, SEQ = 4096, NTOK = NBATCH * SEQ;
constexpr int NEXP = 32, TOPK = 4;
constexpr int INW = 3652, INWP = 3840;
constexpr int NSLOT = 139264;
constexpr float NORM_EPS = 1e-6f;
constexpr float MOE_WSCALE = 64.0f, MOE_WINV = 1.0f / 64.0f;
constexpr float Y_SCALE = 16.0f;
constexpr int NWAVES = 8, NTHREADS = 512;
constexpr int LDS_BYTES = 147456;
constexpr int RING_BYTES = 131072;
constexpr int MISC_OFF = 135168;

constexpr size_t MiB = 1u << 20;
constexpr size_t WS_CTL = 0;
constexpr size_t WS_BCNT = 64 * 1024;
constexpr size_t WS_WCNT = 128 * 1024;
constexpr size_t WS_CS = 2 * MiB;
constexpr size_t WS_WIN = 16 * MiB;
constexpr size_t WS_WCAT = 24 * MiB;
constexpr size_t WS_WOUT = 26 * MiB;
constexpr size_t WS_WGU = 28 * MiB;
constexpr size_t WS_WD = 156 * MiB;
constexpr size_t WS_REC_E = 220 * MiB;
constexpr size_t WS_REC_POS = 221 * MiB;
constexpr size_t WS_REC_GATE = 222 * MiB;
constexpr size_t WS_SLOT_OF = 223 * MiB;
constexpr size_t WS_SLOT_GATE = 223 * MiB + 512 * 1024;
constexpr size_t WS_XN = 226 * MiB;
constexpr size_t WS_Q = 290 * MiB;
constexpr size_t WS_K = 322 * MiB;
constexpr size_t WS_VT = 330 * MiB;
constexpr size_t WS_QI = 338 * MiB;
constexpr size_t WS_KI = 354 * MiB;
constexpr size_t WS_WI = 358 * MiB;
constexpr size_t WS_POOL = 360 * MiB;
constexpr size_t WS_GA = 392 * MiB;
constexpr size_t WS_GP = 456 * MiB;
constexpr size_t WS_ACAT = 520 * MiB;
constexpr size_t WS_TA = 584 * MiB;
constexpr size_t WS_MASK = WS_TA;
constexpr size_t WS_MERGED = 648 * MiB;
constexpr size_t WS_H2 = WS_XN;
constexpr size_t WS_H2S = 290 * MiB;
constexpr size_t WS_Y = WS_H2S;
constexpr size_t WS_ACT = 562 * MiB;
constexpr size_t WS_END = 834 * MiB;
static_assert(WS_SLOT_GATE + (size_t)NSLOT * 4 <= WS_XN, "ws map");

__device__ __forceinline__ unsigned cvt_pk_bf16(float lo, float hi) { unsigned r; asm volatile("v_cvt_pk_bf16_f32 %0, %1, %2" : "=v"(r) : "v"(lo), "v"(hi)); return r; }
__device__ __forceinline__ unsigned pk4_fp8(float a, float b, float c, float d) { int w = __builtin_amdgcn_cvt_pk_fp8_f32(a, b, 0, false); w = __builtin_amdgcn_cvt_pk_fp8_f32(c, d, w, true); return (unsigned)w; }
__device__ __forceinline__ float bf_lo(unsigned w) { return __uint_as_float(w << 16); }
__device__ __forceinline__ float bf_hi(unsigned w) { return __uint_as_float(w & 0xffff0000u); }
__device__ __forceinline__ float wave_sum(float v) {
#pragma unroll
    for (int o = 1; o < 64; o <<= 1) v += __shfl_xor(v, o);
    return v;
}
__device__ __forceinline__ float sigmoidf_(float x) { return __builtin_amdgcn_rcpf(1.0f + __builtin_amdgcn_exp2f(-1.4426950408889634f * x)); }
#define LDS_WAIT() asm volatile("s_waitcnt lgkmcnt(0)" ::: "memory")

__host__ __device__ __forceinline__ int idx_bj_j(int d, int& bj) {
    int j;
    if (d < 16) { bj = 0; j = d; } else if (d < 32) { bj = 1; j = d - 16; } else if (d < 48) { bj = 0; j = d - 16; } else { bj = 1; j = d - 32; }
    return j;
}
__host__ __device__ __forceinline__ int win_phys(int n) {
    if (n < 512) { const int h = n >> 6, d = n & 63; return 256 * (h >> 2) + 128 * (d >> 5) + 32 * (h & 3) + (d & 31); }
    if (n < 768) { const int h = (n - 512) >> 6, d = n & 63; return 512 + 128 * (d >> 5) + 32 * h + (d & 31); }
    if (n < 1024) { const int h = (n - 768) >> 6, d = n & 63; int bj; const int j = idx_bj_j(d, bj); return 768 + 128 * bj + 32 * h + j; }
    if (n < 1088) { const int d = n - 1024; int bj; const int j = idx_bj_j(d, bj); return 1024 + 128 * bj + j; }
    if (n < 1092) return 1024 + 32 + (n - 1088);
    if (n < 1604) return 1280 + (n - 1092);
    if (n < 2628) return 1792 + (n - 1604);
    return 2816 + (n - 2628);
}

namespace pg8 {
constexpr int BM = 256, BK = 64, HALF = 128, HTB = HALF * BK * 2, STAGE_BYTES = 8 * HTB, NXCD = 8, WGM = 8;
__host__ __device__ __forceinline__ int lds_byte(int r, int c) { const int st = (r >> 4) * 2 + (c >> 5), rr = r & 15, cc = c & 31, ob = rr * 64 + cc * 2; return st * 1024 + (ob ^ (((ob >> 9) & 1) << 5)); }
__host__ __device__ __forceinline__ void stage_rc(int b, int& R, int& C) { const int st = b / 1024, sb = b % 1024, swz = sb ^ (((sb >> 9) & 1) << 5); R = (st >> 1) * 16 + swz / 64; C = (st & 1) * 32 + (swz % 64) / 2; }
__host__ __device__ __forceinline__ int perm32(int rho) { const int n = rho >> 4, i = rho & 15; return 8 * (i >> 2) + 4 * n + (i & 3); }

struct Unit { int pm, pn; };
struct Gemm { const bf16_t* A; const bf16_t* Bt; int M, N, K; };

struct StaticOrder {
    int nM, nN, nwg, G, c;
    __device__ void init(int M, int N, int G_, int c_) { nM = M / BM; nN = N / BM; nwg = nM * nN; G = G_; c = c_; }
    __device__ bool next(int i, Unit& u) const {
        const long L = (long)i * G + c; if (L >= nwg) return false;
        int wgid = (int)L; { const int q = nwg / NXCD, r = nwg % NXCD, xcd = wgid % NXCD, off = wgid / NXCD; wgid = (xcd < r ? xcd * (q + 1) : r * (q + 1) + (xcd - r) * q) + off; }
        const int nig = WGM * nN, gid = wgid / nig, fm = gid * WGM, gsz = (nM - fm) < WGM ? (nM - fm) : WGM;
        u.pm = fm + ((wgid % nig) % gsz); u.pn = (wgid % nig) / gsz; return true;
    }
};
template <int NPN> struct MoeOrder {
    const LAS int* tstart; int G, c;
    __device__ bool next(int i, Unit& u) const {
        const int x = c & 7, lc = c >> 3, ng = G >> 3;
        int U = i * ng + lc;
#pragma unroll
        for (int k = 0; k < NEXP / 8; ++k) {
            const int e = x + 8 * k; const int t0 = __builtin_amdgcn_readfirstlane(tstart[e]), t1 = __builtin_amdgcn_readfirstlane(tstart[e + 1]);
            const int nu = (t1 - t0) * NPN;
            if (U < nu) { u.pm = t0 + U / NPN; u.pn = e * NPN + U % NPN; return true; }
            U -= nu;
        }
        return false;
    }
};

typedef int i32x8 __attribute__((ext_vector_type(8)));
__device__ __forceinline__ i32x8 pk32(bf16x8 a, bf16x8 b) { typedef int i32x4 __attribute__((ext_vector_type(4))); const i32x4 x = __builtin_bit_cast(i32x4, a), y = __builtin_bit_cast(i32x4, b); return __builtin_shufflevector(x, y, 0, 1, 2, 3, 4, 5, 6, 7); }
__device__ __forceinline__ void mfma_f8_inplace(f32x4& acc, i32x8 a, i32x8 b, int one) {
    asm volatile("v_mfma_scale_f32_16x16x128_f8f6f4 %0, %1, %2, %0, %3, %3 op_sel_hi:[0,0,0]" : "+v"(acc) : "v"(a), "v"(b), "v"(one));
}
template <class Epi, class Sched, bool F8 = false>
__device__ __forceinline__ void gemm_phase(LAS unsigned char* lds, const Gemm g, const Sched& S, const Epi& E) {
    const int tid = threadIdx.x, wid = __builtin_amdgcn_readfirstlane(tid >> 6), lane = tid & 63, wr = wid >> 2, wc = wid & 3, fr = lane & 15, fq = lane >> 4;
    constexpr int ES = F8 ? 1 : 2;
    const int K = g.K, RB = K * ES, nt = RB / 128;
    unsigned voffA[2], voffB[2];
    { int R, C; stage_rc(tid * 16, R, C); const int Rb = (R & ~31) + perm32(R & 31);
        voffA[0] = (unsigned)(R * RB + C * 2); voffB[0] = (unsigned)(Rb * RB + C * 2); voffA[1] = 64u * (unsigned)RB; voffB[1] = 64u * (unsigned)RB; }
    const size_t kstep = (size_t)(BK * 2);
    const size_t hstep = (size_t)HALF * RB;
    const size_t tstep = 2 * hstep;
    const unsigned ldsw = (unsigned)wid * 1024u;
    const int aoff = lds_byte(wr * 64 + fr, F8 ? fq * 16 : fq * 8), boff = lds_byte(wc * 32 + fr, F8 ? fq * 16 : fq * 8);
    constexpr int PSTEP = F8 ? 16 : 1024;
#define PG8_SA(b, h) (((b) * 2 + (h)) * HTB)
#define PG8_SB(b, h) ((4 + (b) * 2 + (h)) * HTB)
#define PG8_STAGE(bufoff, gbase, voff) do { _Pragma("unroll") for (int _i = 0; _i < 2; ++_i) \
        __builtin_amdgcn_global_load_lds((const unsigned*)((const char*)(gbase) + (size_t)(_i ? (voff)[1] : 0u) + (voff)[0]), (LAS unsigned*)(lds + (bufoff) + ldsw + _i * 8192), 16, 0, 0); } while (0)
#define PG8_LDA(dst, b, h) do { _Pragma("unroll") for (int m = 0; m < 4; ++m) _Pragma("unroll") for (int k = 0; k < 2; ++k) dst[m][k] = *(const LAS bf16x8*)(lds + PG8_SA(b, h) + aoff + m * 2048 + k * PSTEP); } while (0)
#define PG8_LDB(dst, b, h) do { _Pragma("unroll") for (int n = 0; n < 2; ++n) _Pragma("unroll") for (int k = 0; k < 2; ++k) dst[n][k] = *(const LAS bf16x8*)(lds + PG8_SB(b, h) + boff + n * 2048 + k * PSTEP); } while (0)
#define PG8_MMA(ai, bj, At, Bt) do { __builtin_amdgcn_s_setprio(1); \
        if constexpr (F8) { _Pragma("unroll") for (int m = 0; m < 4; ++m) _Pragma("unroll") for (int n = 0; n < 2; ++n) \
            mfma_f8_inplace(acc[ai][bj][m][n], pk32(Bt[n][0], Bt[n][1]), pk32(At[m][0], At[m][1]), one_scale); \
            asm volatile("s_nop 15\n\ts_nop 15" ::: ); } \
        else { _Pragma("unroll") for (int m = 0; m < 4; ++m) _Pragma("unroll") for (int n = 0; n < 2; ++n) _Pragma("unroll") for (int k = 0; k < 2; ++k) \
            acc[ai][bj][m][n] = __builtin_amdgcn_mfma_f32_16x16x32_bf16(Bt[n][k], At[m][k], acc[ai][bj][m][n], 0, 0, 0); } \
        __builtin_amdgcn_s_setprio(0); } while (0)
#define PG8_WAIT_V(n) asm volatile("s_waitcnt vmcnt(" #n ")" ::: "memory")
#define PG8_WAIT_L(n) asm volatile("s_waitcnt lgkmcnt(" #n ")" ::: "memory")
#define PG8_BAR __builtin_amdgcn_s_barrier()
#define PG8_SCHED __builtin_amdgcn_sched_barrier(0)
    int one_scale = 0x7F7F7F7F; asm volatile("" : "+v"(one_scale));
    Unit cur, nxt; int ui = 0;
    if (!S.next(0, cur)) return;
    cur.pm = __builtin_amdgcn_readfirstlane(cur.pm); cur.pn = __builtin_amdgcn_readfirstlane(cur.pn);
    f32x4 acc[2][2][4][2];
#pragma unroll
    for (int a = 0; a < 2; ++a)
#pragma unroll
        for (int b = 0; b < 2; ++b)
#pragma unroll
            for (int m = 0; m < 4; ++m)
#pragma unroll
                for (int n = 0; n < 2; ++n) acc[a][b][m][n] = (f32x4){0.f, 0.f, 0.f, 0.f};
    bf16x8 At[4][2], B0[2][2], B1[2][2];
    const char* cA = (const char*)g.A + (size_t)cur.pm * tstep; const char* cB = (const char*)g.Bt + (size_t)cur.pn * tstep;
    PG8_STAGE(PG8_SB(0, 0), cB, voffB); PG8_STAGE(PG8_SB(0, 1), cB + hstep, voffB); PG8_STAGE(PG8_SA(0, 0), cA, voffA); PG8_STAGE(PG8_SA(0, 1), cA + hstep, voffA);
    if (wr == 1) PG8_BAR;
    PG8_WAIT_V(2); PG8_BAR;
    PG8_STAGE(PG8_SB(1, 0), cB + kstep, voffB); PG8_STAGE(PG8_SA(1, 0), cA + kstep, voffA); PG8_STAGE(PG8_SB(1, 1), cB + hstep + kstep, voffB);
    PG8_WAIT_V(6); PG8_BAR;
    for (;;) {
        const bool has_next = S.next(ui + 1, nxt); nxt.pm = __builtin_amdgcn_readfirstlane(nxt.pm); nxt.pn = __builtin_amdgcn_readfirstlane(nxt.pn);
        const char* nA = has_next ? (const char*)g.A + (size_t)nxt.pm * tstep : cA; const char* nB = has_next ? (const char*)g.Bt + (size_t)nxt.pn * tstep : cB;
#pragma unroll 1
        for (int t = 0; t < nt; t += 2) {
            const bool last = (t == nt - 2);
            const char* a1 = cA + (size_t)(t + 1) * kstep;
            const char* a2 = last ? nA : cA + (size_t)(t + 2) * kstep; const char* b2 = last ? nB : cB + (size_t)(t + 2) * kstep;
            const char* a3 = a2 + kstep; const char* b3 = b2 + kstep;
            PG8_LDB(B0, 0, 0); PG8_LDB(B1, 0, 1); PG8_SCHED; PG8_LDA(At, 0, 0); PG8_STAGE(PG8_SA(1, 1), a1 + hstep, voffA);
            PG8_WAIT_V(8); PG8_WAIT_L(0); PG8_BAR; PG8_MMA(0, 0, At, B0); PG8_MMA(0, 1, At, B1); PG8_BAR; PG8_SCHED;
            PG8_LDA(At, 0, 1); PG8_STAGE(PG8_SB(0, 0), b2, voffB); PG8_STAGE(PG8_SB(0, 1), b2 + hstep, voffB); PG8_STAGE(PG8_SA(0, 0), a2, voffA);
            PG8_WAIT_V(8); PG8_WAIT_L(0); PG8_BAR; PG8_MMA(1, 0, At, B0); PG8_MMA(1, 1, At, B1); PG8_BAR; PG8_SCHED;
            PG8_LDB(B0, 1, 0); PG8_LDB(B1, 1, 1); PG8_SCHED; PG8_LDA(At, 1, 0); PG8_STAGE(PG8_SA(0, 1), a2 + hstep, voffA);
            PG8_WAIT_V(8); PG8_WAIT_L(0); PG8_BAR; PG8_MMA(0, 0, At, B0); PG8_MMA(0, 1, At, B1); PG8_BAR; PG8_SCHED;
            PG8_LDA(At, 1, 1); PG8_STAGE(PG8_SB(1, 0), b3, voffB); PG8_STAGE(PG8_SB(1, 1), b3 + hstep, voffB); PG8_STAGE(PG8_SA(1, 0), a3, voffA);
            PG8_WAIT_V(8); PG8_WAIT_L(0); PG8_BAR; PG8_MMA(1, 0, At, B0); PG8_MMA(1, 1, At, B1); PG8_BAR; PG8_SCHED;
            if constexpr (Epi::MIDK) { if (t == nt / 2 - 2) E.mid(acc, cur, wr, wc, fr, fq); }
        }
        if (wr == 0) PG8_BAR;
        E(acc, cur, wr, wc, fr, fq);
        if (!has_next) break;
#pragma unroll
        for (int a = 0; a < 2; ++a)
#pragma unroll
            for (int b = 0; b < 2; ++b)
#pragma unroll
                for (int m = 0; m < 4; ++m)
#pragma unroll
                    for (int n = 0; n < 2; ++n) acc[a][b][m][n] = (f32x4){0.f, 0.f, 0.f, 0.f};
        cur = nxt; cA = nA; cB = nB; ++ui;
        if (wr == 1) PG8_BAR;
    }
    PG8_WAIT_V(0);
    PG8_BAR;
#undef PG8_SA
#undef PG8_SB
#undef PG8_STAGE
#undef PG8_LDA
#undef PG8_LDB
#undef PG8_MMA
#undef PG8_WAIT_V
#undef PG8_WAIT_L
#undef PG8_BAR
#undef PG8_SCHED
}
}

struct Params {
    const float* x; const int* pos; const float* norm1_g; const float* w_in; const float* q_norm_g; const float* k_norm_g;
    const float* idx_g; const float* idx_b; const float* w_a; const float* pool_mix; const float* pool_scale; const float* w_b;
    const float* w_out; const float* norm2_g; const float* router_w; const float* router_b; const float* w_gu; const float* b_gu;
    const float* w_d; const float* b_d;
    float* out; unsigned char* ws; int ph_lo, ph_hi;
};

using pg8::Unit; using pg8::HALF;
__device__ __forceinline__ void st8(bf16_t* p, const float (&v)[8]) {
    u32x4 w; w.x = cvt_pk_bf16(v[0], v[1]); w.y = cvt_pk_bf16(v[2], v[3]); w.z = cvt_pk_bf16(v[4], v[5]); w.w = cvt_pk_bf16(v[6], v[7]); *(u32x4*)p = w;
}
__device__ __forceinline__ void ld8f(const float* p, float (&v)[8]) { const f32x4 a = *(const f32x4*)p, b = *(const f32x4*)(p + 4); v[0]=a[0]; v[1]=a[1]; v[2]=a[2]; v[3]=a[3]; v[4]=b[0]; v[5]=b[1]; v[6]=b[2]; v[7]=b[3]; }
__device__ __forceinline__ void ld8bf(const bf16_t* p, float (&v)[8]) { const u32x4 w = *(const u32x4*)p; v[0]=bf_lo(w.x); v[1]=bf_hi(w.x); v[2]=bf_lo(w.y); v[3]=bf_hi(w.y); v[4]=bf_lo(w.z); v[5]=bf_hi(w.z); v[6]=bf_lo(w.w); v[7]=bf_hi(w.w); }

struct EpiInProj {
    static constexpr bool MIDK = false;
    bf16_t *Q, *Kb, *Vb, *Qi, *Ki, *Pool, *Ga, *Gp; float* Wi; const float* cs; const float *gq, *gk, *lng, *lnb;
    __device__ __forceinline__ void operator()(const f32x4 (&acc)[2][2][4][2], const Unit& u, int wr, int wc, int fr, int fq) const {
        const int pn = u.pn;
#pragma unroll
        for (int ai = 0; ai < 2; ++ai)
#pragma unroll
            for (int m = 0; m < 4; ++m) {
                const int row = u.pm * 256 + ai * HALF + wr * 64 + m * 16 + fr;
                float v0[8], v1[8];
#pragma unroll
                for (int n = 0; n < 2; ++n)
#pragma unroll
                    for (int i = 0; i < 4; ++i) { v0[4 * n + i] = acc[ai][0][m][n][i]; v1[4 * n + i] = acc[ai][1][m][n][i]; }
                if (pn <= 1 || (pn == 2 && wc < 2)) {
                    float ss = 0.f;
#pragma unroll
                    for (int j = 0; j < 8; ++j) ss += v0[j] * v0[j] + v1[j] * v1[j];
                    ss += __shfl_xor(ss, 16); ss += __shfl_xor(ss, 32);
                    const float rs = 1.0f / sqrtf(ss * (1.0f / 64.0f) + NORM_EPS);
                    const float* gg = (pn <= 1) ? gq : gk; const float sc = (pn <= 1) ? 0.18033688011112042f : 1.0f;
                    float g0[8], g1[8], cc[8], sn[8];
                    ld8f(gg + 8 * fq, g0); ld8f(gg + 32 + 8 * fq, g1);
                    ld8f(cs + (size_t)row * 96 + 8 * fq, cc); ld8f(cs + (size_t)row * 96 + 48 + 8 * fq, sn);
                    float o0[8], o1[8];
#pragma unroll
                    for (int j = 0; j < 8; ++j) { const float x1 = v0[j] * rs * g0[j], x2 = v1[j] * rs * g1[j]; o0[j] = (x1 * cc[j] - x2 * sn[j]) * sc; o1[j] = (x2 * cc[j] + x1 * sn[j]) * sc; }
                    if (pn <= 1) { bf16_t* dst = Q + (size_t)row * 512 + (4 * pn + wc) * 64; st8(dst + 8 * fq, o0); st8(dst + 32 + 8 * fq, o1); }
                    else {
                        bf16_t* dst = Kb + ((((size_t)((row >> 12) * 2 + wc) * 128 + ((row & 4095) >> 5)) * 4 + (fq >> 1)) * 64 + ((fq & 1) * 32 + (row & 31))) * 8;
                        st8(dst, o0); st8(dst + 2 * 512, o1); }
                } else if (pn == 2) {
                    const int t = row & 4095, kk = t & 31;
                    bf16_t* dst = Vb + (((size_t)((row >> 12) * 2 + (wc - 2)) * 128 + (t >> 5)) * 4 + (kk >> 4)) * 512 + (((kk >> 2) & 1) * 32 + 8 * fq) * 8 + 4 * ((kk >> 3) & 1) + (kk & 3);
#pragma unroll
                    for (int j = 0; j < 8; ++j) { dst[j * 8] = (bf16_t)(cvt_pk_bf16(v0[j], v0[j]) & 0xffffu); dst[2 * 512 + j * 8] = (bf16_t)(cvt_pk_bf16(v1[j], v1[j]) & 0xffffu); }
                } else if (pn == 3 || (pn == 4 && wc == 0)) {
                    if (pn == 4) {
                        float s = 0.f;
#pragma unroll
                        for (int j = 0; j < 8; ++j) s += v0[j] + v1[j];
                        s += __shfl_xor(s, 16); s += __shfl_xor(s, 32);
                        const float mu = s * (1.0f / 64.0f); float q = 0.f;
#pragma unroll
                        for (int j = 0; j < 8; ++j) { v0[j] -= mu; v1[j] -= mu; q += v0[j] * v0[j] + v1[j] * v1[j]; }
                        q += __shfl_xor(q, 16); q += __shfl_xor(q, 32);
                        const float rs = 1.0f / sqrtf(q * (1.0f / 64.0f) + NORM_EPS);
                        const int d0 = (fq < 2) ? 8 * fq : 8 * fq + 16, d1 = (fq < 2) ? 16 + 8 * fq : 8 * fq + 32;
                        float a0[8], a1[8], b0[8], b1[8];
                        ld8f(lng + d0, a0); ld8f(lng + d1, a1); ld8f(lnb + d0, b0); ld8f(lnb + d1, b1);
#pragma unroll
                        for (int j = 0; j < 8; ++j) { v0[j] = v0[j] * rs * a0[j] + b0[j]; v1[j] = v1[j] * rs * a1[j] + b1[j]; }
                    }
                    bf16_t* dst = Qi + (size_t)row * 256 + wc * 64;
                    bf16_t* kdst = Ki + (((size_t)(row >> 12) * 128 + ((row & 4095) >> 5)) * 4 * 64 + (row & 31)) * 8;
                    if (fq < 2) {
                        float cc[8], sn[8];
                        ld8f(cs + (size_t)row * 96 + 32 + 8 * fq, cc); ld8f(cs + (size_t)row * 96 + 48 + 32 + 8 * fq, sn);
                        float o0[8], o1[8];
#pragma unroll
                        for (int j = 0; j < 8; ++j) { o0[j] = v0[j] * cc[j] - v1[j] * sn[j]; o1[j] = v1[j] * cc[j] + v0[j] * sn[j]; }
                        if (pn == 3) { st8(dst + 8 * fq, o0); st8(dst + 16 + 8 * fq, o1); }
                        else { st8(kdst + (fq * 32) * 8, o0); st8(kdst + (64 + fq * 32) * 8, o1); }
                    } else {
                        if (pn == 3) { st8(dst + 8 * fq + 16, v0); st8(dst + 8 * fq + 32, v1); }
                        else { st8(kdst + (2 * 64 + (fq - 2) * 32) * 8, v0); st8(kdst + (3 * 64 + (fq - 2) * 32) * 8, v1); } }
                } else if (pn == 4) {
                    if (wc == 1 && fq == 0) *(f32x4*)(Wi + (size_t)row * 4) = (f32x4){v0[0] * 0.0625f, v0[1] * 0.0625f, v0[2] * 0.0625f, v0[3] * 0.0625f};
                } else if (pn <= 6) {
                    bf16_t* dst = Pool + (size_t)row * 512 + (pn - 5) * 256 + wc * 32 + 8 * fq;
                    st8(dst, v0); st8(dst + HALF, v1);
                } else {
                    bf16_t* dst = ((pn <= 10) ? Ga + (size_t)row * 1024 + (pn - 7) * 256 : Gp + (size_t)row * 1024 + (pn - 11) * 256) + wc * 32 + 8 * fq;
#pragma unroll
                    for (int j = 0; j < 8; ++j) { v0[j] = sigmoidf_(v0[j]); v1[j] = sigmoidf_(v1[j]); }
                    st8(dst, v0); st8(dst + HALF, v1);
                }
            }
    }
};

struct EpiGated {
    static constexpr bool MIDK = true;
    const bf16_t* Ga; const bf16_t* Gp; bf16_t* O;
    __device__ __forceinline__ void mid(f32x4 (&acc)[2][2][4][2], const Unit& u, int wr, int wc, int fr, int fq) const {
        asm volatile("" : "+v"(fr), "+v"(fq));
#pragma unroll
        for (int ai = 0; ai < 2; ++ai)
#pragma unroll
            for (int m = 0; m < 4; ++m) {
                const size_t off = (size_t)(u.pm * 256 + ai * HALF + wr * 64 + m * 16 + fr) * 1024 + u.pn * 256 + wc * 32 + 8 * fq;
#pragma unroll
                for (int bj = 0; bj < 2; ++bj) {
                    float ga[8], gp[8]; ld8bf(Ga + off + bj * HALF, ga); ld8bf(Gp + off + bj * HALF, gp);
#pragma unroll
                    for (int n = 0; n < 2; ++n)
#pragma unroll
                        for (int i = 0; i < 4; ++i) acc[ai][bj][m][n][i] *= ga[4 * n + i] * __builtin_amdgcn_rcpf(fmaxf(gp[4 * n + i], 1e-30f));
                }
                if (m & 1) asm volatile("" ::: "memory");
            }
    }
    __device__ __forceinline__ void operator()(const f32x4 (&acc)[2][2][4][2], const Unit& u, int wr, int wc, int fr, int fq) const {
        asm volatile("" : "+v"(fr), "+v"(fq));
#pragma unroll
        for (int ai = 0; ai < 2; ++ai)
#pragma unroll
            for (int m = 0; m < 4; ++m) {
                const size_t off = (size_t)(u.pm * 256 + ai * HALF + wr * 64 + m * 16 + fr) * 1024 + u.pn * 256 + wc * 32 + 8 * fq;
#pragma unroll
                for (int bj = 0; bj < 2; ++bj) {
                    float g[8], o[8]; ld8bf(Gp + off + bj * HALF, g);
#pragma unroll
                    for (int n = 0; n < 2; ++n)
#pragma unroll
                        for (int i = 0; i < 4; ++i) o[4 * n + i] = g[4 * n + i] * acc[ai][bj][m][n][i];
                    st8(O + off + bj * HALF, o);
                }
            }
    }
};
struct EpiResid {
    static constexpr bool MIDK = false;
    const float* X; float* O;
    __device__ __forceinline__ void operator()(const f32x4 (&acc)[2][2][4][2], const Unit& u, int wr, int wc, int fr, int fq) const {
#pragma unroll
        for (int ai = 0; ai < 2; ++ai)
#pragma unroll
            for (int m = 0; m < 4; ++m) {
                const size_t off = (size_t)(u.pm * 256 + ai * HALF + wr * 64 + m * 16 + fr) * 1024 + u.pn * 256 + wc * 32 + 8 * fq;
#pragma unroll
                for (int bj = 0; bj < 2; ++bj)
#pragma unroll
                    for (int n = 0; n < 2; ++n) { const size_t o = off + bj * HALF + 4 * n; *(f32x4*)(O + o) = *(const f32x4*)(X + o) + acc[ai][bj][m][n]; }
            }
    }
};
struct EpiGateUp {
    static constexpr bool MIDK = false;
    const float* bias; unsigned char* Act;
    __device__ __forceinline__ void operator()(const f32x4 (&acc)[2][2][4][2], const Unit& u, int wr, int wc, int fr, int fq) const {
        { int t_ = threadIdx.x; asm volatile("" : "+v"(t_)); fr = t_ & 15; fq = (t_ >> 4) & 3; }
        const int e = u.pn >> 3, pnl = u.pn & 7, col = pnl * 128 + wc * 32 + 8 * fq;
        float bg[8], bu[8]; ld8f(bias + (size_t)e * 2048 + col, bg); ld8f(bias + (size_t)e * 2048 + 1024 + col, bu);
#pragma unroll
        for (int ai = 0; ai < 2; ++ai)
#pragma unroll
            for (int m = 0; m < 4; ++m) {
                const size_t row = (size_t)(u.pm * 256 + ai * HALF + wr * 64 + m * 16 + fr);
                float o[8];
#pragma unroll
                for (int n = 0; n < 2; ++n)
#pragma unroll
                    for (int i = 0; i < 4; ++i) { const int j = 4 * n + i;
                        const float gt = fminf(acc[ai][0][m][n][i] * MOE_WINV + bg[j], 7.0f), up = fminf(fmaxf(acc[ai][1][m][n][i] * MOE_WINV + bu[j], -7.0f), 7.0f);
                        o[j] = gt * __builtin_amdgcn_rcpf(1.0f + __builtin_amdgcn_exp2f(-2.4554669595930156f * gt)) * (up + 1.0f); }
                u32x2 w; w.x = pk4_fp8(o[0], o[1], o[2], o[3]); w.y = pk4_fp8(o[4], o[5], o[6], o[7]);
                *(u32x2*)(Act + row * 1024 + col) = w;
            }
    }
};
struct EpiDown {
    static constexpr bool MIDK = false;
    const float* bias; const float* sgate; unsigned char* Y;
    __device__ __forceinline__ void operator()(const f32x4 (&acc)[2][2][4][2], const Unit& u, int wr, int wc, int fr, int fq) const {
        { int t_ = threadIdx.x; asm volatile("" : "+v"(t_)); fr = t_ & 15; fq = (t_ >> 4) & 3; }
        const int e = u.pn >> 2, pnl = u.pn & 3, col = pnl * 256 + wc * 32 + 8 * fq;
        float b0[8], b1[8]; ld8f(bias + (size_t)e * 1024 + col, b0); ld8f(bias + (size_t)e * 1024 + col + HALF, b1);
#pragma unroll
        for (int ai = 0; ai < 2; ++ai)
#pragma unroll
            for (int m = 0; m < 4; ++m) {
                const size_t row = (size_t)(u.pm * 256 + ai * HALF + wr * 64 + m * 16 + fr);
                const float gt = sgate[row] * Y_SCALE;
                float o0[8], o1[8];
#pragma unroll
                for (int n = 0; n < 2; ++n)
#pragma unroll
                    for (int i = 0; i < 4; ++i) { const int j = 4 * n + i; o0[j] = (acc[ai][0][m][n][i] * MOE_WINV + b0[j]) * gt; o1[j] = (acc[ai][1][m][n][i] * MOE_WINV + b1[j]) * gt; }
                u32x2 w0, w1; w0.x = pk4_fp8(o0[0], o0[1], o0[2], o0[3]); w0.y = pk4_fp8(o0[4], o0[5], o0[6], o0[7]); w1.x = pk4_fp8(o1[0], o1[1], o1[2], o1[3]); w1.y = pk4_fp8(o1[4], o1[5], o1[6], o1[7]);
                *(u32x2*)(Y + row * 1024 + col) = w0; *(u32x2*)(Y + row * 1024 + col + HALF) = w1;
            }
    }
};

template <class RowMap>
__device__ __forceinline__ void cvt_item(const float* W, int K, int N, bf16_t* WT, LAS float* scr, int kb, int nb, int lane, const RowMap& rm, int ldt = 0) {
    if (ldt == 0) ldt = K;
    const int k0 = kb * 64, n0 = nb * 64, n4 = lane & 15, kr = lane >> 4, n = n0 + 4 * n4;
    f32x4 v[16];
#pragma unroll
    for (int i = 0; i < 16; ++i) v[i] = (n < N) ? *(const f32x4*)(W + (size_t)(k0 + 4 * i + kr) * N + n) : (f32x4){0.f, 0.f, 0.f, 0.f};
#pragma unroll
    for (int i = 0; i < 16; ++i) { LAS float* d = scr + (4 * i + kr) * 65 + 4 * n4; d[0] = v[i][0]; d[1] = v[i][1]; d[2] = v[i][2]; d[3] = v[i][3]; }
    LDS_WAIT(); asm volatile("" ::: "memory");
    const int c8 = lane & 7;
#pragma unroll
    for (int jj = 0; jj < 8; ++jj) { const int nn = (lane >> 3) + 8 * jj; const LAS float* s = scr + (8 * c8) * 65 + nn;
        if (n0 + nn < N) { u32x4 o; o.x = cvt_pk_bf16(s[0], s[65]); o.y = cvt_pk_bf16(s[2 * 65], s[3 * 65]); o.z = cvt_pk_bf16(s[4 * 65], s[5 * 65]); o.w = cvt_pk_bf16(s[6 * 65], s[7 * 65]);
            *(u32x4*)(WT + (size_t)rm(n0 + nn) * ldt + k0 + 8 * c8) = o; } }
    LDS_WAIT(); asm volatile("" ::: "memory");
}
template <class RowMap>
__device__ __forceinline__ void cvt_item_f8(const float* W, int K, int N, unsigned char* WT, LAS float* scr, int kb, int nb, int lane, const RowMap& rm, float scale) {
    const int k0 = kb * 64, n0 = nb * 64, n4 = lane & 15, kr = lane >> 4, n = n0 + 4 * n4;
    f32x4 v[16];
#pragma unroll
    for (int i = 0; i < 16; ++i) v[i] = *(const f32x4*)(W + (size_t)(k0 + 4 * i + kr) * N + n);
#pragma unroll
    for (int i = 0; i < 16; ++i) { LAS float* d = scr + (4 * i + kr) * 65 + 4 * n4; d[0] = v[i][0] * scale; d[1] = v[i][1] * scale; d[2] = v[i][2] * scale; d[3] = v[i][3] * scale; }
    LDS_WAIT(); asm volatile("" ::: "memory");
    const int c8 = lane & 7;
#pragma unroll
    for (int jj = 0; jj < 8; ++jj) { const int nn = (lane >> 3) + 8 * jj; const LAS float* sp = scr + (8 * c8) * 65 + nn;
        u32x2 o; o.x = pk4_fp8(sp[0], sp[65], sp[2 * 65], sp[3 * 65]); o.y = pk4_fp8(sp[4 * 65], sp[5 * 65], sp[6 * 65], sp[7 * 65]);
        *(u32x2*)(WT + (size_t)rm(n0 + nn) * K + k0 + 8 * c8) = o; }
    LDS_WAIT(); asm volatile("" ::: "memory");
}
struct RmIdent { int off; __device__ __forceinline__ int operator()(int n) const { return off + n; } };
struct RmWin { __device__ __forceinline__ int operator()(int n) const { return win_phys(n); } };
struct RmGu { int e; __device__ __forceinline__ int operator()(int n) const { return e * 2048 + 256 * ((n & 1023) >> 7) + 128 * (n >> 10) + (n & 127); } };

__device__ __forceinline__ void phase0(const Params& p, LAS unsigned char* lds, int bid, int G) {
    const int tid = threadIdx.x, lane = tid & 63, wave = __builtin_amdgcn_readfirstlane(tid >> 6);
    const int gw = bid * NWAVES + wave, NGW = G * NWAVES;
    unsigned char* ws = p.ws;
    LAS float* scr = (LAS float*)(lds + wave * 16640);
    constexpr int I_GU = NEXP * 16 * 32, I_D = NEXP * 16 * 16, I_IN = 16 * 58, I_A = 8 * 16, I_O = 16 * 16;
    constexpr int NITEMS = I_GU + I_D + I_IN + I_A + I_O;
    for (int it = gw; it < NITEMS; it += NGW) {
        int r = it;
        if (r < I_GU) { const int e = r / 512, q = r % 512; cvt_item_f8(p.w_gu + (size_t)e * 1024 * 2048, 1024, 2048, ws + WS_WGU, scr, q / 32, q % 32, lane, RmGu{e}, MOE_WSCALE); continue; } r -= I_GU;
        if (r < I_D) { const int e = r / 256, q = r % 256; cvt_item_f8(p.w_d + (size_t)e * 1024 * 1024, 1024, 1024, ws + WS_WD, scr, q / 16, q % 16, lane, RmIdent{e * 1024}, MOE_WSCALE); continue; } r -= I_D;
        if (r < I_IN) { cvt_item(p.w_in, 1024, INW, (bf16_t*)(ws + WS_WIN), scr, r / 58, r % 58, lane, RmWin{}); continue; } r -= I_IN;
        if (r < I_A) { cvt_item(p.w_a, 512, 1024, (bf16_t*)(ws + WS_WCAT), scr, r / 16, r % 16, lane, RmIdent{0}, 1024); continue; } r -= I_A;
        cvt_item(p.w_out, 1024, 1024, (bf16_t*)(ws + WS_WOUT), scr, r / 16, r % 16, lane, RmIdent{0});
    }
    for (int it = gw; it < 16 * 4 * 16; it += NGW) {
        const int nb = it & 15, g = (it >> 4) & 3, cb = it >> 6, n = nb * 64 + lane, c0 = cb * 8;
        float a[8];
#pragma unroll
        for (int q = 0; q < 8; ++q) a[q] = 0.f;
        const float* mix = p.pool_mix + (size_t)g * 128 * 128 + (size_t)c0 * 128;
        for (int d = 0; d < 128; ++d) {
            const float wb = p.pool_scale[g * 128 + d] * p.w_b[(size_t)(g * 128 + d) * 1024 + n];
#pragma unroll
            for (int q = 0; q < 8; ++q) a[q] += mix[q * 128 + d] * wb;
        }
        st8((bf16_t*)(ws + WS_WCAT) + (size_t)n * 1024 + 512 + g * 128 + c0, a);
    }
    {
        f32x4 gv[4];
#pragma unroll
        for (int j = 0; j < 4; ++j) gv[j] = *(const f32x4*)(p.norm1_g + 4 * lane + 256 * j);
        bf16_t* XN = (bf16_t*)(ws + WS_XN);
        for (int m = gw; m < NTOK; m += NGW) {
            const f32x4* xr = (const f32x4*)(p.x + (size_t)m * D) + lane;
            f32x4 v[4]; float s = 0.f;
#pragma unroll
            for (int j = 0; j < 4; ++j) { v[j] = xr[64 * j]; s += (v[j].x * v[j].x + v[j].y * v[j].y) + (v[j].z * v[j].z + v[j].w * v[j].w); }
            const float rs = 1.0f / sqrtf(wave_sum(s) * (1.0f / D) + NORM_EPS);
#pragma unroll
            for (int j = 0; j < 4; ++j) { const f32x4 o = v[j] * rs * gv[j]; u32x2 w; w.x = cvt_pk_bf16(o.x, o.y); w.y = cvt_pk_bf16(o.z, o.w); *(u32x2*)(XN + (size_t)m * D + 4 * lane + 256 * j) = w; }
        }
    }
    {
        float* cs = (float*)(ws + WS_CS);
        for (int i = bid * NTHREADS + tid; i < NTOK * 48; i += G * NTHREADS) {
            const int row = i / 48, j = i % 48;
            const float ex = (j < 32) ? -(float)j / 32.0f : -(float)(j - 32) / 16.0f;
            const float ang = (float)p.pos[row] * powf(10000.0f, ex);
            float sn, cc; sincosf(ang, &sn, &cc);
            cs[(size_t)row * 96 + j] = cc; cs[(size_t)row * 96 + 48 + j] = sn;
        }
    }
}

__device__ __forceinline__ void pool_phase(const Params& p, int bid, int G) {
    const int tid = threadIdx.x, lane = tid & 63, wave = __builtin_amdgcn_readfirstlane(tid >> 6);
    const int gw = bid * NWAVES + wave, NGW = G * NWAVES;
    const bf16_t* Pool = (const bf16_t*)(p.ws + WS_POOL); bf16_t* Mixed = (bf16_t*)(p.ws + WS_ACAT) + 512;
    const int w = 2 << (lane >> 4);
    for (int it = gw; it < NBATCH * 256; it += NGW) {
        const int b = it >> 8, tb = (it & 255) * 16;
        const bf16_t* P = Pool + (size_t)b * SEQ * 512 + 8 * lane;
        float sum[8];
#pragma unroll
        for (int q = 0; q < 8; ++q) sum[q] = 0.f;
        for (int d = 1; d < 16; ++d) if (d < w && tb - d >= 0) { float v[8]; ld8bf(P + (size_t)(tb - d) * 512, v);
#pragma unroll
            for (int q = 0; q < 8; ++q) sum[q] += v[q]; }
        for (int t = tb; t < tb + 16; ++t) {
            float cur[8]; ld8bf(P + (size_t)t * 512, cur);
#pragma unroll
            for (int q = 0; q < 8; ++q) sum[q] += cur[q];
            const float inv = 1.0f / (float)((t + 1 < w) ? t + 1 : w);
            float o[8];
#pragma unroll
            for (int q = 0; q < 8; ++q) o[q] = sum[q] * inv - cur[q];
            st8(Mixed + ((size_t)b * SEQ + t) * 1024 + 8 * lane, o);
            if (t - w + 1 >= 0) { float old[8]; ld8bf(P + (size_t)(t - w + 1) * 512, old);
#pragma unroll
                for (int q = 0; q < 8; ++q) sum[q] -= old[q]; }
        }
    }
}

__device__ __forceinline__ int wave_sum_i(int v) {
    v += __builtin_amdgcn_update_dpp(0, v, 0xB1, 0xF, 0xF, true);
    v += __builtin_amdgcn_update_dpp(0, v, 0x4E, 0xF, 0xF, true);
    v += __builtin_amdgcn_update_dpp(0, v, 0x141, 0xF, 0xF, true);
    v += __builtin_amdgcn_update_dpp(0, v, 0x140, 0xF, 0xF, true);
    v += __builtin_amdgcn_update_dpp(0, v, 0x142, 0xA, 0xF, true);
    v += __builtin_amdgcn_update_dpp(0, v, 0x143, 0xC, 0xF, true);
    return __builtin_amdgcn_readlane(v, 63);
}
__device__ __forceinline__ int count_ge(const unsigned (&key)[64], int nj, unsigned mid) {
    int c0 = 0, c1 = 0, c2 = 0, c3 = 0;
#pragma unroll
    for (int jb = 0; jb < 8; ++jb) if (jb * 8 < nj) {
        c0 += (key[jb * 8 + 0] >= mid) ? 1 : 0; c1 += (key[jb * 8 + 1] >= mid) ? 1 : 0; c2 += (key[jb * 8 + 2] >= mid) ? 1 : 0; c3 += (key[jb * 8 + 3] >= mid) ? 1 : 0;
        c0 += (key[jb * 8 + 4] >= mid) ? 1 : 0; c1 += (key[jb * 8 + 5] >= mid) ? 1 : 0; c2 += (key[jb * 8 + 6] >= mid) ? 1 : 0; c3 += (key[jb * 8 + 7] >= mid) ? 1 : 0; }
    return wave_sum_i((c0 + c1) + (c2 + c3));
}
__device__ __forceinline__ int lane_prefix(unsigned long long m) { return __builtin_amdgcn_mbcnt_hi((unsigned)(m >> 32), __builtin_amdgcn_mbcnt_lo((unsigned)m, 0u)); }
__device__ __forceinline__ unsigned wave_umax(unsigned v) {
#pragma unroll
    for (int o = 1; o < 64; o <<= 1) { const unsigned t = (unsigned)__shfl_xor((int)v, o); v = t > v ? t : v; }
    return (unsigned)__builtin_amdgcn_readfirstlane((int)v);
}
__device__ __forceinline__ unsigned wave_umin(unsigned v) {
#pragma unroll
    for (int o = 1; o < 64; o <<= 1) { const unsigned t = (unsigned)__shfl_xor((int)v, o); v = t < v ? t : v; }
    return (unsigned)__builtin_amdgcn_readfirstlane((int)v);
}

__device__ __forceinline__ void select_unit(const Params& p, LAS unsigned char* lds, int b, int t0) {
    int tid = threadIdx.x; asm volatile("" : "+v"(tid));
    const int lane = tid & 63, wave = __builtin_amdgcn_readfirstlane(tid >> 6);
    unsigned char* wsq = p.ws; asm volatile("" : "+s"(wsq));
    const bf16_t* Qi = (const bf16_t*)(wsq + WS_QI); const bf16_t* Ki = (const bf16_t*)(wsq + WS_KI); const float* Wi = (const float*)(wsq + WS_WI);
    unsigned* M32 = (unsigned*)(wsq + WS_MASK);
    LAS float* SC = (LAS float*)lds;
    const int c = t0 >> 6, nj = c + 1, nk = 64 * nj, ntile = nk >> 5;
    const size_t tok0 = (size_t)b * SEQ + t0;
    {
        const int r = lane & 31, hh = lane >> 5;
        bf16x8 qa[4];
        const bf16_t* qp = Qi + (tok0 + (r >> 2)) * 256 + (r & 3) * 64 + 8 * hh;
#pragma unroll
        for (int ks = 0; ks < 4; ++ks) qa[ks] = *(const bf16x8*)(qp + 16 * ks);
        f32x4 wv[4];
#pragma unroll
        for (int g = 0; g < 4; ++g) wv[g] = *(const f32x4*)(Wi + (tok0 + 2 * g + hh) * 4);
        const bf16_t* kif = Ki + (size_t)b * 128 * 4 * 512 + lane * 8;
        bf16x8 kbA[4][4], kbB[4][4];
#define LOADK(dst, k0) do { _Pragma("unroll") for (int u = 0; u < 4; ++u) { const int kt = ((k0) + u < ntile) ? (k0) + u : (k0); \
            _Pragma("unroll") for (int ks = 0; ks < 4; ++ks) dst[u][ks] = *(const bf16x8*)(kif + (size_t)(kt * 4 + ks) * 512); } } while (0)
#define COMPK(src, k0) do { _Pragma("unroll") for (int u = 0; u < 4; ++u) if ((k0) + u < ntile) { f32x16 acc; \
            _Pragma("unroll") for (int q = 0; q < 16; ++q) acc[q] = 0.f; \
            _Pragma("unroll") for (int ks = 0; ks < 4; ++ks) acc = __builtin_amdgcn_mfma_f32_32x32x16_bf16(qa[ks], src[u][ks], acc, 0, 0, 0); \
            _Pragma("unroll") for (int g = 0; g < 4; ++g) { float sv = fmaf(wv[g][0], fmaxf(acc[4 * g], 0.f), 0.0f); \
                sv = fmaf(wv[g][1], fmaxf(acc[4 * g + 1], 0.f), sv); sv = fmaf(wv[g][2], fmaxf(acc[4 * g + 2], 0.f), sv); sv = fmaf(wv[g][3], fmaxf(acc[4 * g + 3], 0.f), sv); \
                SC[(2 * g + hh) * 4096 + ((k0) + u) * 32 + r] = sv; } } } while (0)
        int kt0 = wave * 4;
        if (kt0 < ntile) {
            LOADK(kbA, kt0);
            for (;;) {
                const int k1 = kt0 + NWAVES * 4; if (k1 < ntile) LOADK(kbB, k1);
                COMPK(kbA, kt0); if (k1 >= ntile) break;
                const int k2 = k1 + NWAVES * 4; if (k2 < ntile) LOADK(kbA, k2);
                COMPK(kbB, k1); if (k2 >= ntile) break;
                kt0 = k2;
            }
        }
#undef LOADK
#undef COMPK
    }
    __syncthreads();
    LAS float* row = SC + wave * 4096;
    unsigned key[64];
#pragma unroll
    for (int jb = 0; jb < 8; ++jb) {
#pragma unroll
        for (int q = 0; q < 8; ++q) key[jb * 8 + q] = 0u;
        if (jb * 8 < nj) {
#pragma unroll
            for (int q = 0; q < 8; ++q) { const int j = jb * 8 + q; const unsigned u = __float_as_uint(row[j * 64 + lane]); const unsigned kk = (u & 0x80000000u) ? ~u : (u | 0x80000000u); key[j] = (j < nj) ? kk : 0u; }
        }
    }
    unsigned hiSel = 1u, T = 0u; int rrem = 0;
    if (nk > 256) {
        unsigned g0 = 0u, g1 = 0u, g2 = 0u, g3 = 0u;
#pragma unroll
        for (int j = 0; j < 64; j += 4) { g0 = key[j] > g0 ? key[j] : g0; g1 = key[j + 1] > g1 ? key[j + 1] : g1; g2 = key[j + 2] > g2 ? key[j + 2] : g2; g3 = key[j + 3] > g3 ? key[j + 3] : g3; }
        const unsigned mx01 = g0 > g1 ? g0 : g1, mx23 = g2 > g3 ? g2 : g3, mn01 = g0 < g1 ? g0 : g1, mn23 = g2 < g3 ? g2 : g3;
        const unsigned km = wave_umax(mx01 > mx23 ? mx01 : mx23);
        unsigned lo = wave_umin(mn01 < mn23 ? mn01 : mn23), hi = km + 1u; int cnt_hi = 0; bool exact = false;
        while (hi - lo > 1u) {
            const unsigned mid = lo + ((hi - lo) >> 1);
            const int cnt = count_ge(key, nj, mid);
            if (cnt >= 256) { lo = mid; if (cnt == 256) { exact = true; break; } } else { hi = mid; cnt_hi = cnt; }
        }
        if (exact) { hiSel = lo; T = 0u; rrem = 0; } else { hiSel = hi; T = lo; rrem = 256 - cnt_hi; }
    }
    unsigned* mrow = M32 + (tok0 + wave) * 128;
#pragma unroll
    for (int j = 0; j < 64; ++j) if ((j & ~7) < nj) {
        const bool eq = (key[j] == T) && (key[j] < hiSel);
        const unsigned long long eqm = __ballot(eq);
        const bool take = eq && (lane_prefix(eqm) < rrem);
        const int ne = __popcll(eqm); rrem = (ne < rrem) ? rrem - ne : 0;
        const bool sel = (key[j] >= hiSel) || take;
        const unsigned long long sm = __ballot(sel);
        if (lane == 0) *(u32x2*)(mrow + 2 * j) = (u32x2){(unsigned)sm, (unsigned)(sm >> 32)};
    }
    __syncthreads();
}

__device__ __forceinline__ void dense_attn_chunk(const Params& p, int b, int c, float negC) {
    int tid = threadIdx.x; asm volatile("" : "+v"(tid));
    const int lane = tid & 63, wave = __builtin_amdgcn_readfirstlane(tid >> 6);
    unsigned char* wsq = p.ws; asm volatile("" : "+s"(wsq));
    const bf16_t* Qb = (const bf16_t*)(wsq + WS_Q); const bf16_t* Kb = (const bf16_t*)(wsq + WS_K); const bf16_t* VT = (const bf16_t*)(wsq + WS_VT);
    const unsigned* M32 = (const unsigned*)(wsq + WS_MASK); bf16_t* Attn = (bf16_t*)(wsq + WS_ACAT);
    const int kvh = wave >> 2, cl = lane & 31, hi = lane >> 5, ntile = 2 * (c + 1);
    const size_t tokc = (size_t)b * SEQ + 64 * c + 16 * (wave & 3);
    bf16x8 qf[2][4]; const unsigned* mrow[2]; size_t tokq[2];
#pragma unroll
    for (int ti = 0; ti < 2; ++ti) { tokq[ti] = tokc + 8 * ti + (cl >> 2); mrow[ti] = M32 + tokq[ti] * 128;
#pragma unroll
        for (int ks = 0; ks < 4; ++ks) qf[ti][ks] = *(const bf16x8*)(Qb + tokq[ti] * 512 + (4 * kvh + (cl & 3)) * 64 + 16 * ks + 8 * hi); }
    f32x16 o[2][2]; float lsum[2] = {0.f, 0.f};
#pragma unroll
    for (int ti = 0; ti < 2; ++ti)
#pragma unroll
        for (int dt = 0; dt < 2; ++dt)
#pragma unroll
            for (int q = 0; q < 16; ++q) o[ti][dt][q] = 0.f;
    const bf16_t* kbase = Kb + (size_t)(b * 2 + kvh) * 128 * 4 * 512 + lane * 8;
    const bf16_t* vbase = VT + (size_t)(b * 2 + kvh) * 128 * 4 * 512 + lane * 8;
    bf16x8 kfA[4], kfB[4], vfA[4], vfB[4]; unsigned mwA[2], mwB[2];
#define LOADT(kf, vf, mw, kt) do { _Pragma("unroll") for (int q = 0; q < 4; ++q) { kf[q] = *(const bf16x8*)(kbase + (size_t)((kt) * 4 + q) * 512); vf[q] = *(const bf16x8*)(vbase + (size_t)((kt) * 4 + q) * 512); } \
        mw[0] = mrow[0][kt]; mw[1] = mrow[1][kt]; } while (0)
#define COMPT(kf, vf, mw) do { _Pragma("unroll") for (int ti = 0; ti < 2; ++ti) { f32x16 sa; const unsigned mwh = mw[ti] >> (4 * hi); \
        _Pragma("unroll") for (int q = 0; q < 16; ++q) sa[q] = negC; \
        _Pragma("unroll") for (int ks = 0; ks < 4; ++ks) sa = __builtin_amdgcn_mfma_f32_32x32x16_bf16(kf[ks], qf[ti][ks], sa, 0, 0, 0); \
        float pv[16]; float ls = 0.f; \
        _Pragma("unroll") for (int r = 0; r < 16; ++r) { const int pos = (r & 3) + 8 * (r >> 2); \
            const float e = __builtin_amdgcn_exp2f(sa[r]); const int m = __builtin_amdgcn_sbfe((int)mwh, pos, 1); \
            pv[r] = __uint_as_float(__float_as_uint(e) & (unsigned)m); ls += pv[r]; } \
        lsum[ti] += ls; \
        _Pragma("unroll") for (int sx = 0; sx < 2; ++sx) { \
            u32x4 pw; pw.x = cvt_pk_bf16(pv[8 * sx], pv[8 * sx + 1]); pw.y = cvt_pk_bf16(pv[8 * sx + 2], pv[8 * sx + 3]); pw.z = cvt_pk_bf16(pv[8 * sx + 4], pv[8 * sx + 5]); pw.w = cvt_pk_bf16(pv[8 * sx + 6], pv[8 * sx + 7]); \
            const bf16x8 pb = __builtin_bit_cast(bf16x8, pw); \
            _Pragma("unroll") for (int dt = 0; dt < 2; ++dt) o[ti][dt] = __builtin_amdgcn_mfma_f32_32x32x16_bf16(vf[dt * 2 + sx], pb, o[ti][dt], 0, 0, 0); } } } while (0)
    LOADT(kfA, vfA, mwA, 0);
    for (int kt = 0; kt < ntile; kt += 2) {
        LOADT(kfB, vfB, mwB, kt + 1);
        COMPT(kfA, vfA, mwA);
        if (kt + 2 < ntile) LOADT(kfA, vfA, mwA, kt + 2);
        COMPT(kfB, vfB, mwB);
    }
#undef LOADT
#undef COMPT
    int lane2 = lane; asm volatile("" : "+v"(lane2));
    const int cl2 = lane2 & 31, hi2 = lane2 >> 5;
#pragma unroll
    for (int ti = 0; ti < 2; ++ti) {
        const float lt = lsum[ti] + __shfl_xor(lsum[ti], 32); const float inv = 1.0f / lt;
        bf16_t* dst = Attn + (tokc + 8 * ti + (cl2 >> 2)) * 1024 + (4 * kvh + (cl2 & 3)) * 64 + 4 * hi2;
#pragma unroll
        for (int dt = 0; dt < 2; ++dt)
#pragma unroll
            for (int g4 = 0; g4 < 4; ++g4) { u32x2 w; w.x = cvt_pk_bf16(o[ti][dt][4 * g4] * inv, o[ti][dt][4 * g4 + 1] * inv); w.y = cvt_pk_bf16(o[ti][dt][4 * g4 + 2] * inv, o[ti][dt][4 * g4 + 3] * inv);
                *(u32x2*)(dst + 32 * dt + 8 * g4) = w; }
    }
}

__device__ __forceinline__ void attn_phase(const Params& p, LAS unsigned char* lds, int bid, int G) {
    const int lane = threadIdx.x & 63;
    float mq = fabsf(p.q_norm_g[lane]), mk = fabsf(p.k_norm_g[lane]);
#pragma unroll
    for (int o = 1; o < 64; o <<= 1) { mq = fmaxf(mq, __shfl_xor(mq, o)); mk = fmaxf(mk, __shfl_xor(mk, o)); }
    const float negC = -(8.0f * mq * mk * 1.4426950408889634f * 1.03f);
    for (int u = bid; u < NBATCH * 32; u += G) {
        const int b = u & 7, y = u >> 3;
        for (int half = 0; half < 2; ++half) {
            const int c = half ? 63 - y : y;
            for (int sx = 0; sx < 8; ++sx) select_unit(p, lds, b, 64 * c + 8 * sx);
            asm volatile("s_waitcnt vmcnt(0)" ::: "memory"); __syncthreads();
            dense_attn_chunk(p, b, c, negC);
        }
    }
}

constexpr int T_TSTART = 0, T_PADSTART = 40, T_BLOCKBASE = 80, T_NE = 112, T_WB = 144  , T_PART = 400  ;
__device__ __forceinline__ void router_phase(const Params& p, LAS unsigned char* lds, int bid, int G) {
    const int tid = threadIdx.x, lane = tid & 63, wave = __builtin_amdgcn_readfirstlane(tid >> 6);
    constexpr int WP = 1028;
    LAS float* WrT = (LAS float*)lds;
    for (int i = tid; i < 1024 * 32 / 4; i += NTHREADS) { const f32x4 v = *(const f32x4*)(p.router_w + 4 * (size_t)i); const int c = i >> 3, e0 = 4 * (i & 7); const float g = p.norm2_g[c];
        WrT[(e0 + 0) * WP + c] = v[0] * g; WrT[(e0 + 1) * WP + c] = v[1] * g; WrT[(e0 + 2) * WP + c] = v[2] * g; WrT[(e0 + 3) * WP + c] = v[3] * g; }
    __syncthreads();
    LAS int* tbl = (LAS int*)(lds + MISC_OFF);
    const float* X1 = p.out; unsigned char* H2 = p.ws + WS_H2;
    int* rec_e = (int*)(p.ws + WS_REC_E); int* rec_pos = (int*)(p.ws + WS_REC_POS); float* rec_gate = (float*)(p.ws + WS_REC_GATE);
    const int ex = lane & 15, kq = lane >> 4;
    const size_t tokw = (size_t)bid * 128 + wave * 16;
    f32x4 acc0 = (f32x4){0.f, 0.f, 0.f, 0.f}, acc1 = acc0; float ssq = 0.f;
    {
        const float* xr = X1 + (tokw + ex) * D + 4 * kq;
        const LAS float* w0 = WrT + ex * WP + 4 * kq; const LAS float* w1 = w0 + 16 * WP;
#pragma unroll 4
        for (int q = 0; q < 64; ++q) {
            const f32x4 a = *(const f32x4*)(xr + 16 * q); const f32x4 b0 = *(const LAS f32x4*)(w0 + 16 * q), b1 = *(const LAS f32x4*)(w1 + 16 * q);
            ssq += (a.x * a.x + a.y * a.y) + (a.z * a.z + a.w * a.w);
#pragma unroll
            for (int k = 0; k < 4; ++k) { acc0 = __builtin_amdgcn_mfma_f32_16x16x4f32(a[k], b0[k], acc0, 0, 0, 0); acc1 = __builtin_amdgcn_mfma_f32_16x16x4f32(a[k], b1[k], acc1, 0, 0, 0); }
        }
    }
    ssq += __shfl_xor(ssq, 16); ssq += __shfl_xor(ssq, 32);
    const float rs = 1.0f / sqrtf(ssq * (1.0f / D) + NORM_EPS);
    const float br0 = p.router_b[ex], br1 = p.router_b[ex + 16];
    float lg0[4], lg1[4];
#pragma unroll
    for (int i = 0; i < 4; ++i) { const float r = __shfl(rs, 4 * kq + i); lg0[i] = acc0[i] * r + br0; lg1[i] = acc1[i] * r + br1; }
    int ti[4][4]; float tv[4][4];
#pragma unroll
    for (int r = 0; r < 4; ++r)
#pragma unroll
        for (int i = 0; i < 4; ++i) {
            float bv = (lg0[i] >= lg1[i]) ? lg0[i] : lg1[i]; int bi = (lg0[i] >= lg1[i]) ? ex : ex + 16;
#pragma unroll
            for (int m = 1; m < 16; m <<= 1) { const float ov = __shfl_xor(bv, m); const int oi = __shfl_xor(bi, m); const bool better = (ov > bv) || (ov == bv && oi < bi); bv = better ? ov : bv; bi = better ? oi : bi; }
            tv[i][r] = bv; ti[i][r] = bi;
            if (bi == ex) lg0[i] = -INFINITY; if (bi == ex + 16) lg1[i] = -INFINITY;
        }
    unsigned M[4];
#pragma unroll
    for (int i = 0; i < 4; ++i) M[i] = (1u << ti[i][0]) | (1u << ti[i][1]) | (1u << ti[i][2]) | (1u << ti[i][3]);
    unsigned Mall[16];
#pragma unroll
    for (int t = 0; t < 16; ++t) Mall[t] = (unsigned)__builtin_amdgcn_readlane((int)M[t & 3], 16 * (t >> 2));
#pragma unroll
    for (int i = 0; i < 4; ++i) {
        const int t = 4 * kq + i;
        const float e1 = __expf(tv[i][1] - tv[i][0]), e2 = __expf(tv[i][2] - tv[i][0]), e3 = __expf(tv[i][3] - tv[i][0]); const float inv = 1.0f / (1.0f + e1 + e2 + e3);
#pragma unroll
        for (int r = 0; r < 4; ++r) {
            const int x = ti[i][r]; int pos = 0;
#pragma unroll
            for (int tp = 0; tp < 16; ++tp) pos += (tp < t) ? (int)((Mall[tp] >> x) & 1u) : 0;
            const float gt = (r == 0 ? 1.0f : (r == 1 ? e1 : (r == 2 ? e2 : e3))) * inv;
            if (ex == r) { rec_e[(tokw + t) * 4 + r] = x; rec_pos[(tokw + t) * 4 + r] = pos; rec_gate[(tokw + t) * 4 + r] = gt; }
        }
    }
    { int cnt = 0;
#pragma unroll
        for (int t = 0; t < 16; ++t) cnt += (int)((Mall[t] >> (lane & 31)) & 1u);
        if (lane < 32) tbl[T_WB + wave * 32 + lane] = cnt; }
    {
        f32x4 g2[4];
#pragma unroll
        for (int j = 0; j < 4; ++j) g2[j] = *(const f32x4*)(p.norm2_g + 4 * lane + 256 * j);
#pragma unroll 4
        for (int t = 0; t < 16; ++t) {
            const float r = __shfl(rs, t);
            const f32x4* xr = (const f32x4*)(X1 + (tokw + t) * D) + lane;
#pragma unroll
            for (int j = 0; j < 4; ++j) { const f32x4 h = xr[64 * j] * r * g2[j]; *(unsigned*)(H2 + (tokw + t) * D + 4 * lane + 256 * j) = pk4_fp8(h.x, h.y, h.z, h.w); }
        }
    }
    __syncthreads();
    if (tid < 256) ((int*)(p.ws + WS_WCNT))[(size_t)bid * 256 + tid] = tbl[T_WB + tid];
    if (tid < 32) { int sm = 0;
#pragma unroll
        for (int w = 0; w < 8; ++w) sm += tbl[T_WB + w * 32 + tid];
        ((int*)(p.ws + WS_BCNT))[bid * 32 + tid] = sm; }
    __syncthreads();
}

__device__ __forceinline__ void moe_tables(const Params& p, LAS int* tbl, int bid) {
    const int tid = threadIdx.x; const int* bcnt = (const int*)(p.ws + WS_BCNT);
    { const int e = tid & 31, part = tid >> 5; int all = 0, below = 0;
        for (int k = 0; k < 16; ++k) { const int blk = part * 16 + k; const int v = bcnt[blk * 32 + e]; all += v; below += (blk < bid) ? v : 0; }
        tbl[T_PART + part * 32 + e] = all; tbl[T_PART + 512 + part * 32 + e] = below; }
    __syncthreads();
    if (tid < 32) { int all = 0, below = 0;
        for (int q = 0; q < 16; ++q) { all += tbl[T_PART + q * 32 + tid]; below += tbl[T_PART + 512 + q * 32 + tid]; }
        tbl[T_NE + tid] = all; tbl[T_BLOCKBASE + tid] = below; }
    __syncthreads();
    if (tid == 0) { int ps = 0, ts = 0;
        for (int e = 0; e < NEXP; ++e) { tbl[T_PADSTART + e] = ps; tbl[T_TSTART + e] = ts; const int nt = (tbl[T_NE + e] + 255) >> 8; ps += nt * 256; ts += nt; }
        tbl[T_PADSTART + NEXP] = ps; tbl[T_TSTART + NEXP] = ts; }
    __syncthreads();
}

__device__ __forceinline__ void permute_phase(const Params& p, LAS unsigned char* lds, int bid, int G) {
    const int tid = threadIdx.x, lane = tid & 63, wave = __builtin_amdgcn_readfirstlane(tid >> 6);
    LAS int* tbl = (LAS int*)(lds + MISC_OFF);
    moe_tables(p, tbl, bid);
    if (tid < 256) { const int w = tid >> 5, e = tid & 31; int s = 0; const int* wc = (const int*)(p.ws + WS_WCNT) + (size_t)bid * 256;
        for (int q = 0; q < 8; ++q) s += (q < w) ? wc[q * 32 + e] : 0;
        tbl[T_WB + tid] = s; }
    __syncthreads();
    const int* rec_e = (const int*)(p.ws + WS_REC_E); const int* rec_pos = (const int*)(p.ws + WS_REC_POS); const float* rec_gate = (const float*)(p.ws + WS_REC_GATE);
    int* slot_of = (int*)(p.ws + WS_SLOT_OF); float* slot_gate = (float*)(p.ws + WS_SLOT_GATE);
    const unsigned char* H2 = p.ws + WS_H2; unsigned char* H2S = p.ws + WS_H2S;
    for (int bt = 0; bt < 4; ++bt) {
        const int idx = wave * 64 + bt * 16 + (lane & 15); const int tl = idx >> 2; const size_t tk = (size_t)bid * 128 + tl;
        const int e = rec_e[tk * 4 + (idx & 3)], pw = rec_pos[tk * 4 + (idx & 3)];
        const int slot = tbl[T_PADSTART + e] + tbl[T_BLOCKBASE + e] + tbl[T_WB + (tl >> 4) * 32 + e] + pw;
        if (lane < 16) { slot_of[tk * 4 + (idx & 3)] = slot; slot_gate[slot] = rec_gate[tk * 4 + (idx & 3)]; }
        u32x4 v0[16];
#pragma unroll
        for (int i = 0; i < 16; ++i) { const size_t tki = (size_t)bid * 128 + ((wave * 64 + bt * 16 + i) >> 2); v0[i] = *(const u32x4*)(H2 + tki * D + 16 * lane); }
#pragma unroll
        for (int i = 0; i < 16; ++i) { const int sl = __shfl(slot, i); *(u32x4*)(H2S + (size_t)sl * D + 16 * lane) = v0[i]; }
    }
}

__device__ __forceinline__ void combine_phase(const Params& p, int bid, int G) {
    const int tid = threadIdx.x, lane = tid & 63, wave = __builtin_amdgcn_readfirstlane(tid >> 6);
    const int gw = bid * NWAVES + wave, NGW = G * NWAVES;
    const int* slot_of = (const int*)(p.ws + WS_SLOT_OF); const unsigned char* Y = p.ws + WS_Y;
    typedef float f32x2v __attribute__((ext_vector_type(2)));
    for (int tk = gw; tk < NTOK; tk += NGW) {
        int sl[4];
#pragma unroll
        for (int r = 0; r < 4; ++r) sl[r] = slot_of[(size_t)tk * 4 + r];
        float* orow = p.out + (size_t)tk * D;
        unsigned yv[4][4];
#pragma unroll
        for (int j = 0; j < 4; ++j)
#pragma unroll
            for (int r = 0; r < 4; ++r) yv[j][r] = *(const unsigned*)(Y + (size_t)sl[r] * D + 4 * lane + 256 * j);
#pragma unroll
        for (int j = 0; j < 4; ++j) { f32x4 a = *(const f32x4*)(orow + 4 * lane + 256 * j); float s0 = 0.f, s1 = 0.f, s2 = 0.f, s3 = 0.f;
#pragma unroll
            for (int r = 0; r < 4; ++r) { const f32x2v lo = __builtin_amdgcn_cvt_pk_f32_fp8((int)yv[j][r], false), hi = __builtin_amdgcn_cvt_pk_f32_fp8((int)yv[j][r], true); s0 += lo.x; s1 += lo.y; s2 += hi.x; s3 += hi.y; }
            a.x += s0 * (1.0f / Y_SCALE); a.y += s1 * (1.0f / Y_SCALE); a.z += s2 * (1.0f / Y_SCALE); a.w += s3 * (1.0f / Y_SCALE);
            *(f32x4*)(orow + 4 * lane + 256 * j) = a; }
    }
}

constexpr int NPH = 11;
__global__ void __launch_bounds__(NTHREADS, 2) mega(Params p) {
    extern __shared__ __attribute__((aligned(16))) unsigned char lds_raw[];
    LAS unsigned char* lds = (LAS unsigned char*)lds_raw;
    cg::grid_group grid = cg::this_grid();
    const int bid = blockIdx.x, G = gridDim.x;
    unsigned char* ws = p.ws;
#ifndef PH_MASK
#define PH_MASK 0x7ff
#endif
#define IN(k) (((PH_MASK >> (k)) & 1) && p.ph_lo <= (k) && (k) < p.ph_hi)
#ifndef PH_DUP
#define PH_DUP 0
#endif
#define DUP(k) (((PH_DUP >> (k)) & 1) ? 2 : 1)
#define SEAM(k) do { if (IN(k) && IN((k) + 1)) grid.sync(); } while (0)
    if (IN(0)) { phase0(p, lds, bid, G); }
    SEAM(0);
    if (IN(1)) {
        pg8::Gemm g{(const bf16_t*)(ws + WS_XN), (const bf16_t*)(ws + WS_WIN), NTOK, INWP, D}; pg8::StaticOrder S; S.init(NTOK, INWP, G, bid);
        EpiInProj E{(bf16_t*)(ws + WS_Q), (bf16_t*)(ws + WS_K), (bf16_t*)(ws + WS_VT), (bf16_t*)(ws + WS_QI), (bf16_t*)(ws + WS_KI), (bf16_t*)(ws + WS_POOL), (bf16_t*)(ws + WS_GA), (bf16_t*)(ws + WS_GP),
                    (float*)(ws + WS_WI), (const float*)(ws + WS_CS), p.q_norm_g, p.k_norm_g, p.idx_g, p.idx_b};
        pg8::gemm_phase(lds, g, S, E);
    }
    SEAM(1);
    if (IN(2)) { pool_phase(p, bid, G); attn_phase(p, lds, bid, G); }
    SEAM(2);
    if (IN(3)) {
        pg8::Gemm g{(const bf16_t*)(ws + WS_ACAT), (const bf16_t*)(ws + WS_WCAT), NTOK, D, D}; pg8::StaticOrder S; S.init(NTOK, D, G, bid);
        EpiGated E{(const bf16_t*)(ws + WS_GA), (const bf16_t*)(ws + WS_GP), (bf16_t*)(ws + WS_MERGED)};
        pg8::gemm_phase(lds, g, S, E);
    }
    SEAM(4);
    if (IN(5)) {
        pg8::Gemm g{(const bf16_t*)(ws + WS_MERGED), (const bf16_t*)(ws + WS_WOUT), NTOK, D, D}; pg8::StaticOrder S; S.init(NTOK, D, G, bid);
        EpiResid E{p.x, p.out};
        pg8::gemm_phase(lds, g, S, E);
    }
    SEAM(5);
    if (IN(6)) { router_phase(p, lds, bid, G); }
    SEAM(6);
    if (IN(7)) { permute_phase(p, lds, bid, G); }
    SEAM(7);
    if (IN(8)) {
        LAS int* tbl = (LAS int*)(lds + MISC_OFF); moe_tables(p, tbl, bid);
        pg8::Gemm g{(const bf16_t*)(ws + WS_H2S), (const bf16_t*)(ws + WS_WGU), NSLOT, NEXP * 2048, D}; pg8::MoeOrder<8> S{tbl + T_TSTART, G, bid};
        EpiGateUp E{p.b_gu, ws + WS_ACT};
        pg8::gemm_phase<EpiGateUp, pg8::MoeOrder<8>, true>(lds, g, S, E);
    }
    SEAM(8);
    if (IN(9)) {
        LAS int* tbl = (LAS int*)(lds + MISC_OFF); moe_tables(p, tbl, bid);
        pg8::Gemm g{(const bf16_t*)(ws + WS_ACT), (const bf16_t*)(ws + WS_WD), NSLOT, NEXP * 1024, D}; pg8::MoeOrder<4> S{tbl + T_TSTART, G, bid};
        EpiDown E{p.b_d, (const float*)(ws + WS_SLOT_GATE), ws + WS_Y};
        pg8::gemm_phase<EpiDown, pg8::MoeOrder<4>, true>(lds, g, S, E);
    }
    SEAM(9);
    if (IN(10)) combine_phase(p, bid, G);
#undef IN
#undef SEAM
}

extern "C" void kernel_launch(void* const* d_in, const int* in_sizes, int n_in, void* d_out, int out_size, void* d_ws, size_t ws_size, hipStream_t stream) {
    static int grid = 0;
    if (grid == 0) {
        if (n_in != 20 || out_size != NTOK * D || ws_size < WS_END) { fprintf(stderr, "kernel_launch: unexpected shapes: n_in %d out %d ws %zu (need %zu)\n", n_in, out_size, ws_size, (size_t)WS_END); grid = -1; return; }
        int dev = 0, cus = 0, per_cu = 0;
        hipGetDevice(&dev); hipDeviceGetAttribute(&cus, hipDeviceAttributeMultiprocessorCount, dev);
        if (hipFuncSetAttribute((const void*)mega, hipFuncAttributeMaxDynamicSharedMemorySize, LDS_BYTES) != hipSuccess) { fprintf(stderr, "kernel_launch: hipFuncSetAttribute failed\n"); grid = -1; return; }
        if (hipOccupancyMaxActiveBlocksPerMultiprocessor(&per_cu, (const void*)mega, NTHREADS, LDS_BYTES) != hipSuccess || per_cu < 1) { fprintf(stderr, "kernel_launch: occupancy query says %d blocks per CU\n", per_cu); per_cu = 1; }
        (void)hipGetLastError();
        grid = cus;
        if (grid != 256) fprintf(stderr, "kernel_launch: %d CUs; the router / permute phases assume a 256-workgroup grid\n", grid);
    }
    if (grid < 0) return;
    Params p{};
    p.x = (const float*)d_in[0]; p.pos = (const int*)d_in[1]; p.norm1_g = (const float*)d_in[2]; p.w_in = (const float*)d_in[3]; p.q_norm_g = (const float*)d_in[4];
    p.k_norm_g = (const float*)d_in[5]; p.idx_g = (const float*)d_in[6]; p.idx_b = (const float*)d_in[7]; p.w_a = (const float*)d_in[8]; p.pool_mix = (const float*)d_in[9];
    p.pool_scale = (const float*)d_in[10]; p.w_b = (const float*)d_in[11]; p.w_out = (const float*)d_in[12]; p.norm2_g = (const float*)d_in[13]; p.router_w = (const float*)d_in[14];
    p.router_b = (const float*)d_in[15]; p.w_gu = (const float*)d_in[16]; p.b_gu = (const float*)d_in[17]; p.w_d = (const float*)d_in[18]; p.b_d = (const float*)d_in[19];
    p.out = (float*)d_out; p.ws = (unsigned char*)d_ws;
#if MK_MODE == 0
    p.ph_lo = 0; p.ph_hi = NPH;
    void* args[] = {&p};
    hipError_t e = hipLaunchCooperativeKernel((const void*)mega, dim3(grid), dim3(NTHREADS), args, LDS_BYTES, stream);
    if (e != hipSuccess) fprintf(stderr, "kernel_launch: cooperative launch failed: %s (grid %d)\n", hipGetErrorString(e), grid);
#else
    for (int k = 0; k < NPH; ++k) { p.ph_lo = k; p.ph_hi = k + 1; hipLaunchKernelGGL(mega, dim3(grid), dim3(NTHREADS), LDS_BYTES, stream, p); }
#endif
}
```

```cpp
#include <hip/hip_runtime.h>
#include <hip/hip_cooperative_groups.h>
#include <cstdio>
#include <cstdint>
#include <cmath>
namespace cg = cooperative_groups;

#ifndef TS_PHASE
#define TS_PHASE (-1)
#endif
#ifndef MK_MODE
#define MK_MODE 0
#endif

#define LAS __attribute__((address_space(3)))
#define GAS __attribute__((address_space(1)))
typedef unsigned short bf16_t;
typedef short bf16x8 __attribute__((ext_vector_type(8)));
typedef float f32x2 __attribute__((ext_vector_type(2)));
typedef float f32x4 __attribute__((ext_vector_type(4)));
typedef float f32x16 __attribute__((ext_vector_type(16)));
typedef unsigned u32x2 __attribute__((ext_vector_type(2)));
typedef unsigned u32x4 __attribute__((ext_vector_type(4)));

constexpr int D = 1024, NBATCH = 8, SEQ = 4096, NTOK = NBATCH * SEQ;
constexpr int NEXP = 32, TOPK = 4;
constexpr int INW = 3652, INWP = 3840;
constexpr int NSLOT = 139264;
constexpr float NORM_EPS = 1e-6f;
constexpr float MOE_WSCALE = 64.0f, MOE_WINV = 1.0f / 64.0f;
constexpr float Y_SCALE = 16.0f;
constexpr int NWAVES = 8, NTHREADS = 512;
constexpr int LDS_BYTES = 147456;
constexpr int RING_BYTES = 131072;
constexpr int MISC_OFF = 135168;

constexpr size_t MiB = 1u << 20;
constexpr size_t WS_CTL = 0;
constexpr size_t WS_BCNT = 64 * 1024;
constexpr size_t WS_WCNT = 128 * 1024;
constexpr size_t WS_CS = 2 * MiB;
constexpr size_t WS_WIN = 16 * MiB;
constexpr size_t WS_WCAT = 24 * MiB;
constexpr size_t WS_WOUT = 26 * MiB;
constexpr size_t WS_WGU = 28 * MiB;
constexpr size_t WS_WD = 156 * MiB;
constexpr size_t WS_REC_E = 220 * MiB;
constexpr size_t WS_REC_POS = 221 * MiB;
constexpr size_t WS_REC_GATE = 222 * MiB;
constexpr size_t WS_SLOT_OF = 223 * MiB;
constexpr size_t WS_SLOT_GATE = 223 * MiB + 512 * 1024;
constexpr size_t WS_XN = 226 * MiB;
constexpr size_t WS_Q = 290 * MiB;
constexpr size_t WS_K = 322 * MiB;
constexpr size_t WS_VT = 330 * MiB;
constexpr size_t WS_QI = 338 * MiB;
constexpr size_t WS_KI = 354 * MiB;
constexpr size_t WS_WI = 358 * MiB;
constexpr size_t WS_POOL = 360 * MiB;
constexpr size_t WS_GA = 392 * MiB;
constexpr size_t WS_GP = 456 * MiB;
constexpr size_t WS_ACAT = 520 * MiB;
constexpr size_t WS_TA = 584 * MiB;
constexpr size_t WS_MASK = WS_TA;
constexpr size_t WS_MERGED = 648 * MiB;
constexpr size_t WS_H2 = WS_XN;
constexpr size_t WS_H2S = 290 * MiB;
constexpr size_t WS_Y = WS_H2S;
constexpr size_t WS_ACT = 562 * MiB;
constexpr size_t WS_END = 834 * MiB;
static_assert(WS_SLOT_GATE + (size_t)NSLOT * 4 <= WS_XN, "ws map");

__device__ __forceinline__ unsigned cvt_pk_bf16(float lo, float hi) { unsigned r; asm volatile("v_cvt_pk_bf16_f32 %0, %1, %2" : "=v"(r) : "v"(lo), "v"(hi)); return r; }
__device__ __forceinline__ unsigned pk4_fp8(float a, float b, float c, float d) { int w = __builtin_amdgcn_cvt_pk_fp8_f32(a, b, 0, false); w = __builtin_amdgcn_cvt_pk_fp8_f32(c, d, w, true); return (unsigned)w; }
__device__ __forceinline__ float bf_lo(unsigned w) { return __uint_as_float(w << 16); }
__device__ __forceinline__ float bf_hi(unsigned w) { return __uint_as_float(w & 0xffff0000u); }
__device__ __forceinline__ float wave_sum(float v) {
#pragma unroll
    for (int o = 1; o < 64; o <<= 1) v += __shfl_xor(v, o);
    return v;
}
__device__ __forceinline__ float sigmoidf_(float x) { return __builtin_amdgcn_rcpf(1.0f + __builtin_amdgcn_exp2f(-1.4426950408889634f * x)); }
#define LDS_WAIT() asm volatile("s_waitcnt lgkmcnt(0)" ::: "memory")

__host__ __device__ __forceinline__ int idx_bj_j(int d, int& bj) {
    int j;
    if (d < 16) { bj = 0; j = d; } else if (d < 32) { bj = 1; j = d - 16; } else if (d < 48) { bj = 0; j = d - 16; } else { bj = 1; j = d - 32; }
    return j;
}
__host__ __device__ __forceinline__ int win_phys(int n) {
    if (n < 512) { const int h = n >> 6, d = n & 63; return 256 * (h >> 2) + 128 * (d >> 5) + 32 * (h & 3) + (d & 31); }
    if (n < 768) { const int h = (n - 512) >> 6, d = n & 63; return 512 + 128 * (d >> 5) + 32 * h + (d & 31); }
    if (n < 1024) { const int h = (n - 768) >> 6, d = n & 63; int bj; const int j = idx_bj_j(d, bj); return 768 + 128 * bj + 32 * h + j; }
    if (n < 1088) { const int d = n - 1024; int bj; const int j = idx_bj_j(d, bj); return 1024 + 128 * bj + j; }
    if (n < 1092) return 1024 + 32 + (n - 1088);
    if (n < 1604) return 1280 + (n - 1092);
    if (n < 2628) return 1792 + (n - 1604);
    return 2816 + (n - 2628);
}

namespace pg8 {
constexpr int BM = 256, BK = 64, HALF = 128, HTB = HALF * BK * 2, STAGE_BYTES = 8 * HTB, NXCD = 8, WGM = 8;
__host__ __device__ __forceinline__ int lds_byte(int r, int c) { const int st = (r >> 4) * 2 + (c >> 5), rr = r & 15, cc = c & 31, ob = rr * 64 + cc * 2; return st * 1024 + (ob ^ (((ob >> 9) & 1) << 5)); }
__host__ __device__ __forceinline__ void stage_rc(int b, int& R, int& C) { const int st = b / 1024, sb = b % 1024, swz = sb ^ (((sb >> 9) & 1) << 5); R = (st >> 1) * 16 + swz / 64; C = (st & 1) * 32 + (swz % 64) / 2; }
__host__ __device__ __forceinline__ int perm32(int rho) { const int n = rho >> 4, i = rho & 15; return 8 * (i >> 2) + 4 * n + (i & 3); }

struct Unit { int pm, pn; };
struct Gemm { const bf16_t* A; const bf16_t* Bt; int M, N, K; };

struct StaticOrder {
    int nM, nN, nwg, G, c;
    __device__ void init(int M, int N, int G_, int c_) { nM = M / BM; nN = N / BM; nwg = nM * nN; G = G_; c = c_; }
    __device__ bool next(int i, Unit& u) const {
        const long L = (long)i * G + c; if (L >= nwg) return false;
        int wgid = (int)L; { const int q = nwg / NXCD, r = nwg % NXCD, xcd = wgid % NXCD, off = wgid / NXCD; wgid = (xcd < r ? xcd * (q + 1) : r * (q + 1) + (xcd - r) * q) + off; }
        const int nig = WGM * nN, gid = wgid / nig, fm = gid * WGM, gsz = (nM - fm) < WGM ? (nM - fm) : WGM;
        u.pm = fm + ((wgid % nig) % gsz); u.pn = (wgid % nig) / gsz; return true;
    }
};
template <int NPN> struct MoeOrder {
    const LAS int* tstart; int G, c;
    __device__ bool next(int i, Unit& u) const {
        const int x = c & 7, lc = c >> 3, ng = G >> 3;
        int U = i * ng + lc;
#pragma unroll
        for (int k = 0; k < NEXP / 8; ++k) {
            const int e = x + 8 * k; const int t0 = __builtin_amdgcn_readfirstlane(tstart[e]), t1 = __builtin_amdgcn_readfirstlane(tstart[e + 1]);
            const int nu = (t1 - t0) * NPN;
            if (U < nu) { u.pm = t0 + U / NPN; u.pn = e * NPN + U % NPN; return true; }
            U -= nu;
        }
        return false;
    }
};

typedef int i32x8 __attribute__((ext_vector_type(8)));
__device__ __forceinline__ i32x8 pk32(bf16x8 a, bf16x8 b) { typedef int i32x4 __attribute__((ext_vector_type(4))); const i32x4 x = __builtin_bit_cast(i32x4, a), y = __builtin_bit_cast(i32x4, b); return __builtin_shufflevector(x, y, 0, 1, 2, 3, 4, 5, 6, 7); }
__device__ __forceinline__ void mfma_f8_inplace(f32x4& acc, i32x8 a, i32x8 b, int one) {
    asm volatile("v_mfma_scale_f32_16x16x128_f8f6f4 %0, %1, %2, %0, %3, %3 op_sel_hi:[0,0,0]" : "+v"(acc) : "v"(a), "v"(b), "v"(one));
}
template <class Epi, class Sched, bool F8 = false>
__device__ __forceinline__ void gemm_phase(LAS unsigned char* lds, const Gemm g, const Sched& S, const Epi& E) {
    const int tid = threadIdx.x, wid = __builtin_amdgcn_readfirstlane(tid >> 6), lane = tid & 63, wr = wid >> 2, wc = wid & 3, fr = lane & 15, fq = lane >> 4;
    constexpr int ES = F8 ? 1 : 2;
    const int K = g.K, RB = K * ES, nt = RB / 128;
    unsigned voffA[2], voffB[2];
    { int R, C; stage_rc(tid * 16, R, C); const int Rb = (R & ~31) + perm32(R & 31);
        voffA[0] = (unsigned)(R * RB + C * 2); voffB[0] = (unsigned)(Rb * RB + C * 2); voffA[1] = 64u * (unsigned)RB; voffB[1] = 64u * (unsigned)RB; }
    const size_t kstep = (size_t)(BK * 2);
    const size_t hstep = (size_t)HALF * RB;
    const size_t tstep = 2 * hstep;
    const unsigned ldsw = (unsigned)wid * 1024u;
    const int aoff = lds_byte(wr * 64 + fr, F8 ? fq * 16 : fq * 8), boff = lds_byte(wc * 32 + fr, F8 ? fq * 16 : fq * 8);
    constexpr int PSTEP = F8 ? 16 : 1024;
#define PG8_SA(b, h) (((b) * 2 + (h)) * HTB)
#define PG8_SB(b, h) ((4 + (b) * 2 + (h)) * HTB)
#define PG8_STAGE(bufoff, gbase, voff) do { _Pragma("unroll") for (int _i = 0; _i < 2; ++_i) \
        __builtin_amdgcn_global_load_lds((const unsigned*)((const char*)(gbase) + (size_t)(_i ? (voff)[1] : 0u) + (voff)[0]), (LAS unsigned*)(lds + (bufoff) + ldsw + _i * 8192), 16, 0, 0); } while (0)
#define PG8_LDA(dst, b, h) do { _Pragma("unroll") for (int m = 0; m < 4; ++m) _Pragma("unroll") for (int k = 0; k < 2; ++k) dst[m][k] = *(const LAS bf16x8*)(lds + PG8_SA(b, h) + aoff + m * 2048 + k * PSTEP); } while (0)
#define PG8_LDB(dst, b, h) do { _Pragma("unroll") for (int n = 0; n < 2; ++n) _Pragma("unroll") for (int k = 0; k < 2; ++k) dst[n][k] = *(const LAS bf16x8*)(lds + PG8_SB(b, h) + boff + n * 2048 + k * PSTEP); } while (0)
#define PG8_MMA(ai, bj, At, Bt) do { __builtin_amdgcn_s_setprio(1); \
        if constexpr (F8) { _Pragma("unroll") for (int m = 0; m < 4; ++m) _Pragma("unroll") for (int n = 0; n < 2; ++n) \
            mfma_f8_inplace(acc[ai][bj][m][n], pk32(Bt[n][0], Bt[n][1]), pk32(At[m][0], At[m][1]), one_scale); \
            asm volatile("s_nop 15\n\ts_nop 15" ::: ); } \
        else { _Pragma("unroll") for (int m = 0; m < 4; ++m) _Pragma("unroll") for (int n = 0; n < 2; ++n) _Pragma("unroll") for (int k = 0; k < 2; ++k) \
            acc[ai][bj][m][n] = __builtin_amdgcn_mfma_f32_16x16x32_bf16(Bt[n][k], At[m][k], acc[ai][bj][m][n], 0, 0, 0); } \
        __builtin_amdgcn_s_setprio(0); } while (0)
#define PG8_WAIT_V(n) asm volatile("s_waitcnt vmcnt(" #n ")" ::: "memory")
#define PG8_WAIT_L(n) asm volatile("s_waitcnt lgkmcnt(" #n ")" ::: "memory")
#define PG8_BAR __builtin_amdgcn_s_barrier()
#define PG8_SCHED __builtin_amdgcn_sched_barrier(0)
    int one_scale = 0x7F7F7F7F; asm volatile("" : "+v"(one_scale));
    Unit cur, nxt; int ui = 0;
    if (!S.next(0, cur)) return;
    cur.pm = __builtin_amdgcn_readfirstlane(cur.pm); cur.pn = __builtin_amdgcn_readfirstlane(cur.pn);
    f32x4 acc[2][2][4][2];
#pragma unroll
    for (int a = 0; a < 2; ++a)
#pragma unroll
        for (int b = 0; b < 2; ++b)
#pragma unroll
            for (int m = 0; m < 4; ++m)
#pragma unroll
                for (int n = 0; n < 2; ++n) acc[a][b][m][n] = (f32x4){0.f, 0.f, 0.f, 0.f};
    bf16x8 At[4][2], B0[2][2], B1[2][2];
    const char* cA = (const char*)g.A + (size_t)cur.pm * tstep; const char* cB = (const char*)g.Bt + (size_t)cur.pn * tstep;
    PG8_STAGE(PG8_SB(0, 0), cB, voffB); PG8_STAGE(PG8_SB(0, 1), cB + hstep, voffB); PG8_STAGE(PG8_SA(0, 0), cA, voffA); PG8_STAGE(PG8_SA(0, 1), cA + hstep, voffA);
    if (wr == 1) PG8_BAR;
    PG8_WAIT_V(2); PG8_BAR;
    PG8_STAGE(PG8_SB(1, 0), cB + kstep, voffB); PG8_STAGE(PG8_SA(1, 0), cA + kstep, voffA); PG8_STAGE(PG8_SB(1, 1), cB + hstep + kstep, voffB);
    PG8_WAIT_V(6); PG8_BAR;
    for (;;) {
        const bool has_next = S.next(ui + 1, nxt); nxt.pm = __builtin_amdgcn_readfirstlane(nxt.pm); nxt.pn = __builtin_amdgcn_readfirstlane(nxt.pn);
        const char* nA = has_next ? (const char*)g.A + (size_t)nxt.pm * tstep : cA; const char* nB = has_next ? (const char*)g.Bt + (size_t)nxt.pn * tstep : cB;
#pragma unroll 1
        for (int t = 0; t < nt; t += 2) {
            const bool last = (t == nt - 2);
            const char* a1 = cA + (size_t)(t + 1) * kstep;
            const char* a2 = last ? nA : cA + (size_t)(t + 2) * kstep; const char* b2 = last ? nB : cB + (size_t)(t + 2) * kstep;
            const char* a3 = a2 + kstep; const char* b3 = b2 + kstep;
            PG8_LDB(B0, 0, 0); PG8_LDB(B1, 0, 1); PG8_SCHED; PG8_LDA(At, 0, 0); PG8_STAGE(PG8_SA(1, 1), a1 + hstep, voffA);
            PG8_WAIT_V(8); PG8_WAIT_L(0); PG8_BAR; PG8_MMA(0, 0, At, B0); PG8_MMA(0, 1, At, B1); PG8_BAR; PG8_SCHED;
            PG8_LDA(At, 0, 1); PG8_STAGE(PG8_SB(0, 0), b2, voffB); PG8_STAGE(PG8_SB(0, 1), b2 + hstep, voffB); PG8_STAGE(PG8_SA(0, 0), a2, voffA);
            PG8_WAIT_V(8); PG8_WAIT_L(0); PG8_BAR; PG8_MMA(1, 0, At, B0); PG8_MMA(1, 1, At, B1); PG8_BAR; PG8_SCHED;
            PG8_LDB(B0, 1, 0); PG8_LDB(B1, 1, 1); PG8_SCHED; PG8_LDA(At, 1, 0); PG8_STAGE(PG8_SA(0, 1), a2 + hstep, voffA);
            PG8_WAIT_V(8); PG8_WAIT_L(0); PG8_BAR; PG8_MMA(0, 0, At, B0); PG8_MMA(0, 1, At, B1); PG8_BAR; PG8_SCHED;
            PG8_LDA(At, 1, 1); PG8_STAGE(PG8_SB(1, 0), b3, voffB); PG8_STAGE(PG8_SB(1, 1), b3 + hstep, voffB); PG8_STAGE(PG8_SA(1, 0), a3, voffA);
            PG8_WAIT_V(8); PG8_WAIT_L(0); PG8_BAR; PG8_MMA(1, 0, At, B0); PG8_MMA(1, 1, At, B1); PG8_BAR; PG8_SCHED;
            if constexpr (Epi::MIDK) { if (t == nt / 2 - 2) E.mid(acc, cur, wr, wc, fr, fq); }
        }
        if (wr == 0) PG8_BAR;
        E(acc, cur, wr, wc, fr, fq);
        if (!has_next) break;
#pragma unroll
        for (int a = 0; a < 2; ++a)
#pragma unroll
            for (int b = 0; b < 2; ++b)
#pragma unroll
                for (int m = 0; m < 4; ++m)
#pragma unroll
                    for (int n = 0; n < 2; ++n) acc[a][b][m][n] = (f32x4){0.f, 0.f, 0.f, 0.f};
        cur = nxt; cA = nA; cB = nB; ++ui;
        if (wr == 1) PG8_BAR;
    }
    PG8_WAIT_V(0);
    PG8_BAR;
#undef PG8_SA
#undef PG8_SB
#undef PG8_STAGE
#undef PG8_LDA
#undef PG8_LDB
#undef PG8_MMA
#undef PG8_WAIT_V
#undef PG8_WAIT_L
#undef PG8_BAR
#undef PG8_SCHED
}
}

struct Params {
    const float* x; const int* pos; const float* norm1_g; const float* w_in; const float* q_norm_g; const float* k_norm_g;
    const float* idx_g; const float* idx_b; const float* w_a; const float* pool_mix; const float* pool_scale; const float* w_b;
    const float* w_out; const float* norm2_g; const float* router_w; const float* router_b; const float* w_gu; const float* b_gu;
    const float* w_d; const float* b_d;
    float* out; unsigned char* ws; int ph_lo, ph_hi;
};

using pg8::Unit; using pg8::HALF;
__device__ __forceinline__ void st8(bf16_t* p, const float (&v)[8]) {
    u32x4 w; w.x = cvt_pk_bf16(v[0], v[1]); w.y = cvt_pk_bf16(v[2], v[3]); w.z = cvt_pk_bf16(v[4], v[5]); w.w = cvt_pk_bf16(v[6], v[7]); *(u32x4*)p = w;
}
__device__ __forceinline__ void ld8f(const float* p, float (&v)[8]) { const f32x4 a = *(const f32x4*)p, b = *(const f32x4*)(p + 4); v[0]=a[0]; v[1]=a[1]; v[2]=a[2]; v[3]=a[3]; v[4]=b[0]; v[5]=b[1]; v[6]=b[2]; v[7]=b[3]; }
__device__ __forceinline__ void ld8bf(const bf16_t* p, float (&v)[8]) { const u32x4 w = *(const u32x4*)p; v[0]=bf_lo(w.x); v[1]=bf_hi(w.x); v[2]=bf_lo(w.y); v[3]=bf_hi(w.y); v[4]=bf_lo(w.z); v[5]=bf_hi(w.z); v[6]=bf_lo(w.w); v[7]=bf_hi(w.w); }

struct EpiInProj {
    static constexpr bool MIDK = false;
    bf16_t *Q, *Kb, *Vb, *Qi, *Ki, *Pool, *Ga, *Gp; float* Wi; const float* cs; const float *gq, *gk, *lng, *lnb;
    __device__ __forceinline__ void operator()(const f32x4 (&acc)[2][2][4][2], const Unit& u, int wr, int wc, int fr, int fq) const {
        const int pn = u.pn;
#pragma unroll
        for (int ai = 0; ai < 2; ++ai)
#pragma unroll
            for (int m = 0; m < 4; ++m) {
                const int row = u.pm * 256 + ai * HALF + wr * 64 + m * 16 + fr;
                float v0[8], v1[8];
#pragma unroll
                for (int n = 0; n < 2; ++n)
#pragma unroll
                    for (int i = 0; i < 4; ++i) { v0[4 * n + i] = acc[ai][0][m][n][i]; v1[4 * n + i] = acc[ai][1][m][n][i]; }
                if (pn <= 1 || (pn == 2 && wc < 2)) {
                    float ss = 0.f;
#pragma unroll
                    for (int j = 0; j < 8; ++j) ss += v0[j] * v0[j] + v1[j] * v1[j];
                    ss += __shfl_xor(ss, 16); ss += __shfl_xor(ss, 32);
                    const float rs = 1.0f / sqrtf(ss * (1.0f / 64.0f) + NORM_EPS);
                    const float* gg = (pn <= 1) ? gq : gk; const float sc = (pn <= 1) ? 0.18033688011112042f : 1.0f;
                    float g0[8], g1[8], cc[8], sn[8];
                    ld8f(gg + 8 * fq, g0); ld8f(gg + 32 + 8 * fq, g1);
                    ld8f(cs + (size_t)row * 96 + 8 * fq, cc); ld8f(cs + (size_t)row * 96 + 48 + 8 * fq, sn);
                    float o0[8], o1[8];
#pragma unroll
                    for (int j = 0; j < 8; ++j) { const float x1 = v0[j] * rs * g0[j], x2 = v1[j] * rs * g1[j]; o0[j] = (x1 * cc[j] - x2 * sn[j]) * sc; o1[j] = (x2 * cc[j] + x1 * sn[j]) * sc; }
                    if (pn <= 1) { bf16_t* dst = Q + (size_t)row * 512 + (4 * pn + wc) * 64; st8(dst + 8 * fq, o0); st8(dst + 32 + 8 * fq, o1); }
                    else {
                        bf16_t* dst = Kb + ((((size_t)((row >> 12) * 2 + wc) * 128 + ((row & 4095) >> 5)) * 4 + (fq >> 1)) * 64 + ((fq & 1) * 32 + (row & 31))) * 8;
                        st8(dst, o0); st8(dst + 2 * 512, o1); }
                } else if (pn == 2) {
                    const int t = row & 4095, kk = t & 31;
                    bf16_t* dst = Vb + (((size_t)((row >> 12) * 2 + (wc - 2)) * 128 + (t >> 5)) * 4 + (kk >> 4)) * 512 + (((kk >> 2) & 1) * 32 + 8 * fq) * 8 + 4 * ((kk >> 3) & 1) + (kk & 3);
#pragma unroll
                    for (int j = 0; j < 8; ++j) { dst[j * 8] = (bf16_t)(cvt_pk_bf16(v0[j], v0[j]) & 0xffffu); dst[2 * 512 + j * 8] = (bf16_t)(cvt_pk_bf16(v1[j], v1[j]) & 0xffffu); }
                } else if (pn == 3 || (pn == 4 && wc == 0)) {
                    if (pn == 4) {
                        float s = 0.f;
#pragma unroll
                        for (int j = 0; j < 8; ++j) s += v0[j] + v1[j];
                        s += __shfl_xor(s, 16); s += __shfl_xor(s, 32);
                        const float mu = s * (1.0f / 64.0f); float q = 0.f;
#pragma unroll
                        for (int j = 0; j < 8; ++j) { v0[j] -= mu; v1[j] -= mu; q += v0[j] * v0[j] + v1[j] * v1[j]; }
                        q += __shfl_xor(q, 16); q += __shfl_xor(q, 32);
                        const float rs = 1.0f / sqrtf(q * (1.0f / 64.0f) + NORM_EPS);
                        const int d0 = (fq < 2) ? 8 * fq : 8 * fq + 16, d1 = (fq < 2) ? 16 + 8 * fq : 8 * fq + 32;
                        float a0[8], a1[8], b0[8], b1[8];
                        ld8f(lng + d0, a0); ld8f(lng + d1, a1); ld8f(lnb + d0, b0); ld8f(lnb + d1, b1);
#pragma unroll
                        for (int j = 0; j < 8; ++j) { v0[j] = v0[j] * rs * a0[j] + b0[j]; v1[j] = v1[j] * rs * a1[j] + b1[j]; }
                    }
                    bf16_t* dst = Qi + (size_t)row * 256 + wc * 64;
                    bf16_t* kdst = Ki + (((size_t)(row >> 12) * 128 + ((row & 4095) >> 5)) * 4 * 64 + (row & 31)) * 8;
                    if (fq < 2) {
                        float cc[8], sn[8];
                        ld8f(cs + (size_t)row * 96 + 32 + 8 * fq, cc); ld8f(cs + (size_t)row * 96 + 48 + 32 + 8 * fq, sn);
                        float o0[8], o1[8];
#pragma unroll
                        for (int j = 0; j < 8; ++j) { o0[j] = v0[j] * cc[j] - v1[j] * sn[j]; o1[j] = v1[j] * cc[j] + v0[j] * sn[j]; }
                        if (pn == 3) { st8(dst + 8 * fq, o0); st8(dst + 16 + 8 * fq, o1); }
                        else { st8(kdst + (fq * 32) * 8, o0); st8(kdst + (64 + fq * 32) * 8, o1); }
                    } else {
                        if (pn == 3) { st8(dst + 8 * fq + 16, v0); st8(dst + 8 * fq + 32, v1); }
                        else { st8(kdst + (2 * 64 + (fq - 2) * 32) * 8, v0); st8(kdst + (3 * 64 + (fq - 2) * 32) * 8, v1); } }
                } else if (pn == 4) {
                    if (wc == 1 && fq == 0) *(f32x4*)(Wi + (size_t)row * 4) = (f32x4){v0[0] * 0.0625f, v0[1] * 0.0625f, v0[2] * 0.0625f, v0[3] * 0.0625f};
                } else if (pn <= 6) {
                    bf16_t* dst = Pool + (size_t)row * 512 + (pn - 5) * 256 + wc * 32 + 8 * fq;
                    st8(dst, v0); st8(dst + HALF, v1);
                } else {
                    bf16_t* dst = ((pn <= 10) ? Ga + (size_t)row * 1024 + (pn - 7) * 256 : Gp + (size_t)row * 1024 + (pn - 11) * 256) + wc * 32 + 8 * fq;
#pragma unroll
                    for (int j = 0; j < 8; ++j) { v0[j] = sigmoidf_(v0[j]); v1[j] = sigmoidf_(v1[j]); }
                    st8(dst, v0); st8(dst + HALF, v1);
                }
            }
    }
};

struct EpiGated {
    static constexpr bool MIDK = true;
    const bf16_t* Ga; const bf16_t* Gp; bf16_t* O;
    __device__ __forceinline__ void mid(f32x4 (&acc)[2][2][4][2], const Unit& u, int wr, int wc, int fr, int fq) const {
        asm volatile("" : "+v"(fr), "+v"(fq));
#pragma unroll
        for (int ai = 0; ai < 2; ++ai)
#pragma unroll
            for (int m = 0; m < 4; ++m) {
                const size_t off = (size_t)(u.pm * 256 + ai * HALF + wr * 64 + m * 16 + fr) * 1024 + u.pn * 256 + wc * 32 + 8 * fq;
#pragma unroll
                for (int bj = 0; bj < 2; ++bj) {
                    float ga[8], gp[8]; ld8bf(Ga + off + bj * HALF, ga); ld8bf(Gp + off + bj * HALF, gp);
#pragma unroll
                    for (int n = 0; n < 2; ++n)
#pragma unroll
                        for (int i = 0; i < 4; ++i) acc[ai][bj][m][n][i] *= ga[4 * n + i] * __builtin_amdgcn_rcpf(fmaxf(gp[4 * n + i], 1e-30f));
                }
                if (m & 1) asm volatile("" ::: "memory");
            }
    }
    __device__ __forceinline__ void operator()(const f32x4 (&acc)[2][2][4][2], const Unit& u, int wr, int wc, int fr, int fq) const {
        asm volatile("" : "+v"(fr), "+v"(fq));
#pragma unroll
        for (int ai = 0; ai < 2; ++ai)
#pragma unroll
            for (int m = 0; m < 4; ++m) {
                const size_t off = (size_t)(u.pm * 256 + ai * HALF + wr * 64 + m * 16 + fr) * 1024 + u.pn * 256 + wc * 32 + 8 * fq;
#pragma unroll
                for (int bj = 0; bj < 2; ++bj) {
                    float g[8], o[8]; ld8bf(Gp + off + bj * HALF, g);
#pragma unroll
                    for (int n = 0; n < 2; ++n)
#pragma unroll
                        for (int i = 0; i < 4; ++i) o[4 * n + i] = g[4 * n + i] * acc[ai][bj][m][n][i];
                    st8(O + off + bj * HALF, o);
                }
            }
    }
};
struct EpiResid {
    static constexpr bool MIDK = false;
    const float* X; float* O;
    __device__ __forceinline__ void operator()(const f32x4 (&acc)[2][2][4][2], const Unit& u, int wr, int wc, int fr, int fq) const {
#pragma unroll
        for (int ai = 0; ai < 2; ++ai)
#pragma unroll
            for (int m = 0; m < 4; ++m) {
                const size_t off = (size_t)(u.pm * 256 + ai * HALF + wr * 64 + m * 16 + fr) * 1024 + u.pn * 256 + wc * 32 + 8 * fq;
#pragma unroll
                for (int bj = 0; bj < 2; ++bj)
#pragma unroll
                    for (int n = 0; n < 2; ++n) { const size_t o = off + bj * HALF + 4 * n; *(f32x4*)(O + o) = *(const f32x4*)(X + o) + acc[ai][bj][m][n]; }
            }
    }
};
struct EpiGateUp {
    static constexpr bool MIDK = false;
    const float* bias; unsigned char* Act;
    __device__ __forceinline__ void operator()(const f32x4 (&acc)[2][2][4][2], const Unit& u, int wr, int wc, int fr, int fq) const {
        { int t_ = threadIdx.x; asm volatile("" : "+v"(t_)); fr = t_ & 15; fq = (t_ >> 4) & 3; }
        const int e = u.pn >> 3, pnl = u.pn & 7, col = pnl * 128 + wc * 32 + 8 * fq;
        float bg[8], bu[8]; ld8f(bias + (size_t)e * 2048 + col, bg); ld8f(bias + (size_t)e * 2048 + 1024 + col, bu);
#pragma unroll
        for (int ai = 0; ai < 2; ++ai)
#pragma unroll
            for (int m = 0; m < 4; ++m) {
                const size_t row = (size_t)(u.pm * 256 + ai * HALF + wr * 64 + m * 16 + fr);
                float o[8];
#pragma unroll
                for (int n = 0; n < 2; ++n)
#pragma unroll
                    for (int i = 0; i < 4; ++i) { const int j = 4 * n + i;
                        const float gt = fminf(acc[ai][0][m][n][i] * MOE_WINV + bg[j], 7.0f), up = fminf(fmaxf(acc[ai][1][m][n][i] * MOE_WINV + bu[j], -7.0f), 7.0f);
                        o[j] = gt * __builtin_amdgcn_rcpf(1.0f + __builtin_amdgcn_exp2f(-2.4554669595930156f * gt)) * (up + 1.0f); }
                u32x2 w; w.x = pk4_fp8(o[0], o[1], o[2], o[3]); w.y = pk4_fp8(o[4], o[5], o[6], o[7]);
                *(u32x2*)(Act + row * 1024 + col) = w;
            }
    }
};
struct EpiDown {
    static constexpr bool MIDK = false;
    const float* bias; const float* sgate; unsigned char* Y;
    __device__ __forceinline__ void operator()(const f32x4 (&acc)[2][2][4][2], const Unit& u, int wr, int wc, int fr, int fq) const {
        { int t_ = threadIdx.x; asm volatile("" : "+v"(t_)); fr = t_ & 15; fq = (t_ >> 4) & 3; }
        const int e = u.pn >> 2, pnl = u.pn & 3, col = pnl * 256 + wc * 32 + 8 * fq;
        float b0[8], b1[8]; ld8f(bias + (size_t)e * 1024 + col, b0); ld8f(bias + (size_t)e * 1024 + col + HALF, b1);
#pragma unroll
        for (int ai = 0; ai < 2; ++ai)
#pragma unroll
            for (int m = 0; m < 4; ++m) {
                const size_t row = (size_t)(u.pm * 256 + ai * HALF + wr * 64 + m * 16 + fr);
                const float gt = sgate[row] * Y_SCALE;
                float o0[8], o1[8];
#pragma unroll
                for (int n = 0; n < 2; ++n)
#pragma unroll
                    for (int i = 0; i < 4; ++i) { const int j = 4 * n + i; o0[j] = (acc[ai][0][m][n][i] * MOE_WINV + b0[j]) * gt; o1[j] = (acc[ai][1][m][n][i] * MOE_WINV + b1[j]) * gt; }
                u32x2 w0, w1; w0.x = pk4_fp8(o0[0], o0[1], o0[2], o0[3]); w0.y = pk4_fp8(o0[4], o0[5], o0[6], o0[7]); w1.x = pk4_fp8(o1[0], o1[1], o1[2], o1[3]); w1.y = pk4_fp8(o1[4], o1[5], o1[6], o1[7]);
                *(u32x2*)(Y + row * 1024 + col) = w0; *(u32x2*)(Y + row * 1024 + col + HALF) = w1;
            }
    }
};

template <class RowMap>
__device__ __forceinline__ void cvt_item(const float* W, int K, int N, bf16_t* WT, LAS float* scr, int kb, int nb, int lane, const RowMap& rm, int ldt = 0) {
    if (ldt == 0) ldt = K;
    const int k0 = kb * 64, n0 = nb * 64, n4 = lane & 15, kr = lane >> 4, n = n0 + 4 * n4;
    f32x4 v[16];
#pragma unroll
    for (int i = 0; i < 16; ++i) v[i] = (n < N) ? *(const f32x4*)(W + (size_t)(k0 + 4 * i + kr) * N + n) : (f32x4){0.f, 0.f, 0.f, 0.f};
#pragma unroll
    for (int i = 0; i < 16; ++i) { LAS float* d = scr + (4 * i + kr) * 65 + 4 * n4; d[0] = v[i][0]; d[1] = v[i][1]; d[2] = v[i][2]; d[3] = v[i][3]; }
    LDS_WAIT(); asm volatile("" ::: "memory");
    const int c8 = lane & 7;
#pragma unroll
    for (int jj = 0; jj < 8; ++jj) { const int nn = (lane >> 3) + 8 * jj; const LAS float* s = scr + (8 * c8) * 65 + nn;
        if (n0 + nn < N) { u32x4 o; o.x = cvt_pk_bf16(s[0], s[65]); o.y = cvt_pk_bf16(s[2 * 65], s[3 * 65]); o.z = cvt_pk_bf16(s[4 * 65], s[5 * 65]); o.w = cvt_pk_bf16(s[6 * 65], s[7 * 65]);
            *(u32x4*)(WT + (size_t)rm(n0 + nn) * ldt + k0 + 8 * c8) = o; } }
    LDS_WAIT(); asm volatile("" ::: "memory");
}
template <class RowMap>
__device__ __forceinline__ void cvt_item_f8(const float* W, int K, int N, unsigned char* WT, LAS float* scr, int kb, int nb, int lane, const RowMap& rm, float scale) {
    const int k0 = kb * 64, n0 = nb * 64, n4 = lane & 15, kr = lane >> 4, n = n0 + 4 * n4;
    f32x4 v[16];
#pragma unroll
    for (int i = 0; i < 16; ++i) v[i] = *(const f32x4*)(W + (size_t)(k0 + 4 * i + kr) * N + n);
#pragma unroll
    for (int i = 0; i < 16; ++i) { LAS float* d = scr + (4 * i + kr) * 65 + 4 * n4; d[0] = v[i][0] * scale; d[1] = v[i][1] * scale; d[2] = v[i][2] * scale; d[3] = v[i][3] * scale; }
    LDS_WAIT(); asm volatile("" ::: "memory");
    const int c8 = lane & 7;
#pragma unroll
    for (int jj = 0; jj < 8; ++jj) { const int nn = (lane >> 3) + 8 * jj; const LAS float* sp = scr + (8 * c8) * 65 + nn;
        u32x2 o; o.x = pk4_fp8(sp[0], sp[65], sp[2 * 65], sp[3 * 65]); o.y = pk4_fp8(sp[4 * 65], sp[5 * 65], sp[6 * 65], sp[7 * 65]);
        *(u32x2*)(WT + (size_t)rm(n0 + nn) * K + k0 + 8 * c8) = o; }
    LDS_WAIT(); asm volatile("" ::: "memory");
}
struct RmIdent { int off; __device__ __forceinline__ int operator()(int n) const { return off + n; } };
struct RmWin { __device__ __forceinline__ int operator()(int n) const { return win_phys(n); } };
struct RmGu { int e; __device__ __forceinline__ int operator()(int n) const { return e * 2048 + 256 * ((n & 1023) >> 7) + 128 * (n >> 10) + (n & 127); } };

struct CvtItem { const float* W; int N, K, k0, n0, kind, e; };
__device__ __forceinline__ CvtItem cvt_decode(const Params& p, int it) {
    constexpr int I_GU = NEXP * 16 * 32, I_D = NEXP * 16 * 16, I_IN = 16 * 58, I_A = 8 * 16;
    CvtItem d; int r = it;
    if (r < I_GU) { const int e = r / 512, q = r % 512; d.W = p.w_gu + (size_t)e * 1024 * 2048; d.N = 2048; d.K = 1024; d.k0 = (q / 32) * 64; d.n0 = (q % 32) * 64; d.kind = 0; d.e = e; return d; } r -= I_GU;
    if (r < I_D) { const int e = r / 256, q = r % 256; d.W = p.w_d + (size_t)e * 1024 * 1024; d.N = 1024; d.K = 1024; d.k0 = (q / 16) * 64; d.n0 = (q % 16) * 64; d.kind = 1; d.e = e; return d; } r -= I_D;
    if (r < I_IN) { d.W = p.w_in; d.N = INW; d.K = 1024; d.k0 = (r / 58) * 64; d.n0 = (r % 58) * 64; d.kind = 2; d.e = 0; return d; } r -= I_IN;
    if (r < I_A) { d.W = p.w_a; d.N = 1024; d.K = 512; d.k0 = (r / 16) * 64; d.n0 = (r % 16) * 64; d.kind = 3; d.e = 0; return d; } r -= I_A;
    d.W = p.w_out; d.N = 1024; d.K = 1024; d.k0 = (r / 16) * 64; d.n0 = (r % 16) * 64; d.kind = 4; d.e = 0; return d;
}
__device__ __forceinline__ void cvt_load(const CvtItem& d, int lane, f32x4 (&v)[16]) {
    const int n = d.n0 + 4 * (lane & 15), kr = lane >> 4;
#pragma unroll
    for (int i = 0; i < 16; ++i) v[i] = (n < d.N) ? *(const f32x4*)(d.W + (size_t)(d.k0 + 4 * i + kr) * d.N + n) : (f32x4){0.f, 0.f, 0.f, 0.f};
}
__device__ __forceinline__ void cvt_finish(const CvtItem& d, unsigned char* ws, LAS float* scr, int lane, const f32x4 (&v)[16]) {
    const int n4 = lane & 15, kr = lane >> 4; const float sc = (d.kind < 2) ? MOE_WSCALE : 1.0f;
#pragma unroll
    for (int i = 0; i < 16; ++i) { LAS float* q = scr + (4 * i + kr) * 65 + 4 * n4; q[0] = v[i][0] * sc; q[1] = v[i][1] * sc; q[2] = v[i][2] * sc; q[3] = v[i][3] * sc; }
    LDS_WAIT(); asm volatile("" ::: "memory");
    const int c8 = lane & 7;
#pragma unroll
    for (int jj = 0; jj < 8; ++jj) { const int nn = (lane >> 3) + 8 * jj, n = d.n0 + nn; const LAS float* sp = scr + (8 * c8) * 65 + nn;
        if (n < d.N) {
            if (d.kind < 2) {
                const int prow = (d.kind == 0) ? d.e * 2048 + 256 * ((n & 1023) >> 7) + 128 * (n >> 10) + (n & 127) : d.e * 1024 + n;
                u32x2 o; o.x = pk4_fp8(sp[0], sp[65], sp[2 * 65], sp[3 * 65]); o.y = pk4_fp8(sp[4 * 65], sp[5 * 65], sp[6 * 65], sp[7 * 65]);
                *(u32x2*)(ws + (d.kind == 0 ? WS_WGU : WS_WD) + (size_t)prow * 1024 + d.k0 + 8 * c8) = o;
            } else {
                u32x4 o; o.x = cvt_pk_bf16(sp[0], sp[65]); o.y = cvt_pk_bf16(sp[2 * 65], sp[3 * 65]); o.z = cvt_pk_bf16(sp[4 * 65], sp[5 * 65]); o.w = cvt_pk_bf16(sp[6 * 65], sp[7 * 65]);
                bf16_t* dst = (d.kind == 2) ? (bf16_t*)(ws + WS_WIN) + (size_t)win_phys(n) * 1024 : (d.kind == 3) ? (bf16_t*)(ws + WS_WCAT) + (size_t)n * 1024 : (bf16_t*)(ws + WS_WOUT) + (size_t)n * 1024;
                *(u32x4*)(dst + d.k0 + 8 * c8) = o;
            }
        } }
    LDS_WAIT(); asm volatile("" ::: "memory");
}

__device__ __forceinline__ void phase0(const Params& p, LAS unsigned char* lds, int bid, int G) {
    const int tid = threadIdx.x, lane = tid & 63, wave = __builtin_amdgcn_readfirstlane(tid >> 6);
    const int gw = bid * NWAVES + wave, NGW = G * NWAVES;
    unsigned char* ws = p.ws;
    LAS float* scr = (LAS float*)(lds + wave * 16640);
    constexpr int NITEMS = NEXP * 16 * 32 + NEXP * 16 * 16 + 16 * 58 + 8 * 16 + 16 * 16;
    {
        f32x4 vA[16], vB[16];
        int it = gw;
        if (it < NITEMS) {
            CvtItem dA = cvt_decode(p, it), dB = dA; cvt_load(dA, lane, vA);
            for (;;) {
                const int i1 = it + NGW; if (i1 < NITEMS) { dB = cvt_decode(p, i1); cvt_load(dB, lane, vB); }
                cvt_finish(dA, ws, scr, lane, vA); if (i1 >= NITEMS) break;
                const int i2 = i1 + NGW; if (i2 < NITEMS) { dA = cvt_decode(p, i2); cvt_load(dA, lane, vA); }
                cvt_finish(dB, ws, scr, lane, vB); if (i2 >= NITEMS) break;
                it = i2;
            }
        }
    }
    for (int it = gw; it < 16 * 4 * 16; it += NGW) {
        const int nb = it & 15, g = (it >> 4) & 3, cb = it >> 6, n = nb * 64 + lane, c0 = cb * 8;
        float a[8];
#pragma unroll
        for (int q = 0; q < 8; ++q) a[q] = 0.f;
        const float* mix = p.pool_mix + (size_t)g * 128 * 128 + (size_t)c0 * 128;
        for (int d0 = 0; d0 < 128; d0 += 16) {
            float wb[16];
#pragma unroll
            for (int dd = 0; dd < 16; ++dd) wb[dd] = p.w_b[(size_t)(g * 128 + d0 + dd) * 1024 + n];
#pragma unroll
            for (int dd = 0; dd < 16; ++dd) { const float w = p.pool_scale[g * 128 + d0 + dd] * wb[dd];
#pragma unroll
                for (int q = 0; q < 8; ++q) a[q] += mix[q * 128 + d0 + dd] * w; }
        }
        st8((bf16_t*)(ws + WS_WCAT) + (size_t)n * 1024 + 512 + g * 128 + c0, a);
    }
    {
        f32x4 gv[4];
#pragma unroll
        for (int j = 0; j < 4; ++j) gv[j] = *(const f32x4*)(p.norm1_g + 4 * lane + 256 * j);
        bf16_t* XN = (bf16_t*)(ws + WS_XN);
        for (int m0 = gw * 4; m0 < NTOK; m0 += NGW * 4) {
            f32x4 v[4][4];
#pragma unroll
            for (int r = 0; r < 4; ++r) { const f32x4* xr = (const f32x4*)(p.x + (size_t)(m0 + r) * D) + lane;
#pragma unroll
                for (int j = 0; j < 4; ++j) v[r][j] = xr[64 * j]; }
#pragma unroll
            for (int r = 0; r < 4; ++r) { float sq = 0.f;
#pragma unroll
                for (int j = 0; j < 4; ++j) sq += (v[r][j].x * v[r][j].x + v[r][j].y * v[r][j].y) + (v[r][j].z * v[r][j].z + v[r][j].w * v[r][j].w);
                const float rs = 1.0f / sqrtf(wave_sum(sq) * (1.0f / D) + NORM_EPS);
#pragma unroll
                for (int j = 0; j < 4; ++j) { const f32x4 o = v[r][j] * rs * gv[j]; u32x2 w; w.x = cvt_pk_bf16(o.x, o.y); w.y = cvt_pk_bf16(o.z, o.w); *(u32x2*)(XN + (size_t)(m0 + r) * D + 4 * lane + 256 * j) = w; } }
        }
    }
    {
        float* cs = (float*)(ws + WS_CS);
        for (int i = bid * NTHREADS + tid; i < NTOK * 48; i += G * NTHREADS) {
            const int row = i / 48, j = i % 48;
            const float ex = (j < 32) ? -(float)j / 32.0f : -(float)(j - 32) / 16.0f;
            const float ang = (float)p.pos[row] * powf(10000.0f, ex);
            float sn, cc; sincosf(ang, &sn, &cc);
            cs[(size_t)row * 96 + j] = cc; cs[(size_t)row * 96 + 48 + j] = sn;
        }
    }
}

__device__ __forceinline__ void pool_phase(const Params& p, int bid, int G) {
    const int tid = threadIdx.x, lane = tid & 63, wave = __builtin_amdgcn_readfirstlane(tid >> 6);
    const int gw = bid * NWAVES + wave, NGW = G * NWAVES;
    const bf16_t* Pool = (const bf16_t*)(p.ws + WS_POOL); bf16_t* Mixed = (bf16_t*)(p.ws + WS_ACAT) + 512;
    const int w = 2 << (lane >> 4);
    for (int it = gw; it < NBATCH * 256; it += NGW) {
        const int b = it >> 8, tb = (it & 255) * 16;
        const bf16_t* P = Pool + (size_t)b * SEQ * 512 + 8 * lane;
        float sum[8];
#pragma unroll
        for (int q = 0; q < 8; ++q) sum[q] = 0.f;
        for (int d = 1; d < 16; ++d) if (d < w && tb - d >= 0) { float v[8]; ld8bf(P + (size_t)(tb - d) * 512, v);
#pragma unroll
            for (int q = 0; q < 8; ++q) sum[q] += v[q]; }
        for (int t = tb; t < tb + 16; ++t) {
            float cur[8]; ld8bf(P + (size_t)t * 512, cur);
#pragma unroll
            for (int q = 0; q < 8; ++q) sum[q] += cur[q];
            const float inv = 1.0f / (float)((t + 1 < w) ? t + 1 : w);
            float o[8];
#pragma unroll
            for (int q = 0; q < 8; ++q) o[q] = sum[q] * inv - cur[q];
            st8(Mixed + ((size_t)b * SEQ + t) * 1024 + 8 * lane, o);
            if (t - w + 1 >= 0) { float old[8]; ld8bf(P + (size_t)(t - w + 1) * 512, old);
#pragma unroll
                for (int q = 0; q < 8; ++q) sum[q] -= old[q]; }
        }
    }
}

__device__ __forceinline__ int wave_sum_i(int v) {
    v += __builtin_amdgcn_update_dpp(0, v, 0xB1, 0xF, 0xF, true);
    v += __builtin_amdgcn_update_dpp(0, v, 0x4E, 0xF, 0xF, true);
    v += __builtin_amdgcn_update_dpp(0, v, 0x141, 0xF, 0xF, true);
    v += __builtin_amdgcn_update_dpp(0, v, 0x140, 0xF, 0xF, true);
    v += __builtin_amdgcn_update_dpp(0, v, 0x142, 0xA, 0xF, true);
    v += __builtin_amdgcn_update_dpp(0, v, 0x143, 0xC, 0xF, true);
    return __builtin_amdgcn_readlane(v, 63);
}
__device__ __forceinline__ int count_ge(const unsigned (&key)[64], int nj, unsigned mid) {
    unsigned a0 = 0u, a1 = 0u; int nproc = 0;
#pragma unroll
    for (int jb = 0; jb < 4; ++jb) if (jb * 8 < nj) { nproc += 8;
#pragma unroll
        for (int q = 0; q < 8; ++q) a0 = __builtin_amdgcn_alignbit(a0, key[jb * 8 + q] - mid, 31); }
#pragma unroll
    for (int jb = 4; jb < 8; ++jb) if (jb * 8 < nj) { nproc += 8;
#pragma unroll
        for (int q = 0; q < 8; ++q) a1 = __builtin_amdgcn_alignbit(a1, key[jb * 8 + q] - mid, 31); }
    const int lt = wave_sum_i(__builtin_popcount(a0) + __builtin_popcount(a1));
    return 64 * nproc - lt;
}
__device__ __forceinline__ int lane_prefix(unsigned long long m) { return __builtin_amdgcn_mbcnt_hi((unsigned)(m >> 32), __builtin_amdgcn_mbcnt_lo((unsigned)m, 0u)); }
__device__ __forceinline__ unsigned wave_umax(unsigned v) {
#pragma unroll
    for (int o = 1; o < 64; o <<= 1) { const unsigned t = (unsigned)__shfl_xor((int)v, o); v = t > v ? t : v; }
    return (unsigned)__builtin_amdgcn_readfirstlane((int)v);
}
__device__ __forceinline__ unsigned wave_umin(unsigned v) {
#pragma unroll
    for (int o = 1; o < 64; o <<= 1) { const unsigned t = (unsigned)__shfl_xor((int)v, o); v = t < v ? t : v; }
    return (unsigned)__builtin_amdgcn_readfirstlane((int)v);
}

__device__ __forceinline__ void select_unit(const Params& p, LAS unsigned char* lds, int b, int t0) {
    int tid = threadIdx.x; asm volatile("" : "+v"(tid));
    const int lane = tid & 63, wave = __builtin_amdgcn_readfirstlane(tid >> 6);
    unsigned char* wsq = p.ws; asm volatile("" : "+s"(wsq));
    const GAS bf16_t* Qi = (const GAS bf16_t*)(wsq + WS_QI); const GAS bf16_t* Ki = (const GAS bf16_t*)(wsq + WS_KI); const GAS float* Wi = (const GAS float*)(wsq + WS_WI);
    GAS unsigned* M32 = (GAS unsigned*)(wsq + WS_MASK);
    LAS float* SC = (LAS float*)lds;
    const int c = t0 >> 6, nj = c + 1, nk = 64 * nj, ntile = nk >> 5;
    const size_t tok0 = (size_t)b * SEQ + t0;
    {
        const int r = lane & 31, hh = lane >> 5;
        bf16x8 qa[4];
        const GAS bf16_t* qp = Qi + (tok0 + (r >> 2)) * 256 + (r & 3) * 64 + 8 * hh;
#pragma unroll
        for (int ks = 0; ks < 4; ++ks) qa[ks] = *(const GAS bf16x8*)(qp + 16 * ks);
        f32x4 wv[4];
#pragma unroll
        for (int g = 0; g < 4; ++g) wv[g] = *(const GAS f32x4*)(Wi + (tok0 + 2 * g + hh) * 4);
        const GAS bf16_t* kif = Ki + (size_t)b * 128 * 4 * 512 + lane * 8;
        bf16x8 kbA[4][4], kbB[4][4];
#define LOADK(dst, k0) do { _Pragma("unroll") for (int u = 0; u < 4; ++u) { const int kt = ((k0) + u < ntile) ? (k0) + u : (k0); \
            _Pragma("unroll") for (int ks = 0; ks < 4; ++ks) dst[u][ks] = *(const GAS bf16x8*)(kif + (size_t)(kt * 4 + ks) * 512); } } while (0)
#define COMPK(src, k0) do { _Pragma("unroll") for (int u = 0; u < 4; ++u) if ((k0) + u < ntile) { f32x16 acc; \
            _Pragma("unroll") for (int q = 0; q < 16; ++q) acc[q] = 0.f; \
            _Pragma("unroll") for (int ks = 0; ks < 4; ++ks) acc = __builtin_amdgcn_mfma_f32_32x32x16_bf16(qa[ks], src[u][ks], acc, 0, 0, 0); \
            _Pragma("unroll") for (int g = 0; g < 4; ++g) { float sv = fmaf(wv[g][0], fmaxf(acc[4 * g], 0.f), 0.0f); \
                sv = fmaf(wv[g][1], fmaxf(acc[4 * g + 1], 0.f), sv); sv = fmaf(wv[g][2], fmaxf(acc[4 * g + 2], 0.f), sv); sv = fmaf(wv[g][3], fmaxf(acc[4 * g + 3], 0.f), sv); \
                SC[(2 * g + hh) * 4096 + ((k0) + u) * 32 + r] = sv; } } } while (0)
        int kt0 = wave * 4;
        if (kt0 < ntile) {
            LOADK(kbA, kt0);
            for (;;) {
                const int k1 = kt0 + NWAVES * 4; if (k1 < ntile) LOADK(kbB, k1);
                COMPK(kbA, kt0); if (k1 >= ntile) break;
                const int k2 = k1 + NWAVES * 4; if (k2 < ntile) LOADK(kbA, k2);
                COMPK(kbB, k1); if (k2 >= ntile) break;
                kt0 = k2;
            }
        }
#undef LOADK
#undef COMPK
    }
    __syncthreads();
    LAS float* row = SC + wave * 4096;
    unsigned key[64];
#pragma unroll
    for (int jb = 0; jb < 8; ++jb) {
#pragma unroll
        for (int q = 0; q < 8; ++q) key[jb * 8 + q] = 0u;
        if (jb * 8 < nj) {
#pragma unroll
            for (int q = 0; q < 8; ++q) { const int j = jb * 8 + q; const unsigned u = __float_as_uint(row[j * 64 + lane]); const unsigned kk = ((u & 0x80000000u) ? ~u : (u | 0x80000000u)) >> 1; key[j] = (j < nj) ? kk : 0u; }
        }
    }
    LDS_WAIT(); __syncthreads();
    unsigned hiSel = 1u, T = 0u; int rrem = 0;
    if (nk > 256) {
        unsigned g0 = 0u, g1 = 0u, g2 = 0u, g3 = 0u;
#pragma unroll
        for (int j = 0; j < 64; j += 4) { g0 = key[j] > g0 ? key[j] : g0; g1 = key[j + 1] > g1 ? key[j + 1] : g1; g2 = key[j + 2] > g2 ? key[j + 2] : g2; g3 = key[j + 3] > g3 ? key[j + 3] : g3; }
        const unsigned mx01 = g0 > g1 ? g0 : g1, mx23 = g2 > g3 ? g2 : g3, mn01 = g0 < g1 ? g0 : g1, mn23 = g2 < g3 ? g2 : g3;
        const unsigned km = wave_umax(mx01 > mx23 ? mx01 : mx23);
        unsigned lo = wave_umin(mn01 < mn23 ? mn01 : mn23), hi = km + 1u; int cnt_hi = 0; bool exact = false;
        while (hi - lo > 1u) {
            const unsigned mid = lo + ((hi - lo) >> 1);
            const int cnt = count_ge(key, nj, mid);
            if (cnt >= 256) { lo = mid; if (cnt == 256) { exact = true; break; } } else { hi = mid; cnt_hi = cnt; }
        }
        if (exact) { hiSel = lo; T = 0u; rrem = 0; } else { hiSel = hi; T = lo; rrem = 256 - cnt_hi; }
    }
    GAS unsigned* mrow = M32 + (tok0 + wave) * 128;
    unsigned mlo = 0u, mhi = 0u;
    if (rrem == 0) {
#pragma unroll
        for (int j = 0; j < 64; ++j) if ((j & ~7) < nj) {
            const unsigned long long sm = __ballot(key[j] >= hiSel);
            mlo = (lane == j) ? (unsigned)sm : mlo; mhi = (lane == j) ? (unsigned)(sm >> 32) : mhi;
        }
    } else {
#pragma unroll
        for (int j = 0; j < 64; ++j) if ((j & ~7) < nj) {
            const bool eq = (key[j] == T);
            const unsigned long long eqm = __ballot(eq);
            const bool take = eq && (lane_prefix(eqm) < rrem);
            const int ne = __popcll(eqm); rrem = (ne < rrem) ? rrem - ne : 0;
            const unsigned long long sm = __ballot((key[j] >= hiSel) || take);
            mlo = (lane == j) ? (unsigned)sm : mlo; mhi = (lane == j) ? (unsigned)(sm >> 32) : mhi;
        }
    }
    *(GAS u32x2*)(mrow + 2 * lane) = (u32x2){mlo, mhi};
}

__device__ __forceinline__ void dense_attn_chunk(const Params& p, int b, int c) {
    int tid = threadIdx.x; asm volatile("" : "+v"(tid));
    const int lane = tid & 63, wave = __builtin_amdgcn_readfirstlane(tid >> 6);
    unsigned char* wsq = p.ws; asm volatile("" : "+s"(wsq));
    const GAS bf16_t* Qb = (const GAS bf16_t*)(wsq + WS_Q); const GAS bf16_t* Kb = (const GAS bf16_t*)(wsq + WS_K); const GAS bf16_t* VT = (const GAS bf16_t*)(wsq + WS_VT);
    const GAS unsigned* M32 = (const GAS unsigned*)(wsq + WS_MASK); GAS bf16_t* Attn = (GAS bf16_t*)(wsq + WS_ACAT);
    float mq = fabsf(p.q_norm_g[lane]), mk = fabsf(p.k_norm_g[lane]);
#pragma unroll
    for (int o = 1; o < 64; o <<= 1) { mq = fmaxf(mq, __shfl_xor(mq, o)); mk = fmaxf(mk, __shfl_xor(mk, o)); }
    const float negC = -(8.0f * mq * mk * 1.4426950408889634f * 1.03f);
    const int kvh = wave >> 2, cl = lane & 31, hi = lane >> 5, ntile = 2 * (c + 1);
    const size_t tokc = (size_t)b * SEQ + 64 * c + 16 * (wave & 3);
    bf16x8 qf[2][4]; const GAS unsigned* mrow[2]; size_t tokq[2];
#pragma unroll
    for (int ti = 0; ti < 2; ++ti) { tokq[ti] = tokc + 8 * ti + (cl >> 2); mrow[ti] = M32 + tokq[ti] * 128;
#pragma unroll
        for (int ks = 0; ks < 4; ++ks) qf[ti][ks] = *(const GAS bf16x8*)(Qb + tokq[ti] * 512 + (4 * kvh + (cl & 3)) * 64 + 16 * ks + 8 * hi); }
    f32x16 o[2][2]; float lsum[2] = {0.f, 0.f};
#pragma unroll
    for (int ti = 0; ti < 2; ++ti)
#pragma unroll
        for (int dt = 0; dt < 2; ++dt)
#pragma unroll
            for (int q = 0; q < 16; ++q) o[ti][dt][q] = 0.f;
    const GAS bf16_t* kbase = Kb + (size_t)(b * 2 + kvh) * 128 * 4 * 512 + lane * 8;
    const GAS bf16_t* vbase = VT + (size_t)(b * 2 + kvh) * 128 * 4 * 512 + lane * 8;
    bf16x8 kfA[4], kfB[4], vfA[4], vfB[4]; unsigned mwA[2], mwB[2];
#define LOADT(kf, vf, mw, kt) do { _Pragma("unroll") for (int q = 0; q < 4; ++q) { kf[q] = *(const GAS bf16x8*)(kbase + (size_t)((kt) * 4 + q) * 512); vf[q] = *(const GAS bf16x8*)(vbase + (size_t)((kt) * 4 + q) * 512); } \
        mw[0] = mrow[0][kt]; mw[1] = mrow[1][kt]; } while (0)
#define COMPT(kf, vf, mw) do { _Pragma("unroll") for (int ti = 0; ti < 2; ++ti) { f32x16 sa; const unsigned mwh = mw[ti] >> (4 * hi); \
        _Pragma("unroll") for (int q = 0; q < 16; ++q) sa[q] = negC; \
        _Pragma("unroll") for (int ks = 0; ks < 4; ++ks) sa = __builtin_amdgcn_mfma_f32_32x32x16_bf16(kf[ks], qf[ti][ks], sa, 0, 0, 0); \
        float pv[16]; float ls = 0.f; \
        _Pragma("unroll") for (int r = 0; r < 16; ++r) { const int pos = (r & 3) + 8 * (r >> 2); \
            const float e = __builtin_amdgcn_exp2f(sa[r]); const int m = __builtin_amdgcn_sbfe((int)mwh, pos, 1); \
            pv[r] = __uint_as_float(__float_as_uint(e) & (unsigned)m); ls += pv[r]; } \
        lsum[ti] += ls; \
        _Pragma("unroll") for (int sx = 0; sx < 2; ++sx) { \
            u32x4 pw; pw.x = cvt_pk_bf16(pv[8 * sx], pv[8 * sx + 1]); pw.y = cvt_pk_bf16(pv[8 * sx + 2], pv[8 * sx + 3]); pw.z = cvt_pk_bf16(pv[8 * sx + 4], pv[8 * sx + 5]); pw.w = cvt_pk_bf16(pv[8 * sx + 6], pv[8 * sx + 7]); \
            const bf16x8 pb = __builtin_bit_cast(bf16x8, pw); \
            _Pragma("unroll") for (int dt = 0; dt < 2; ++dt) o[ti][dt] = __builtin_amdgcn_mfma_f32_32x32x16_bf16(vf[dt * 2 + sx], pb, o[ti][dt], 0, 0, 0); } } } while (0)
    LOADT(kfA, vfA, mwA, 0);
    for (int kt = 0; kt < ntile; kt += 2) {
        LOADT(kfB, vfB, mwB, kt + 1);
        COMPT(kfA, vfA, mwA);
        if (kt + 2 < ntile) LOADT(kfA, vfA, mwA, kt + 2);
        COMPT(kfB, vfB, mwB);
    }
#undef LOADT
#undef COMPT
    int lane2 = lane; asm volatile("" : "+v"(lane2));
    const int cl2 = lane2 & 31, hi2 = lane2 >> 5;
#pragma unroll
    for (int ti = 0; ti < 2; ++ti) {
        const float lt = lsum[ti] + __shfl_xor(lsum[ti], 32); const float inv = 1.0f / lt;
        GAS bf16_t* dst = Attn + (tokc + 8 * ti + (cl2 >> 2)) * 1024 + (4 * kvh + (cl2 & 3)) * 64 + 4 * hi2;
#pragma unroll
        for (int dt = 0; dt < 2; ++dt)
#pragma unroll
            for (int g4 = 0; g4 < 4; ++g4) { u32x2 w; w.x = cvt_pk_bf16(o[ti][dt][4 * g4] * inv, o[ti][dt][4 * g4 + 1] * inv); w.y = cvt_pk_bf16(o[ti][dt][4 * g4 + 2] * inv, o[ti][dt][4 * g4 + 3] * inv);
                *(GAS u32x2*)(dst + 32 * dt + 8 * g4) = w; }
    }
}

__device__ __forceinline__ void attn_phase(const Params& p, LAS unsigned char* lds, int bid, int G) {
    for (;;) {
        if (threadIdx.x == 0) { unsigned* ctr = (unsigned*)(p.ws + WS_CTL + 32768) + (blockIdx.x & 7) * 64;
            ((volatile LAS int*)(lds + MISC_OFF + 11264))[0] = (int)__hip_atomic_fetch_add(ctr, 1u, __ATOMIC_RELAXED, __HIP_MEMORY_SCOPE_AGENT); }
        __syncthreads();
        const int idx = __builtin_amdgcn_readfirstlane(((volatile LAS int*)(lds + MISC_OFF + 11264))[0]);
        __syncthreads();
        const int b = blockIdx.x & 7;
        if (idx >= 64) break;
        const int c = 63 - idx;
        for (int sx = 0; sx < 8; ++sx) select_unit(p, lds, b, 64 * c + 8 * sx);
        asm volatile("s_waitcnt vmcnt(0)" ::: "memory"); __syncthreads();
        dense_attn_chunk(p, b, c);
    }
}

constexpr int T_TSTART = 0, T_PADSTART = 40, T_BLOCKBASE = 80, T_NE = 112, T_WB = 144  , T_PART = 400  ;
__device__ __forceinline__ void router_phase(const Params& p, LAS unsigned char* lds, int bid, int G) {
    const int tid = threadIdx.x, lane = tid & 63, wave = __builtin_amdgcn_readfirstlane(tid >> 6);
    constexpr int WP = 1028;
    LAS float* WrT = (LAS float*)lds;
    {
        f32x4 wv_[16]; float gg_[16];
#pragma unroll
        for (int u = 0; u < 16; ++u) { const int i = tid + u * NTHREADS; wv_[u] = *(const f32x4*)(p.router_w + 4 * (size_t)i); gg_[u] = p.norm2_g[i >> 3]; }
#pragma unroll
        for (int u = 0; u < 16; ++u) { const int i = tid + u * NTHREADS; const int c = i >> 3, e0 = 4 * (i & 7);
            WrT[(e0 + 0) * WP + c] = wv_[u][0] * gg_[u]; WrT[(e0 + 1) * WP + c] = wv_[u][1] * gg_[u]; WrT[(e0 + 2) * WP + c] = wv_[u][2] * gg_[u]; WrT[(e0 + 3) * WP + c] = wv_[u][3] * gg_[u]; }
    }
    __syncthreads();
    LAS int* tbl = (LAS int*)(lds + MISC_OFF);
    const float* X1 = p.out; unsigned char* H2 = p.ws + WS_H2;
    int* rec_e = (int*)(p.ws + WS_REC_E); int* rec_pos = (int*)(p.ws + WS_REC_POS); float* rec_gate = (float*)(p.ws + WS_REC_GATE);
    const int ex = lane & 15, kq = lane >> 4;
    const size_t tokw = (size_t)bid * 128 + wave * 16;
    f32x4 acc0 = (f32x4){0.f, 0.f, 0.f, 0.f}, acc1 = acc0; float ssq = 0.f;
    {
        const float* xr = X1 + (tokw + ex) * D + 4 * kq;
        const LAS float* w0 = WrT + ex * WP + 4 * kq; const LAS float* w1 = w0 + 16 * WP;
#pragma unroll 16
        for (int q = 0; q < 64; ++q) {
            const f32x4 a = *(const f32x4*)(xr + 16 * q); const f32x4 b0 = *(const LAS f32x4*)(w0 + 16 * q), b1 = *(const LAS f32x4*)(w1 + 16 * q);
            ssq += (a.x * a.x + a.y * a.y) + (a.z * a.z + a.w * a.w);
#pragma unroll
            for (int k = 0; k < 4; ++k) { acc0 = __builtin_amdgcn_mfma_f32_16x16x4f32(a[k], b0[k], acc0, 0, 0, 0); acc1 = __builtin_amdgcn_mfma_f32_16x16x4f32(a[k], b1[k], acc1, 0, 0, 0); }
        }
    }
    ssq += __shfl_xor(ssq, 16); ssq += __shfl_xor(ssq, 32);
    const float rs = 1.0f / sqrtf(ssq * (1.0f / D) + NORM_EPS);
    const float br0 = p.router_b[ex], br1 = p.router_b[ex + 16];
    float lg0[4], lg1[4];
#pragma unroll
    for (int i = 0; i < 4; ++i) { const float r = __shfl(rs, 4 * kq + i); lg0[i] = acc0[i] * r + br0; lg1[i] = acc1[i] * r + br1; }
    int ti[4][4]; float tv[4][4];
#pragma unroll
    for (int r = 0; r < 4; ++r)
#pragma unroll
        for (int i = 0; i < 4; ++i) {
            float bv = (lg0[i] >= lg1[i]) ? lg0[i] : lg1[i]; int bi = (lg0[i] >= lg1[i]) ? ex : ex + 16;
#pragma unroll
            for (int m = 1; m < 16; m <<= 1) { const float ov = __shfl_xor(bv, m); const int oi = __shfl_xor(bi, m); const bool better = (ov > bv) || (ov == bv && oi < bi); bv = better ? ov : bv; bi = better ? oi : bi; }
            tv[i][r] = bv; ti[i][r] = bi;
            if (bi == ex) lg0[i] = -INFINITY; if (bi == ex + 16) lg1[i] = -INFINITY;
        }
    unsigned M[4];
#pragma unroll
    for (int i = 0; i < 4; ++i) M[i] = (1u << ti[i][0]) | (1u << ti[i][1]) | (1u << ti[i][2]) | (1u << ti[i][3]);
    unsigned Mall[16];
#pragma unroll
    for (int t = 0; t < 16; ++t) Mall[t] = (unsigned)__builtin_amdgcn_readlane((int)M[t & 3], 16 * (t >> 2));
#pragma unroll
    for (int i = 0; i < 4; ++i) {
        const int t = 4 * kq + i;
        const float e1 = __expf(tv[i][1] - tv[i][0]), e2 = __expf(tv[i][2] - tv[i][0]), e3 = __expf(tv[i][3] - tv[i][0]); const float inv = 1.0f / (1.0f + e1 + e2 + e3);
#pragma unroll
        for (int r = 0; r < 4; ++r) {
            const int x = ti[i][r]; int pos = 0;
#pragma unroll
            for (int tp = 0; tp < 16; ++tp) pos += (tp < t) ? (int)((Mall[tp] >> x) & 1u) : 0;
            const float gt = (r == 0 ? 1.0f : (r == 1 ? e1 : (r == 2 ? e2 : e3))) * inv;
            if (ex == r) { rec_e[(tokw + t) * 4 + r] = x; rec_pos[(tokw + t) * 4 + r] = pos; rec_gate[(tokw + t) * 4 + r] = gt; }
        }
    }
    { int cnt = 0;
#pragma unroll
        for (int t = 0; t < 16; ++t) cnt += (int)((Mall[t] >> (lane & 31)) & 1u);
        if (lane < 32) tbl[T_WB + wave * 32 + lane] = cnt; }
    {
        f32x4 g2[4];
#pragma unroll
        for (int j = 0; j < 4; ++j) g2[j] = *(const f32x4*)(p.norm2_g + 4 * lane + 256 * j);
#pragma unroll 4
        for (int t = 0; t < 16; ++t) {
            const float r = __shfl(rs, t);
            const f32x4* xr = (const f32x4*)(X1 + (tokw + t) * D) + lane;
#pragma unroll
            for (int j = 0; j < 4; ++j) { const f32x4 h = xr[64 * j] * r * g2[j]; *(unsigned*)(H2 + (tokw + t) * D + 4 * lane + 256 * j) = pk4_fp8(h.x, h.y, h.z, h.w); }
        }
    }
    __syncthreads();
    if (tid < 256) ((int*)(p.ws + WS_WCNT))[(size_t)bid * 256 + tid] = tbl[T_WB + tid];
    if (tid < 32) { int sm = 0;
#pragma unroll
        for (int w = 0; w < 8; ++w) sm += tbl[T_WB + w * 32 + tid];
        ((int*)(p.ws + WS_BCNT))[bid * 32 + tid] = sm; }
    __syncthreads();
}

__device__ __forceinline__ void moe_tables(const Params& p, LAS int* tbl, int bid) {
    const int tid = threadIdx.x; const int* bcnt = (const int*)(p.ws + WS_BCNT);
    { const int e = tid & 31, part = tid >> 5; int all = 0, below = 0;
        for (int k = 0; k < 16; ++k) { const int blk = part * 16 + k; const int v = bcnt[blk * 32 + e]; all += v; below += (blk < bid) ? v : 0; }
        tbl[T_PART + part * 32 + e] = all; tbl[T_PART + 512 + part * 32 + e] = below; }
    __syncthreads();
    if (tid < 32) { int all = 0, below = 0;
        for (int q = 0; q < 16; ++q) { all += tbl[T_PART + q * 32 + tid]; below += tbl[T_PART + 512 + q * 32 + tid]; }
        tbl[T_NE + tid] = all; tbl[T_BLOCKBASE + tid] = below; }
    __syncthreads();
    if (tid == 0) { int ps = 0, ts = 0;
        for (int e = 0; e < NEXP; ++e) { tbl[T_PADSTART + e] = ps; tbl[T_TSTART + e] = ts; const int nt = (tbl[T_NE + e] + 255) >> 8; ps += nt * 256; ts += nt; }
        tbl[T_PADSTART + NEXP] = ps; tbl[T_TSTART + NEXP] = ts; }
    __syncthreads();
}

__device__ __forceinline__ void permute_phase(const Params& p, LAS unsigned char* lds, int bid, int G) {
    const int tid = threadIdx.x, lane = tid & 63, wave = __builtin_amdgcn_readfirstlane(tid >> 6);
    LAS int* tbl = (LAS int*)(lds + MISC_OFF);
    moe_tables(p, tbl, bid);
    if (tid < 256) { const int w = tid >> 5, e = tid & 31; int s = 0; const int* wc = (const int*)(p.ws + WS_WCNT) + (size_t)bid * 256;
        for (int q = 0; q < 8; ++q) s += (q < w) ? wc[q * 32 + e] : 0;
        tbl[T_WB + tid] = s; }
    __syncthreads();
    const int* rec_e = (const int*)(p.ws + WS_REC_E); const int* rec_pos = (const int*)(p.ws + WS_REC_POS); const float* rec_gate = (const float*)(p.ws + WS_REC_GATE);
    int* slot_of = (int*)(p.ws + WS_SLOT_OF); float* slot_gate = (float*)(p.ws + WS_SLOT_GATE);
    const unsigned char* H2 = p.ws + WS_H2; unsigned char* H2S = p.ws + WS_H2S;
    for (int bt = 0; bt < 4; ++bt) {
        const int idx = wave * 64 + bt * 16 + (lane & 15); const int tl = idx >> 2; const size_t tk = (size_t)bid * 128 + tl;
        const int e = rec_e[tk * 4 + (idx & 3)], pw = rec_pos[tk * 4 + (idx & 3)];
        const int slot = tbl[T_PADSTART + e] + tbl[T_BLOCKBASE + e] + tbl[T_WB + (tl >> 4) * 32 + e] + pw;
        if (lane < 16) { slot_of[tk * 4 + (idx & 3)] = slot; slot_gate[slot] = rec_gate[tk * 4 + (idx & 3)]; }
        u32x4 v0[16];
#pragma unroll
        for (int i = 0; i < 16; ++i) { const size_t tki = (size_t)bid * 128 + ((wave * 64 + bt * 16 + i) >> 2); v0[i] = *(const u32x4*)(H2 + tki * D + 16 * lane); }
#pragma unroll
        for (int i = 0; i < 16; ++i) { const int sl = __shfl(slot, i); *(u32x4*)(H2S + (size_t)sl * D + 16 * lane) = v0[i]; }
    }
}

__device__ __forceinline__ void combine_phase(const Params& p, int bid, int G) {
    const int tid = threadIdx.x, lane = tid & 63, wave = __builtin_amdgcn_readfirstlane(tid >> 6);
    const int gw = bid * NWAVES + wave, NGW = G * NWAVES;
    const int* slot_of = (const int*)(p.ws + WS_SLOT_OF); const unsigned char* Y = p.ws + WS_Y;
    typedef float f32x2v __attribute__((ext_vector_type(2)));
    for (int tk = gw; tk < NTOK; tk += NGW) {
        int sl[4];
#pragma unroll
        for (int r = 0; r < 4; ++r) sl[r] = slot_of[(size_t)tk * 4 + r];
        float* orow = p.out + (size_t)tk * D;
        unsigned yv[4][4];
#pragma unroll
        for (int j = 0; j < 4; ++j)
#pragma unroll
            for (int r = 0; r < 4; ++r) yv[j][r] = *(const unsigned*)(Y + (size_t)sl[r] * D + 4 * lane + 256 * j);
#pragma unroll
        for (int j = 0; j < 4; ++j) { f32x4 a = *(const f32x4*)(orow + 4 * lane + 256 * j); float s0 = 0.f, s1 = 0.f, s2 = 0.f, s3 = 0.f;
#pragma unroll
            for (int r = 0; r < 4; ++r) { const f32x2v lo = __builtin_amdgcn_cvt_pk_f32_fp8((int)yv[j][r], false), hi = __builtin_amdgcn_cvt_pk_f32_fp8((int)yv[j][r], true); s0 += lo.x; s1 += lo.y; s2 += hi.x; s3 += hi.y; }
            a.x += s0 * (1.0f / Y_SCALE); a.y += s1 * (1.0f / Y_SCALE); a.z += s2 * (1.0f / Y_SCALE); a.w += s3 * (1.0f / Y_SCALE);
            *(f32x4*)(orow + 4 * lane + 256 * j) = a; }
    }
}

#define XB_TMO      128
#define XB_XCNT(j)  (256  + 64 * (j))
#define XB_XSUB(j)  (1280 + 64 * (j))
#define XB_XGEN(j)  (2304 + 64 * (j))
#define XB_TOP      3328
#define XB_TOPGEN   3392
#define XCD_BAR_WORDS 3456
#define XB_SPIN_CAP (1u << 18)

__device__ __forceinline__ unsigned xb_ld(unsigned* p)              { return __hip_atomic_load(p, __ATOMIC_RELAXED, __HIP_MEMORY_SCOPE_AGENT); }
__device__ __forceinline__ unsigned xb_add(unsigned* p, unsigned v) { return __hip_atomic_fetch_add(p, v, __ATOMIC_RELAXED, __HIP_MEMORY_SCOPE_AGENT); }
__device__ __forceinline__ unsigned xb_xcc_id() { return (unsigned)__builtin_amdgcn_s_getreg((3 << 11) | 20) & 0xFu; }
#define XB_SPIN(cond, bar) do { unsigned _sp = 0; while (cond) { __builtin_amdgcn_s_sleep(1); \
    if ((++_sp & 255u) == 0u) { if (xb_ld(&(bar)[XB_TMO])) break; if (_sp > XB_SPIN_CAP) { atomicAdd(&(bar)[XB_TMO], 1u); break; } } } } while (0)

struct XcdBarrier {
    unsigned* bar; unsigned x;
    volatile LAS unsigned* st;
};

__device__ __forceinline__ XcdBarrier xcd_barrier_post(unsigned* bar, volatile LAS unsigned* st) {
    XcdBarrier b; b.bar = bar; b.x = xb_xcc_id(); b.st = st;
    if (threadIdx.x == 0) (void)xb_add(&bar[XB_XCNT(b.x)], 1u);
    return b;
}
__device__ __forceinline__ void xcd_barrier_complete(unsigned* bar, unsigned x, unsigned& nloc, unsigned& nx) {
    const unsigned G = gridDim.x * gridDim.y * gridDim.z;
    unsigned sum, cnt, mine, sp = 0u;
    for (;;) {
        sum = 0u; cnt = 0u; mine = 0u;
#pragma unroll
        for (unsigned j = 0; j < 16; ++j) { const unsigned c = xb_ld(&bar[XB_XCNT(j)]); sum += c; cnt += (c > 0u) ? 1u : 0u; mine = (j == x) ? c : mine; }
        if (sum == G) break;
        __builtin_amdgcn_s_sleep(1);
        if ((++sp & 255u) == 0u) { if (xb_ld(&bar[XB_TMO])) break; if (sp > XB_SPIN_CAP) { atomicAdd(&bar[XB_TMO], 1u); break; } }
    }
    nloc = mine > 0u ? mine : 1u; nx = cnt > 0u ? cnt : 1u;
}

__device__ __forceinline__ void xcd_barrier(const XcdBarrier& b) {
    asm volatile("s_waitcnt vmcnt(0)" ::: "memory");
    __syncthreads();
    if (threadIdx.x == 0) {
        unsigned* bar = b.bar;
        __builtin_amdgcn_s_waitcnt(0);
        unsigned nloc = b.st[0], nx = b.st[1];
        if (nloc == 0u) { xcd_barrier_complete(bar, b.x, nloc, nx); b.st[0] = nloc; b.st[1] = nx; }
        const unsigned old = xb_add(&bar[XB_XSUB(b.x)], 1u);
        const unsigned gen = old / nloc;
        if (old + 1u == (gen + 1u) * nloc) {
            __builtin_amdgcn_fence(__ATOMIC_RELEASE, "agent");
            asm volatile("s_waitcnt vmcnt(0)" ::: "memory");
            const unsigned og = xb_add(&bar[XB_TOP], 1u);
            const unsigned tg = og / nx;
            if (og + 1u == (tg + 1u) * nx) xb_add(&bar[XB_TOPGEN], 1u);
            else XB_SPIN(xb_ld(&bar[XB_TOPGEN]) == tg, bar);
            __builtin_amdgcn_fence(__ATOMIC_ACQUIRE, "agent");
            xb_add(&bar[XB_XGEN(b.x)], 1u);
            asm volatile("s_waitcnt vmcnt(0)" ::: "memory");
        } else {
            XB_SPIN(xb_ld(&bar[XB_XGEN(b.x)]) == gen, bar);
            __builtin_amdgcn_fence(__ATOMIC_ACQUIRE, "agent");
            asm volatile("s_waitcnt vmcnt(0)" ::: "memory");
        }
    }
    __syncthreads();
}

constexpr int NPH = 11;
__global__ void __launch_bounds__(NTHREADS, 2) mega(Params p) {
    extern __shared__ __attribute__((aligned(16))) unsigned char lds_raw[];
    LAS unsigned char* lds = (LAS unsigned char*)lds_raw;
    cg::grid_group grid = cg::this_grid();
    const int bid = blockIdx.x, G = gridDim.x;
    unsigned char* ws = p.ws;
    if (p.ph_lo < 0) grid.sync();
    volatile LAS unsigned* bst = (volatile LAS unsigned*)(lds + MISC_OFF + 12032);
    if (threadIdx.x < 2) bst[threadIdx.x] = 0u;
    __syncthreads();
    const XcdBarrier xbar = xcd_barrier_post((unsigned*)(ws + WS_CTL + 4096), bst);
#ifndef PH_MASK
#define PH_MASK 0x7ff
#endif
#define IN(k) (((PH_MASK >> (k)) & 1) && p.ph_lo <= (k) && (k) < p.ph_hi)
#ifndef PH_DUP
#define PH_DUP 0
#endif
#define DUP(k) (((PH_DUP >> (k)) & 1) ? 2 : 1)
#define STAMP(k) do { if (TS_PHASE >= 0 && ((k) == TS_PHASE || (k) == TS_PHASE + 1)) { if (blockIdx.x == 0 && __builtin_amdgcn_readfirstlane(threadIdx.x) < 64) { unsigned tv_ = (unsigned)__builtin_amdgcn_s_memrealtime(); unsigned ad_ = MISC_OFF + 10240 + 4 * ((k) - TS_PHASE); asm volatile("ds_write_b32 %0, %1\n\ts_waitcnt lgkmcnt(0)" :: "v"(ad_), "v"(tv_) : "memory"); } } } while (0)
#define SEAM(k) do { if (IN(k) && IN((k) + 1)) xcd_barrier(xbar); STAMP((k) + 1); } while (0)
    volatile LAS unsigned* tsv = (volatile LAS unsigned*)(lds + MISC_OFF + 10240);
    STAMP(0);
    if (IN(0)) { phase0(p, lds, bid, G); }
    SEAM(0);
    if (IN(1)) {
        pg8::Gemm g{(const bf16_t*)(ws + WS_XN), (const bf16_t*)(ws + WS_WIN), NTOK, INWP, D}; pg8::StaticOrder S; S.init(NTOK, INWP, G, bid);
        EpiInProj E{(bf16_t*)(ws + WS_Q), (bf16_t*)(ws + WS_K), (bf16_t*)(ws + WS_VT), (bf16_t*)(ws + WS_QI), (bf16_t*)(ws + WS_KI), (bf16_t*)(ws + WS_POOL), (bf16_t*)(ws + WS_GA), (bf16_t*)(ws + WS_GP),
                    (float*)(ws + WS_WI), (const float*)(ws + WS_CS), p.q_norm_g, p.k_norm_g, p.idx_g, p.idx_b};
        pg8::gemm_phase(lds, g, S, E);
    }
    SEAM(1);
    if (IN(2)) { pool_phase(p, bid, G); attn_phase(p, lds, bid, G); }
    SEAM(2);
    if (IN(3)) {
        pg8::Gemm g{(const bf16_t*)(ws + WS_ACAT), (const bf16_t*)(ws + WS_WCAT), NTOK, D, D}; pg8::StaticOrder S; S.init(NTOK, D, G, bid);
        EpiGated E{(const bf16_t*)(ws + WS_GA), (const bf16_t*)(ws + WS_GP), (bf16_t*)(ws + WS_MERGED)};
        pg8::gemm_phase(lds, g, S, E);
    }
    SEAM(4); STAMP(4);
    if (IN(5)) {
        pg8::Gemm g{(const bf16_t*)(ws + WS_MERGED), (const bf16_t*)(ws + WS_WOUT), NTOK, D, D}; pg8::StaticOrder S; S.init(NTOK, D, G, bid);
        EpiResid E{p.x, p.out};
        pg8::gemm_phase(lds, g, S, E);
    }
    SEAM(5);
    if (IN(6)) { router_phase(p, lds, bid, G); }
    SEAM(6);
    if (IN(7)) { permute_phase(p, lds, bid, G); }
    SEAM(7);
    if (IN(8)) {
        LAS int* tbl = (LAS int*)(lds + MISC_OFF); moe_tables(p, tbl, bid);
        pg8::Gemm g{(const bf16_t*)(ws + WS_H2S), (const bf16_t*)(ws + WS_WGU), NSLOT, NEXP * 2048, D}; pg8::MoeOrder<8> S{tbl + T_TSTART, G, bid};
        EpiGateUp E{p.b_gu, ws + WS_ACT};
        pg8::gemm_phase<EpiGateUp, pg8::MoeOrder<8>, true>(lds, g, S, E);
    }
    SEAM(8);
    if (IN(9)) {
        LAS int* tbl = (LAS int*)(lds + MISC_OFF); moe_tables(p, tbl, bid);
        pg8::Gemm g{(const bf16_t*)(ws + WS_ACT), (const bf16_t*)(ws + WS_WD), NSLOT, NEXP * 1024, D}; pg8::MoeOrder<4> S{tbl + T_TSTART, G, bid};
        EpiDown E{p.b_d, (const float*)(ws + WS_SLOT_GATE), ws + WS_Y};
        pg8::gemm_phase<EpiDown, pg8::MoeOrder<4>, true>(lds, g, S, E);
    }
    SEAM(9);
    if (IN(10)) combine_phase(p, bid, G);
    STAMP(11);
    if (TS_PHASE >= 0 && blockIdx.x == 0 && threadIdx.x == 0) {
        const unsigned d = tsv[1] - tsv[0], t0 = (unsigned)__builtin_amdgcn_s_memrealtime();
        while ((unsigned)__builtin_amdgcn_s_memrealtime() - t0 < d) __builtin_amdgcn_s_sleep(8);
    }
#undef IN
#undef SEAM
}

extern "C" void kernel_launch(void* const* d_in, const int* in_sizes, int n_in, void* d_out, int out_size, void* d_ws, size_t ws_size, hipStream_t stream) {
    static int grid = 0;
    if (grid == 0) {
        if (n_in != 20 || out_size != NTOK * D || ws_size < WS_END) { fprintf(stderr, "kernel_launch: unexpected shapes: n_in %d out %d ws %zu (need %zu)\n", n_in, out_size, ws_size, (size_t)WS_END); grid = -1; return; }
        int dev = 0, cus = 0, per_cu = 0;
        hipGetDevice(&dev); hipDeviceGetAttribute(&cus, hipDeviceAttributeMultiprocessorCount, dev);
        if (hipFuncSetAttribute((const void*)mega, hipFuncAttributeMaxDynamicSharedMemorySize, LDS_BYTES) != hipSuccess) { fprintf(stderr, "kernel_launch: hipFuncSetAttribute failed\n"); grid = -1; return; }
        if (hipOccupancyMaxActiveBlocksPerMultiprocessor(&per_cu, (const void*)mega, NTHREADS, LDS_BYTES) != hipSuccess || per_cu < 1) { fprintf(stderr, "kernel_launch: occupancy query says %d blocks per CU\n", per_cu); per_cu = 1; }
        (void)hipGetLastError();
        grid = cus;
        if (grid != 256) fprintf(stderr, "kernel_launch: %d CUs; the router / permute phases assume a 256-workgroup grid\n", grid);
    }
    if (grid < 0) return;
    if (hipMemsetAsync((char*)d_ws + WS_CTL, 0, 64 * 1024, stream) != hipSuccess) { fprintf(stderr, "kernel_launch: hipMemsetAsync of the control words failed\n"); return; }
    Params p{};
    p.x = (const float*)d_in[0]; p.pos = (const int*)d_in[1]; p.norm1_g = (const float*)d_in[2]; p.w_in = (const float*)d_in[3]; p.q_norm_g = (const float*)d_in[4];
    p.k_norm_g = (const float*)d_in[5]; p.idx_g = (const float*)d_in[6]; p.idx_b = (const float*)d_in[7]; p.w_a = (const float*)d_in[8]; p.pool_mix = (const float*)d_in[9];
    p.pool_scale = (const float*)d_in[10]; p.w_b = (const float*)d_in[11]; p.w_out = (const float*)d_in[12]; p.norm2_g = (const float*)d_in[13]; p.router_w = (const float*)d_in[14];
    p.router_b = (const float*)d_in[15]; p.w_gu = (const float*)d_in[16]; p.b_gu = (const float*)d_in[17]; p.w_d = (const float*)d_in[18]; p.b_d = (const float*)d_in[19];
    p.out = (float*)d_out; p.ws = (unsigned char*)d_ws;
#if MK_MODE == 0
    p.ph_lo = 0; p.ph_hi = NPH;
    void* args[] = {&p};
    hipError_t e = hipLaunchCooperativeKernel((const void*)mega, dim3(grid), dim3(NTHREADS), args, LDS_BYTES, stream);
    if (e != hipSuccess) fprintf(stderr, "kernel_launch: cooperative launch failed: %s (grid %d)\n", hipGetErrorString(e), grid);
#else
    for (int k = 0; k < NPH; ++k) { p.ph_lo = k; p.ph_hi = k + 1; hipLaunchKernelGGL(mega, dim3(grid), dim3(NTHREADS), LDS_BYTES, stream, p); }
#endif
}
```

```cpp
#include <hip/hip_runtime.h>
#include <hip/hip_cooperative_groups.h>
#include <cstdio>
#include <cstdint>
#include <cmath>
namespace cg = cooperative_groups;

#ifndef TS_PHASE
#define TS_PHASE (-1)
#endif
#ifndef MK_MODE
#define MK_MODE 0
#endif

#define LAS __attribute__((address_space(3)))
#define GAS __attribute__((address_space(1)))
typedef unsigned short bf16_t;
typedef short bf16x8 __attribute__((ext_vector_type(8)));
typedef float f32x2 __attribute__((ext_vector_type(2)));
typedef float f32x4 __attribute__((ext_vector_type(4)));
typedef float f32x16 __attribute__((ext_vector_type(16)));
typedef unsigned u32x2 __attribute__((ext_vector_type(2)));
typedef unsigned u32x4 __attribute__((ext_vector_type(4)));

constexpr int D = 1024, NBATCH = 8, SEQ = 4096, NTOK = NBATCH * SEQ;
constexpr int NEXP = 32, TOPK = 4;
constexpr int INW = 3652, INWP = 3840;
constexpr int NSLOT = 139264;
constexpr float NORM_EPS = 1e-6f;
constexpr float MOE_WSCALE = 64.0f, MOE_WINV = 1.0f / 64.0f;
constexpr float Y_SCALE = 16.0f;
constexpr int NWAVES = 8, NTHREADS = 512;
constexpr int LDS_BYTES = 147456;
constexpr int RING_BYTES = 131072;
constexpr int MISC_OFF = 135168;

constexpr size_t MiB = 1u << 20;
constexpr size_t WS_CTL = 0;
constexpr size_t WS_BCNT = 64 * 1024;
constexpr size_t WS_WCNT = 128 * 1024;
constexpr size_t WS_CS = 2 * MiB;
constexpr size_t WS_WIN = 16 * MiB;
constexpr size_t WS_WCAT = 24 * MiB;
constexpr size_t WS_WOUT = 26 * MiB;
constexpr size_t WS_WGU = 28 * MiB;
constexpr size_t WS_WD = 156 * MiB;
constexpr size_t WS_REC_E = 220 * MiB;
constexpr size_t WS_REC_POS = 221 * MiB;
constexpr size_t WS_REC_GATE = 222 * MiB;
constexpr size_t WS_SLOT_OF = 223 * MiB;
constexpr size_t WS_SLOT_GATE = 223 * MiB + 512 * 1024;
constexpr size_t WS_XN = 226 * MiB;
constexpr size_t WS_Q = 290 * MiB;
constexpr size_t WS_K = 322 * MiB;
constexpr size_t WS_VT = 330 * MiB;
constexpr size_t WS_QI = 338 * MiB;
constexpr size_t WS_KI = 354 * MiB;
constexpr size_t WS_WI = 358 * MiB;
constexpr size_t WS_POOL = 360 * MiB;
constexpr size_t WS_GA = 392 * MiB;
constexpr size_t WS_GP = 456 * MiB;
constexpr size_t WS_ACAT = 520 * MiB;
constexpr size_t WS_TA = 584 * MiB;
constexpr size_t WS_MASK = WS_TA;
constexpr size_t WS_MERGED = 648 * MiB;
constexpr size_t WS_H2 = WS_XN;
constexpr size_t WS_H2S = 290 * MiB;
constexpr size_t WS_Y = WS_H2S;
constexpr size_t WS_ACT = 562 * MiB;
constexpr size_t WS_END = 834 * MiB;
static_assert(WS_SLOT_GATE + (size_t)NSLOT * 4 <= WS_XN, "ws map");

__device__ __forceinline__ unsigned cvt_pk_bf16(float lo, float hi) { unsigned r; asm volatile("v_cvt_pk_bf16_f32 %0, %1, %2" : "=v"(r) : "v"(lo), "v"(hi)); return r; }
__device__ __forceinline__ unsigned pk4_fp8(float a, float b, float c, float d) { int w = __builtin_amdgcn_cvt_pk_fp8_f32(a, b, 0, false); w = __builtin_amdgcn_cvt_pk_fp8_f32(c, d, w, true); return (unsigned)w; }
__device__ __forceinline__ float bf_lo(unsigned w) { return __uint_as_float(w << 16); }
__device__ __forceinline__ float bf_hi(unsigned w) { return __uint_as_float(w & 0xffff0000u); }
__device__ __forceinline__ float wave_sum(float v) {
#pragma unroll
    for (int o = 1; o < 64; o <<= 1) v += __shfl_xor(v, o);
    return v;
}
__device__ __forceinline__ float sigmoidf_(float x) { return __builtin_amdgcn_rcpf(1.0f + __builtin_amdgcn_exp2f(-1.4426950408889634f * x)); }
#define LDS_WAIT() asm volatile("s_waitcnt lgkmcnt(0)" ::: "memory")

__host__ __device__ __forceinline__ int idx_bj_j(int d, int& bj) {
    int j;
    if (d < 16) { bj = 0; j = d; } else if (d < 32) { bj = 1; j = d - 16; } else if (d < 48) { bj = 0; j = d - 16; } else { bj = 1; j = d - 32; }
    return j;
}
__host__ __device__ __forceinline__ int win_phys(int n) {
    if (n < 512) { const int h = n >> 6, d = n & 63; return 256 * (h >> 2) + 128 * (d >> 5) + 32 * (h & 3) + (d & 31); }
    if (n < 768) { const int h = (n - 512) >> 6, d = n & 63; return 512 + 128 * (d >> 5) + 32 * h + (d & 31); }
    if (n < 1024) { const int h = (n - 768) >> 6, d = n & 63; int bj; const int j = idx_bj_j(d, bj); return 768 + 128 * bj + 32 * h + j; }
    if (n < 1088) { const int d = n - 1024; int bj; const int j = idx_bj_j(d, bj); return 1024 + 128 * bj + j; }
    if (n < 1092) return 1024 + 32 + (n - 1088);
    if (n < 1604) return 1280 + (n - 1092);
    if (n < 2628) return 1792 + (n - 1604);
    return 2816 + (n - 2628);
}

namespace pg8 {
constexpr int BM = 256, BK = 64, HALF = 128, HTB = HALF * BK * 2, STAGE_BYTES = 8 * HTB, NXCD = 8, WGM = 8;
__host__ __device__ __forceinline__ int lds_byte(int r, int c) { const int st = (r >> 4) * 2 + (c >> 5), rr = r & 15, cc = c & 31, ob = rr * 64 + cc * 2; return st * 1024 + (ob ^ (((ob >> 9) & 1) << 5)); }
__host__ __device__ __forceinline__ void stage_rc(int b, int& R, int& C) { const int st = b / 1024, sb = b % 1024, swz = sb ^ (((sb >> 9) & 1) << 5); R = (st >> 1) * 16 + swz / 64; C = (st & 1) * 32 + (swz % 64) / 2; }
__host__ __device__ __forceinline__ int perm32(int rho) { const int n = rho >> 4, i = rho & 15; return 8 * (i >> 2) + 4 * n + (i & 3); }

struct Unit { int pm, pn; };
struct Gemm { const bf16_t* A; const bf16_t* Bt; int M, N, K; };

struct StaticOrder {
    int nM, nN, nwg, G, c;
    __device__ void init(int M, int N, int G_, int c_) { nM = M / BM; nN = N / BM; nwg = nM * nN; G = G_; c = c_; }
    __device__ bool next(int i, Unit& u) const {
        const long L = (long)i * G + c; if (L >= nwg) return false;
        int wgid = (int)L; { const int q = nwg / NXCD, r = nwg % NXCD, xcd = wgid % NXCD, off = wgid / NXCD; wgid = (xcd < r ? xcd * (q + 1) : r * (q + 1) + (xcd - r) * q) + off; }
        const int nig = WGM * nN, gid = wgid / nig, fm = gid * WGM, gsz = (nM - fm) < WGM ? (nM - fm) : WGM;
        u.pm = fm + ((wgid % nig) % gsz); u.pn = (wgid % nig) / gsz; return true;
    }
};
template <int NPN> struct MoeOrder {
    const LAS int* tstart; int G, c;
    __device__ bool next(int i, Unit& u) const {
        const int x = c & 7, lc = c >> 3, ng = G >> 3;
        int U = i * ng + lc;
#pragma unroll
        for (int k = 0; k < NEXP / 8; ++k) {
            const int e = x + 8 * k; const int t0 = __builtin_amdgcn_readfirstlane(tstart[e]), t1 = __builtin_amdgcn_readfirstlane(tstart[e + 1]);
            const int nu = (t1 - t0) * NPN;
            if (U < nu) { u.pm = t0 + U / NPN; u.pn = e * NPN + U % NPN; return true; }
            U -= nu;
        }
        return false;
    }
};

typedef int i32x8 __attribute__((ext_vector_type(8)));
__device__ __forceinline__ i32x8 pk32(bf16x8 a, bf16x8 b) { typedef int i32x4 __attribute__((ext_vector_type(4))); const i32x4 x = __builtin_bit_cast(i32x4, a), y = __builtin_bit_cast(i32x4, b); return __builtin_shufflevector(x, y, 0, 1, 2, 3, 4, 5, 6, 7); }
__device__ __forceinline__ void mfma_f8_inplace(f32x4& acc, i32x8 a, i32x8 b, int one) {
    asm volatile("v_mfma_scale_f32_16x16x128_f8f6f4 %0, %1, %2, %0, %3, %3 op_sel_hi:[0,0,0]" : "+v"(acc) : "v"(a), "v"(b), "v"(one));
}
template <class Epi, class Sched, bool F8 = false>
__device__ __forceinline__ void gemm_phase(LAS unsigned char* lds, const Gemm g, const Sched& S, const Epi& E) {
    const int tid = threadIdx.x, wid = __builtin_amdgcn_readfirstlane(tid >> 6), lane = tid & 63, wr = wid >> 2, wc = wid & 3, fr = lane & 15, fq = lane >> 4;
    constexpr int ES = F8 ? 1 : 2;
    const int K = g.K, RB = K * ES, nt = RB / 128;
    unsigned voffA[2], voffB[2];
    { int R, C; stage_rc(tid * 16, R, C); const int Rb = (R & ~31) + perm32(R & 31);
        voffA[0] = (unsigned)(R * RB + C * 2); voffB[0] = (unsigned)(Rb * RB + C * 2); voffA[1] = 64u * (unsigned)RB; voffB[1] = 64u * (unsigned)RB; }
    const size_t kstep = (size_t)(BK * 2);
    const size_t hstep = (size_t)HALF * RB;
    const size_t tstep = 2 * hstep;
    const unsigned ldsw = (unsigned)wid * 1024u;
    const int aoff = lds_byte(wr * 64 + fr, F8 ? fq * 16 : fq * 8), boff = lds_byte(wc * 32 + fr, F8 ? fq * 16 : fq * 8);
    constexpr int PSTEP = F8 ? 16 : 1024;
#define PG8_SA(b, h) (((b) * 2 + (h)) * HTB)
#define PG8_SB(b, h) ((4 + (b) * 2 + (h)) * HTB)
#define PG8_STAGE(bufoff, gbase, voff) do { _Pragma("unroll") for (int _i = 0; _i < 2; ++_i) \
        __builtin_amdgcn_global_load_lds((const unsigned*)((const char*)(gbase) + (size_t)(_i ? (voff)[1] : 0u) + (voff)[0]), (LAS unsigned*)(lds + (bufoff) + ldsw + _i * 8192), 16, 0, 0); } while (0)
#define PG8_LDA(dst, b, h) do { _Pragma("unroll") for (int m = 0; m < 4; ++m) _Pragma("unroll") for (int k = 0; k < 2; ++k) dst[m][k] = *(const LAS bf16x8*)(lds + PG8_SA(b, h) + aoff + m * 2048 + k * PSTEP); } while (0)
#define PG8_LDB(dst, b, h) do { _Pragma("unroll") for (int n = 0; n < 2; ++n) _Pragma("unroll") for (int k = 0; k < 2; ++k) dst[n][k] = *(const LAS bf16x8*)(lds + PG8_SB(b, h) + boff + n * 2048 + k * PSTEP); } while (0)
#define PG8_MMA(ai, bj, At, Bt) do { __builtin_amdgcn_s_setprio(1); \
        if constexpr (F8) { _Pragma("unroll") for (int m = 0; m < 4; ++m) _Pragma("unroll") for (int n = 0; n < 2; ++n) \
            mfma_f8_inplace(acc[ai][bj][m][n], pk32(Bt[n][0], Bt[n][1]), pk32(At[m][0], At[m][1]), one_scale); } \
        else { _Pragma("unroll") for (int m = 0; m < 4; ++m) _Pragma("unroll") for (int n = 0; n < 2; ++n) _Pragma("unroll") for (int k = 0; k < 2; ++k) \
            acc[ai][bj][m][n] = __builtin_amdgcn_mfma_f32_16x16x32_bf16(Bt[n][k], At[m][k], acc[ai][bj][m][n], 0, 0, 0); } \
        __builtin_amdgcn_s_setprio(0); } while (0)
#define PG8_WAIT_V(n) asm volatile("s_waitcnt vmcnt(" #n ")" ::: "memory")
#define PG8_WAIT_L(n) asm volatile("s_waitcnt lgkmcnt(" #n ")" ::: "memory")
#define PG8_BAR __builtin_amdgcn_s_barrier()
#define PG8_SCHED __builtin_amdgcn_sched_barrier(0)
    int one_scale = 0x7F7F7F7F; asm volatile("" : "+v"(one_scale));
    Unit cur, nxt; int ui = 0;
    if (!S.next(0, cur)) return;
    cur.pm = __builtin_amdgcn_readfirstlane(cur.pm); cur.pn = __builtin_amdgcn_readfirstlane(cur.pn);
    f32x4 acc[2][2][4][2];
#pragma unroll
    for (int a = 0; a < 2; ++a)
#pragma unroll
        for (int b = 0; b < 2; ++b)
#pragma unroll
            for (int m = 0; m < 4; ++m)
#pragma unroll
                for (int n = 0; n < 2; ++n) acc[a][b][m][n] = (f32x4){0.f, 0.f, 0.f, 0.f};
    bf16x8 At[4][2], B0[2][2], B1[2][2];
    const char* cA = (const char*)g.A + (size_t)cur.pm * tstep; const char* cB = (const char*)g.Bt + (size_t)cur.pn * tstep;
    PG8_STAGE(PG8_SB(0, 0), cB, voffB); PG8_STAGE(PG8_SB(0, 1), cB + hstep, voffB); PG8_STAGE(PG8_SA(0, 0), cA, voffA); PG8_STAGE(PG8_SA(0, 1), cA + hstep, voffA);
    if (wr == 1) PG8_BAR;
    PG8_WAIT_V(2); PG8_BAR;
    PG8_STAGE(PG8_SB(1, 0), cB + kstep, voffB); PG8_STAGE(PG8_SA(1, 0), cA + kstep, voffA); PG8_STAGE(PG8_SB(1, 1), cB + hstep + kstep, voffB);
    PG8_WAIT_V(6); PG8_BAR;
    for (;;) {
        const bool has_next = S.next(ui + 1, nxt); nxt.pm = __builtin_amdgcn_readfirstlane(nxt.pm); nxt.pn = __builtin_amdgcn_readfirstlane(nxt.pn);
        const char* nA = has_next ? (const char*)g.A + (size_t)nxt.pm * tstep : cA; const char* nB = has_next ? (const char*)g.Bt + (size_t)nxt.pn * tstep : cB;
#pragma unroll 1
        for (int t = 0; t < nt; t += 2) {
            const bool last = (t == nt - 2);
            const char* a1 = cA + (size_t)(t + 1) * kstep;
            const char* a2 = last ? nA : cA + (size_t)(t + 2) * kstep; const char* b2 = last ? nB : cB + (size_t)(t + 2) * kstep;
            const char* a3 = a2 + kstep; const char* b3 = b2 + kstep;
            PG8_LDB(B0, 0, 0); PG8_LDB(B1, 0, 1); PG8_SCHED; PG8_LDA(At, 0, 0); PG8_STAGE(PG8_SA(1, 1), a1 + hstep, voffA);
            PG8_WAIT_V(8); PG8_WAIT_L(0); PG8_BAR; PG8_MMA(0, 0, At, B0); PG8_MMA(0, 1, At, B1); PG8_BAR; PG8_SCHED;
            PG8_LDA(At, 0, 1); PG8_STAGE(PG8_SB(0, 0), b2, voffB); PG8_STAGE(PG8_SB(0, 1), b2 + hstep, voffB); PG8_STAGE(PG8_SA(0, 0), a2, voffA);
            PG8_WAIT_V(8); PG8_WAIT_L(0); PG8_BAR; PG8_MMA(1, 0, At, B0); PG8_MMA(1, 1, At, B1); PG8_BAR; PG8_SCHED;
            PG8_LDB(B0, 1, 0); PG8_LDB(B1, 1, 1); PG8_SCHED; PG8_LDA(At, 1, 0); PG8_STAGE(PG8_SA(0, 1), a2 + hstep, voffA);
            PG8_WAIT_V(8); PG8_WAIT_L(0); PG8_BAR; PG8_MMA(0, 0, At, B0); PG8_MMA(0, 1, At, B1); PG8_BAR; PG8_SCHED;
            PG8_LDA(At, 1, 1); PG8_STAGE(PG8_SB(1, 0), b3, voffB); PG8_STAGE(PG8_SB(1, 1), b3 + hstep, voffB); PG8_STAGE(PG8_SA(1, 0), a3, voffA);
            PG8_WAIT_V(8); PG8_WAIT_L(0); PG8_BAR; PG8_MMA(1, 0, At, B0); PG8_MMA(1, 1, At, B1); PG8_BAR; PG8_SCHED;
            if constexpr (Epi::MIDK) { if (t == nt / 2 - 2) E.mid(acc, cur, wr, wc, fr, fq); }
        }
        if (wr == 0) PG8_BAR;
        if constexpr (F8) asm volatile("s_nop 15\n\ts_nop 15" ::: );
        E(acc, cur, wr, wc, fr, fq);
        if (!has_next) break;
#pragma unroll
        for (int a = 0; a < 2; ++a)
#pragma unroll
            for (int b = 0; b < 2; ++b)
#pragma unroll
                for (int m = 0; m < 4; ++m)
#pragma unroll
                    for (int n = 0; n < 2; ++n) acc[a][b][m][n] = (f32x4){0.f, 0.f, 0.f, 0.f};
        cur = nxt; cA = nA; cB = nB; ++ui;
        if (wr == 1) PG8_BAR;
    }
    PG8_WAIT_V(0);
    PG8_BAR;
#undef PG8_SA
#undef PG8_SB
#undef PG8_STAGE
#undef PG8_LDA
#undef PG8_LDB
#undef PG8_MMA
#undef PG8_WAIT_V
#undef PG8_WAIT_L
#undef PG8_BAR
#undef PG8_SCHED
}
}

struct Params {
    const float* x; const int* pos; const float* norm1_g; const float* w_in; const float* q_norm_g; const float* k_norm_g;
    const float* idx_g; const float* idx_b; const float* w_a; const float* pool_mix; const float* pool_scale; const float* w_b;
    const float* w_out; const float* norm2_g; const float* router_w; const float* router_b; const float* w_gu; const float* b_gu;
    const float* w_d; const float* b_d;
    float* out; unsigned char* ws; int ph_lo, ph_hi;
};

using pg8::Unit; using pg8::HALF;
__device__ __forceinline__ void st8(bf16_t* p, const float (&v)[8]) {
    u32x4 w; w.x = cvt_pk_bf16(v[0], v[1]); w.y = cvt_pk_bf16(v[2], v[3]); w.z = cvt_pk_bf16(v[4], v[5]); w.w = cvt_pk_bf16(v[6], v[7]); *(u32x4*)p = w;
}
__device__ __forceinline__ void ld8f(const float* p, float (&v)[8]) { const f32x4 a = *(const f32x4*)p, b = *(const f32x4*)(p + 4); v[0]=a[0]; v[1]=a[1]; v[2]=a[2]; v[3]=a[3]; v[4]=b[0]; v[5]=b[1]; v[6]=b[2]; v[7]=b[3]; }
__device__ __forceinline__ void ld8bf(const bf16_t* p, float (&v)[8]) { const u32x4 w = *(const u32x4*)p; v[0]=bf_lo(w.x); v[1]=bf_hi(w.x); v[2]=bf_lo(w.y); v[3]=bf_hi(w.y); v[4]=bf_lo(w.z); v[5]=bf_hi(w.z); v[6]=bf_lo(w.w); v[7]=bf_hi(w.w); }

struct EpiInProj {
    static constexpr bool MIDK = false;
    bf16_t *Q, *Kb, *Vb, *Qi, *Ki, *Pool, *Ga, *Gp; float* Wi; const float* cs; const float *gq, *gk, *lng, *lnb;
    __device__ __forceinline__ void operator()(const f32x4 (&acc)[2][2][4][2], const Unit& u, int wr, int wc, int fr, int fq) const {
        const int pn = u.pn;
#pragma unroll
        for (int ai = 0; ai < 2; ++ai)
#pragma unroll
            for (int m = 0; m < 4; ++m) {
                const int row = u.pm * 256 + ai * HALF + wr * 64 + m * 16 + fr;
                float v0[8], v1[8];
#pragma unroll
                for (int n = 0; n < 2; ++n)
#pragma unroll
                    for (int i = 0; i < 4; ++i) { v0[4 * n + i] = acc[ai][0][m][n][i]; v1[4 * n + i] = acc[ai][1][m][n][i]; }
                if (pn <= 1 || (pn == 2 && wc < 2)) {
                    float ss = 0.f;
#pragma unroll
                    for (int j = 0; j < 8; ++j) ss += v0[j] * v0[j] + v1[j] * v1[j];
                    ss += __shfl_xor(ss, 16); ss += __shfl_xor(ss, 32);
                    const float rs = 1.0f / sqrtf(ss * (1.0f / 64.0f) + NORM_EPS);
                    const float* gg = (pn <= 1) ? gq : gk; const float sc = (pn <= 1) ? 0.18033688011112042f : 1.0f;
                    float g0[8], g1[8], cc[8], sn[8];
                    ld8f(gg + 8 * fq, g0); ld8f(gg + 32 + 8 * fq, g1);
                    ld8f(cs + (size_t)row * 96 + 8 * fq, cc); ld8f(cs + (size_t)row * 96 + 48 + 8 * fq, sn);
                    float o0[8], o1[8];
#pragma unroll
                    for (int j = 0; j < 8; ++j) { const float x1 = v0[j] * rs * g0[j], x2 = v1[j] * rs * g1[j]; o0[j] = (x1 * cc[j] - x2 * sn[j]) * sc; o1[j] = (x2 * cc[j] + x1 * sn[j]) * sc; }
                    if (pn <= 1) { bf16_t* dst = Q + (size_t)row * 512 + (4 * pn + wc) * 64; st8(dst + 8 * fq, o0); st8(dst + 32 + 8 * fq, o1); }
                    else {
                        bf16_t* dst = Kb + ((((size_t)((row >> 12) * 2 + wc) * 128 + ((row & 4095) >> 5)) * 4 + (fq >> 1)) * 64 + ((fq & 1) * 32 + (row & 31))) * 8;
                        st8(dst, o0); st8(dst + 2 * 512, o1); }
                } else if (pn == 2) {
                    const int t = row & 4095, kk = t & 31;
                    bf16_t* dst = Vb + (((size_t)((row >> 12) * 2 + (wc - 2)) * 128 + (t >> 5)) * 4 + (kk >> 4)) * 512 + (((kk >> 2) & 1) * 32 + 8 * fq) * 8 + 4 * ((kk >> 3) & 1) + (kk & 3);
#pragma unroll
                    for (int j = 0; j < 8; ++j) { dst[j * 8] = (bf16_t)(cvt_pk_bf16(v0[j], v0[j]) & 0xffffu); dst[2 * 512 + j * 8] = (bf16_t)(cvt_pk_bf16(v1[j], v1[j]) & 0xffffu); }
                } else if (pn == 3 || (pn == 4 && wc == 0)) {
                    if (pn == 4) {
                        float s = 0.f;
#pragma unroll
                        for (int j = 0; j < 8; ++j) s += v0[j] + v1[j];
                        s += __shfl_xor(s, 16); s += __shfl_xor(s, 32);
                        const float mu = s * (1.0f / 64.0f); float q = 0.f;
#pragma unroll
                        for (int j = 0; j < 8; ++j) { v0[j] -= mu; v1[j] -= mu; q += v0[j] * v0[j] + v1[j] * v1[j]; }
                        q += __shfl_xor(q, 16); q += __shfl_xor(q, 32);
                        const float rs = 1.0f / sqrtf(q * (1.0f / 64.0f) + NORM_EPS);
                        const int d0 = (fq < 2) ? 8 * fq : 8 * fq + 16, d1 = (fq < 2) ? 16 + 8 * fq : 8 * fq + 32;
                        float a0[8], a1[8], b0[8], b1[8];
                        ld8f(lng + d0, a0); ld8f(lng + d1, a1); ld8f(lnb + d0, b0); ld8f(lnb + d1, b1);
#pragma unroll
                        for (int j = 0; j < 8; ++j) { v0[j] = v0[j] * rs * a0[j] + b0[j]; v1[j] = v1[j] * rs * a1[j] + b1[j]; }
                    }
                    bf16_t* dst = Qi + (size_t)row * 256 + wc * 64;
                    bf16_t* kdst = Ki + (((size_t)(row >> 12) * 128 + ((row & 4095) >> 5)) * 4 * 64 + (row & 31)) * 8;
                    if (fq < 2) {
                        float cc[8], sn[8];
                        ld8f(cs + (size_t)row * 96 + 32 + 8 * fq, cc); ld8f(cs + (size_t)row * 96 + 48 + 32 + 8 * fq, sn);
                        float o0[8], o1[8];
#pragma unroll
                        for (int j = 0; j < 8; ++j) { o0[j] = v0[j] * cc[j] - v1[j] * sn[j]; o1[j] = v1[j] * cc[j] + v0[j] * sn[j]; }
                        if (pn == 3) { st8(dst + 8 * fq, o0); st8(dst + 16 + 8 * fq, o1); }
                        else { st8(kdst + (fq * 32) * 8, o0); st8(kdst + (64 + fq * 32) * 8, o1); }
                    } else {
                        if (pn == 3) { st8(dst + 8 * fq + 16, v0); st8(dst + 8 * fq + 32, v1); }
                        else { st8(kdst + (2 * 64 + (fq - 2) * 32) * 8, v0); st8(kdst + (3 * 64 + (fq - 2) * 32) * 8, v1); } }
                } else if (pn == 4) {
                    if (wc == 1 && fq == 0) *(f32x4*)(Wi + (size_t)row * 4) = (f32x4){v0[0] * 0.0625f, v0[1] * 0.0625f, v0[2] * 0.0625f, v0[3] * 0.0625f};
                } else if (pn <= 6) {
                    bf16_t* dst = Pool + (size_t)row * 512 + (pn - 5) * 256 + wc * 32 + 8 * fq;
                    st8(dst, v0); st8(dst + HALF, v1);
                } else {
                    bf16_t* dst = ((pn <= 10) ? Ga + (size_t)row * 1024 + (pn - 7) * 256 : Gp + (size_t)row * 1024 + (pn - 11) * 256) + wc * 32 + 8 * fq;
#pragma unroll
                    for (int j = 0; j < 8; ++j) { v0[j] = sigmoidf_(v0[j]); v1[j] = sigmoidf_(v1[j]); }
                    st8(dst, v0); st8(dst + HALF, v1);
                }
            }
    }
};

struct EpiGated {
    static constexpr bool MIDK = true;
    const bf16_t* Ga; const bf16_t* Gp; bf16_t* O;
    __device__ __forceinline__ void mid(f32x4 (&acc)[2][2][4][2], const Unit& u, int wr, int wc, int fr, int fq) const {
        asm volatile("" : "+v"(fr), "+v"(fq));
#pragma unroll
        for (int ai = 0; ai < 2; ++ai)
#pragma unroll
            for (int m = 0; m < 4; ++m) {
                const size_t off = (size_t)(u.pm * 256 + ai * HALF + wr * 64 + m * 16 + fr) * 1024 + u.pn * 256 + wc * 32 + 8 * fq;
#pragma unroll
                for (int bj = 0; bj < 2; ++bj) {
                    float ga[8], gp[8]; ld8bf(Ga + off + bj * HALF, ga); ld8bf(Gp + off + bj * HALF, gp);
#pragma unroll
                    for (int n = 0; n < 2; ++n)
#pragma unroll
                        for (int i = 0; i < 4; ++i) acc[ai][bj][m][n][i] *= ga[4 * n + i] * __builtin_amdgcn_rcpf(fmaxf(gp[4 * n + i], 1e-30f));
                }
                if (m & 1) asm volatile("" ::: "memory");
            }
    }
    __device__ __forceinline__ void operator()(const f32x4 (&acc)[2][2][4][2], const Unit& u, int wr, int wc, int fr, int fq) const {
        asm volatile("" : "+v"(fr), "+v"(fq));
#pragma unroll
        for (int ai = 0; ai < 2; ++ai)
#pragma unroll
            for (int m = 0; m < 4; ++m) {
                const size_t off = (size_t)(u.pm * 256 + ai * HALF + wr * 64 + m * 16 + fr) * 1024 + u.pn * 256 + wc * 32 + 8 * fq;
#pragma unroll
                for (int bj = 0; bj < 2; ++bj) {
                    float g[8], o[8]; ld8bf(Gp + off + bj * HALF, g);
#pragma unroll
                    for (int n = 0; n < 2; ++n)
#pragma unroll
                        for (int i = 0; i < 4; ++i) o[4 * n + i] = g[4 * n + i] * acc[ai][bj][m][n][i];
                    st8(O + off + bj * HALF, o);
                }
            }
    }
};
struct EpiResid {
    static constexpr bool MIDK = false;
    const float* X; float* O;
    __device__ __forceinline__ void operator()(const f32x4 (&acc)[2][2][4][2], const Unit& u, int wr, int wc, int fr, int fq) const {
#pragma unroll
        for (int ai = 0; ai < 2; ++ai)
#pragma unroll
            for (int m = 0; m < 4; ++m) {
                const size_t off = (size_t)(u.pm * 256 + ai * HALF + wr * 64 + m * 16 + fr) * 1024 + u.pn * 256 + wc * 32 + 8 * fq;
#pragma unroll
                for (int bj = 0; bj < 2; ++bj)
#pragma unroll
                    for (int n = 0; n < 2; ++n) { const size_t o = off + bj * HALF + 4 * n; *(f32x4*)(O + o) = *(const f32x4*)(X + o) + acc[ai][bj][m][n]; }
            }
    }
};
struct EpiGateUp {
    static constexpr bool MIDK = false;
    const float* bias; unsigned char* Act;
    __device__ __forceinline__ void operator()(const f32x4 (&acc)[2][2][4][2], const Unit& u, int wr, int wc, int fr, int fq) const {
        { int t_ = threadIdx.x; asm volatile("" : "+v"(t_)); fr = t_ & 15; fq = (t_ >> 4) & 3; }
        const int e = u.pn >> 3, pnl = u.pn & 7, col = pnl * 128 + wc * 32 + 8 * fq;
        float bg[8], bu[8]; ld8f(bias + (size_t)e * 2048 + col, bg); ld8f(bias + (size_t)e * 2048 + 1024 + col, bu);
#pragma unroll
        for (int ai = 0; ai < 2; ++ai)
#pragma unroll
            for (int m = 0; m < 4; ++m) {
                const size_t row = (size_t)(u.pm * 256 + ai * HALF + wr * 64 + m * 16 + fr);
                float o[8];
#pragma unroll
                for (int n = 0; n < 2; ++n)
#pragma unroll
                    for (int i = 0; i < 4; ++i) { const int j = 4 * n + i;
                        const float gt = fminf(acc[ai][0][m][n][i] * MOE_WINV + bg[j], 7.0f), up = fminf(fmaxf(acc[ai][1][m][n][i] * MOE_WINV + bu[j], -7.0f), 7.0f);
                        o[j] = gt * __builtin_amdgcn_rcpf(1.0f + __builtin_amdgcn_exp2f(-2.4554669595930156f * gt)) * (up + 1.0f); }
                u32x2 w; w.x = pk4_fp8(o[0], o[1], o[2], o[3]); w.y = pk4_fp8(o[4], o[5], o[6], o[7]);
                *(u32x2*)(Act + row * 1024 + col) = w;
            }
    }
};
struct EpiDown {
    static constexpr bool MIDK = false;
    const float* bias; const float* sgate; unsigned char* Y;
    __device__ __forceinline__ void operator()(const f32x4 (&acc)[2][2][4][2], const Unit& u, int wr, int wc, int fr, int fq) const {
        { int t_ = threadIdx.x; asm volatile("" : "+v"(t_)); fr = t_ & 15; fq = (t_ >> 4) & 3; }
        const int e = u.pn >> 2, pnl = u.pn & 3, col = pnl * 256 + wc * 32 + 8 * fq;
        float b0[8], b1[8]; ld8f(bias + (size_t)e * 1024 + col, b0); ld8f(bias + (size_t)e * 1024 + col + HALF, b1);
#pragma unroll
        for (int ai = 0; ai < 2; ++ai)
#pragma unroll
            for (int m = 0; m < 4; ++m) {
                const size_t row = (size_t)(u.pm * 256 + ai * HALF + wr * 64 + m * 16 + fr);
                const float gt = sgate[row] * Y_SCALE;
                float o0[8], o1[8];
#pragma unroll
                for (int n = 0; n < 2; ++n)
#pragma unroll
                    for (int i = 0; i < 4; ++i) { const int j = 4 * n + i; o0[j] = (acc[ai][0][m][n][i] * MOE_WINV + b0[j]) * gt; o1[j] = (acc[ai][1][m][n][i] * MOE_WINV + b1[j]) * gt; }
                u32x2 w0, w1; w0.x = pk4_fp8(o0[0], o0[1], o0[2], o0[3]); w0.y = pk4_fp8(o0[4], o0[5], o0[6], o0[7]); w1.x = pk4_fp8(o1[0], o1[1], o1[2], o1[3]); w1.y = pk4_fp8(o1[4], o1[5], o1[6], o1[7]);
                *(u32x2*)(Y + row * 1024 + col) = w0; *(u32x2*)(Y + row * 1024 + col + HALF) = w1;
            }
    }
};

template <class RowMap>
__device__ __forceinline__ void cvt_item(const float* W, int K, int N, bf16_t* WT, LAS float* scr, int kb, int nb, int lane, const RowMap& rm, int ldt = 0) {
    if (ldt == 0) ldt = K;
    const int k0 = kb * 64, n0 = nb * 64, n4 = lane & 15, kr = lane >> 4, n = n0 + 4 * n4;
    f32x4 v[16];
#pragma unroll
    for (int i = 0; i < 16; ++i) v[i] = (n < N) ? *(const f32x4*)(W + (size_t)(k0 + 4 * i + kr) * N + n) : (f32x4){0.f, 0.f, 0.f, 0.f};
#pragma unroll
    for (int i = 0; i < 16; ++i) { LAS float* d = scr + (4 * i + kr) * 65 + 4 * n4; d[0] = v[i][0]; d[1] = v[i][1]; d[2] = v[i][2]; d[3] = v[i][3]; }
    LDS_WAIT(); asm volatile("" ::: "memory");
    const int c8 = lane & 7;
#pragma unroll
    for (int jj = 0; jj < 8; ++jj) { const int nn = (lane >> 3) + 8 * jj; const LAS float* s = scr + (8 * c8) * 65 + nn;
        if (n0 + nn < N) { u32x4 o; o.x = cvt_pk_bf16(s[0], s[65]); o.y = cvt_pk_bf16(s[2 * 65], s[3 * 65]); o.z = cvt_pk_bf16(s[4 * 65], s[5 * 65]); o.w = cvt_pk_bf16(s[6 * 65], s[7 * 65]);
            *(u32x4*)(WT + (size_t)rm(n0 + nn) * ldt + k0 + 8 * c8) = o; } }
    LDS_WAIT(); asm volatile("" ::: "memory");
}
template <class RowMap>
__device__ __forceinline__ void cvt_item_f8(const float* W, int K, int N, unsigned char* WT, LAS float* scr, int kb, int nb, int lane, const RowMap& rm, float scale) {
    const int k0 = kb * 64, n0 = nb * 64, n4 = lane & 15, kr = lane >> 4, n = n0 + 4 * n4;
    f32x4 v[16];
#pragma unroll
    for (int i = 0; i < 16; ++i) v[i] = *(const f32x4*)(W + (size_t)(k0 + 4 * i + kr) * N + n);
#pragma unroll
    for (int i = 0; i < 16; ++i) { LAS float* d = scr + (4 * i + kr) * 65 + 4 * n4; d[0] = v[i][0] * scale; d[1] = v[i][1] * scale; d[2] = v[i][2] * scale; d[3] = v[i][3] * scale; }
    LDS_WAIT(); asm volatile("" ::: "memory");
    const int c8 = lane & 7;
#pragma unroll
    for (int jj = 0; jj < 8; ++jj) { const int nn = (lane >> 3) + 8 * jj; const LAS float* sp = scr + (8 * c8) * 65 + nn;
        u32x2 o; o.x = pk4_fp8(sp[0], sp[65], sp[2 * 65], sp[3 * 65]); o.y = pk4_fp8(sp[4 * 65], sp[5 * 65], sp[6 * 65], sp[7 * 65]);
        *(u32x2*)(WT + (size_t)rm(n0 + nn) * K + k0 + 8 * c8) = o; }
    LDS_WAIT(); asm volatile("" ::: "memory");
}
struct RmIdent { int off; __device__ __forceinline__ int operator()(int n) const { return off + n; } };
struct RmWin { __device__ __forceinline__ int operator()(int n) const { return win_phys(n); } };
struct RmGu { int e; __device__ __forceinline__ int operator()(int n) const { return e * 2048 + 256 * ((n & 1023) >> 7) + 128 * (n >> 10) + (n & 127); } };

struct CvtItem { const float* W; int N, K, k0, n0, kind, e; };
__device__ __forceinline__ CvtItem cvt_decode(const Params& p, int it) {
    constexpr int I_GU = NEXP * 16 * 32, I_D = NEXP * 16 * 16, I_IN = 16 * 58, I_A = 8 * 16;
    CvtItem d; int r = it;
    if (r < I_GU) { const int e = r / 512, q = r % 512; d.W = p.w_gu + (size_t)e * 1024 * 2048; d.N = 2048; d.K = 1024; d.k0 = (q / 32) * 64; d.n0 = (q % 32) * 64; d.kind = 0; d.e = e; return d; } r -= I_GU;
    if (r < I_D) { const int e = r / 256, q = r % 256; d.W = p.w_d + (size_t)e * 1024 * 1024; d.N = 1024; d.K = 1024; d.k0 = (q / 16) * 64; d.n0 = (q % 16) * 64; d.kind = 1; d.e = e; return d; } r -= I_D;
    if (r < I_IN) { d.W = p.w_in; d.N = INW; d.K = 1024; d.k0 = (r / 58) * 64; d.n0 = (r % 58) * 64; d.kind = 2; d.e = 0; return d; } r -= I_IN;
    if (r < I_A) { d.W = p.w_a; d.N = 1024; d.K = 512; d.k0 = (r / 16) * 64; d.n0 = (r % 16) * 64; d.kind = 3; d.e = 0; return d; } r -= I_A;
    d.W = p.w_out; d.N = 1024; d.K = 1024; d.k0 = (r / 16) * 64; d.n0 = (r % 16) * 64; d.kind = 4; d.e = 0; return d;
}
__device__ __forceinline__ void cvt_load(const CvtItem& d, int lane, f32x4 (&v)[16]) {
    const int n = d.n0 + 4 * (lane & 15), kr = lane >> 4;
#pragma unroll
    for (int i = 0; i < 16; ++i) v[i] = (n < d.N) ? *(const f32x4*)(d.W + (size_t)(d.k0 + 4 * i + kr) * d.N + n) : (f32x4){0.f, 0.f, 0.f, 0.f};
}
__device__ __forceinline__ void cvt_finish(const CvtItem& d, unsigned char* ws, LAS float* scr, int lane, const f32x4 (&v)[16]) {
    const int n4 = lane & 15, kr = lane >> 4; const float sc = (d.kind < 2) ? MOE_WSCALE : 1.0f;
#pragma unroll
    for (int i = 0; i < 16; ++i) { LAS float* q = scr + (4 * i + kr) * 65 + 4 * n4; q[0] = v[i][0] * sc; q[1] = v[i][1] * sc; q[2] = v[i][2] * sc; q[3] = v[i][3] * sc; }
    LDS_WAIT(); asm volatile("" ::: "memory");
    const int c8 = lane & 7;
#pragma unroll
    for (int jj = 0; jj < 8; ++jj) { const int nn = (lane >> 3) + 8 * jj, n = d.n0 + nn; const LAS float* sp = scr + (8 * c8) * 65 + nn;
        if (n < d.N) {
            if (d.kind < 2) {
                const int prow = (d.kind == 0) ? d.e * 2048 + 256 * ((n & 1023) >> 7) + 128 * (n >> 10) + (n & 127) : d.e * 1024 + n;
                u32x2 o; o.x = pk4_fp8(sp[0], sp[65], sp[2 * 65], sp[3 * 65]); o.y = pk4_fp8(sp[4 * 65], sp[5 * 65], sp[6 * 65], sp[7 * 65]);
                *(u32x2*)(ws + (d.kind == 0 ? WS_WGU : WS_WD) + (size_t)prow * 1024 + d.k0 + 8 * c8) = o;
            } else {
                u32x4 o; o.x = cvt_pk_bf16(sp[0], sp[65]); o.y = cvt_pk_bf16(sp[2 * 65], sp[3 * 65]); o.z = cvt_pk_bf16(sp[4 * 65], sp[5 * 65]); o.w = cvt_pk_bf16(sp[6 * 65], sp[7 * 65]);
                bf16_t* dst = (d.kind == 2) ? (bf16_t*)(ws + WS_WIN) + (size_t)win_phys(n) * 1024 : (d.kind == 3) ? (bf16_t*)(ws + WS_WCAT) + (size_t)n * 1024 : (bf16_t*)(ws + WS_WOUT) + (size_t)n * 1024;
                *(u32x4*)(dst + d.k0 + 8 * c8) = o;
            }
        } }
    LDS_WAIT(); asm volatile("" ::: "memory");
}

__device__ __forceinline__ void phase0(const Params& p, LAS unsigned char* lds, int bid, int G) {
    const int tid = threadIdx.x, lane = tid & 63, wave = __builtin_amdgcn_readfirstlane(tid >> 6);
    const int gw = bid * NWAVES + wave, NGW = G * NWAVES;
    unsigned char* ws = p.ws;
    LAS float* scr = (LAS float*)(lds + wave * 16640);
    constexpr int NITEMS = NEXP * 16 * 32 + NEXP * 16 * 16 + 16 * 58 + 8 * 16 + 16 * 16;
    {
        f32x4 vA[16], vB[16];
        int it = gw;
        if (it < NITEMS) {
            CvtItem dA = cvt_decode(p, it), dB = dA; cvt_load(dA, lane, vA);
            for (;;) {
                const int i1 = it + NGW; if (i1 < NITEMS) { dB = cvt_decode(p, i1); cvt_load(dB, lane, vB); }
                cvt_finish(dA, ws, scr, lane, vA); if (i1 >= NITEMS) break;
                const int i2 = i1 + NGW; if (i2 < NITEMS) { dA = cvt_decode(p, i2); cvt_load(dA, lane, vA); }
                cvt_finish(dB, ws, scr, lane, vB); if (i2 >= NITEMS) break;
                it = i2;
            }
        }
    }
    for (int it = gw; it < 16 * 4 * 32; it += NGW) {
        const int nb = it & 15, g = (it >> 4) & 3, cb = it >> 6, n = nb * 64 + lane, c0 = cb * 4;
        float a[4];
#pragma unroll
        for (int q = 0; q < 4; ++q) a[q] = 0.f;
        const float* mix = p.pool_mix + (size_t)g * 128 * 128 + (size_t)c0 * 128;
        for (int d0 = 0; d0 < 128; d0 += 16) {
            float wb[16];
#pragma unroll
            for (int dd = 0; dd < 16; ++dd) wb[dd] = p.w_b[(size_t)(g * 128 + d0 + dd) * 1024 + n];
#pragma unroll
            for (int dd = 0; dd < 16; ++dd) { const float w = p.pool_scale[g * 128 + d0 + dd] * wb[dd];
#pragma unroll
                for (int q = 0; q < 4; ++q) a[q] += mix[q * 128 + d0 + dd] * w; }
        }
        { u32x2 w; w.x = cvt_pk_bf16(a[0], a[1]); w.y = cvt_pk_bf16(a[2], a[3]); *(u32x2*)((bf16_t*)(ws + WS_WCAT) + (size_t)n * 1024 + 512 + g * 128 + c0) = w; }
    }
    {
        f32x4 gv[4];
#pragma unroll
        for (int j = 0; j < 4; ++j) gv[j] = *(const f32x4*)(p.norm1_g + 4 * lane + 256 * j);
        bf16_t* XN = (bf16_t*)(ws + WS_XN);
        for (int m0 = gw * 4; m0 < NTOK; m0 += NGW * 4) {
            f32x4 v[4][4];
#pragma unroll
            for (int r = 0; r < 4; ++r) { const f32x4* xr = (const f32x4*)(p.x + (size_t)(m0 + r) * D) + lane;
#pragma unroll
                for (int j = 0; j < 4; ++j) v[r][j] = xr[64 * j]; }
#pragma unroll
            for (int r = 0; r < 4; ++r) { float sq = 0.f;
#pragma unroll
                for (int j = 0; j < 4; ++j) sq += (v[r][j].x * v[r][j].x + v[r][j].y * v[r][j].y) + (v[r][j].z * v[r][j].z + v[r][j].w * v[r][j].w);
                const float rs = 1.0f / sqrtf(wave_sum(sq) * (1.0f / D) + NORM_EPS);
#pragma unroll
                for (int j = 0; j < 4; ++j) { const f32x4 o = v[r][j] * rs * gv[j]; u32x2 w; w.x = cvt_pk_bf16(o.x, o.y); w.y = cvt_pk_bf16(o.z, o.w); *(u32x2*)(XN + (size_t)(m0 + r) * D + 4 * lane + 256 * j) = w; } }
        }
    }
    {
        LAS float* invf = (LAS float*)(lds + MISC_OFF + 9216);
        __syncthreads();
        if (tid < 48) invf[tid] = powf(10000.0f, (tid < 32) ? -(float)tid / 32.0f : -(float)(tid - 32) / 16.0f);
        __syncthreads();
        float* cs = (float*)(ws + WS_CS);
        for (int i = bid * NTHREADS + tid; i < NTOK * 48; i += G * NTHREADS) {
            const int row = i / 48, j = i % 48;
            const float ang = (float)p.pos[row] * invf[j];
            const float n = rintf(ang * 0.6366197723675814f);
            float r = fmaf(-n, 1.5707962512969971f, ang); r = fmaf(-n, 7.5497894158615964e-08f, r); r = fmaf(-n, 5.3903029534742384e-15f, r);
            const float t = r * 0.15915494309189535f;
            const float s0 = __builtin_amdgcn_sinf(t), c0 = __builtin_amdgcn_cosf(t);
            const int qd = (int)n & 3;
            const float sn = (qd == 0) ? s0 : (qd == 1) ? c0 : (qd == 2) ? -s0 : -c0;
            const float cc = (qd == 0) ? c0 : (qd == 1) ? -s0 : (qd == 2) ? -c0 : s0;
            cs[(size_t)row * 96 + j] = cc; cs[(size_t)row * 96 + 48 + j] = sn;
        }
    }
}

__device__ __forceinline__ void pool_phase(const Params& p, int bid, int G) {
    const int tid = threadIdx.x, lane = tid & 63, wave = __builtin_amdgcn_readfirstlane(tid >> 6);
    const int gw = bid * NWAVES + wave, NGW = G * NWAVES;
    const bf16_t* Pool = (const bf16_t*)(p.ws + WS_POOL); bf16_t* Mixed = (bf16_t*)(p.ws + WS_ACAT) + 512;
    const int w = 2 << (lane >> 4);
    for (int it = gw; it < NBATCH * 256; it += NGW) {
        const int b = it >> 8, tb = (it & 255) * 16;
        const bf16_t* P = Pool + (size_t)b * SEQ * 512 + 8 * lane;
        float sum[8];
#pragma unroll
        for (int q = 0; q < 8; ++q) sum[q] = 0.f;
        for (int d = 1; d < 16; ++d) if (d < w && tb - d >= 0) { float v[8]; ld8bf(P + (size_t)(tb - d) * 512, v);
#pragma unroll
            for (int q = 0; q < 8; ++q) sum[q] += v[q]; }
        for (int t = tb; t < tb + 16; ++t) {
            float cur[8]; ld8bf(P + (size_t)t * 512, cur);
#pragma unroll
            for (int q = 0; q < 8; ++q) sum[q] += cur[q];
            const float inv = 1.0f / (float)((t + 1 < w) ? t + 1 : w);
            float o[8];
#pragma unroll
            for (int q = 0; q < 8; ++q) o[q] = sum[q] * inv - cur[q];
            st8(Mixed + ((size_t)b * SEQ + t) * 1024 + 8 * lane, o);
            if (t - w + 1 >= 0) { float old[8]; ld8bf(P + (size_t)(t - w + 1) * 512, old);
#pragma unroll
                for (int q = 0; q < 8; ++q) sum[q] -= old[q]; }
        }
    }
}

__device__ __forceinline__ int wave_sum_i(int v) {
    v += __builtin_amdgcn_update_dpp(0, v, 0xB1, 0xF, 0xF, true);
    v += __builtin_amdgcn_update_dpp(0, v, 0x4E, 0xF, 0xF, true);
    v += __builtin_amdgcn_update_dpp(0, v, 0x141, 0xF, 0xF, true);
    v += __builtin_amdgcn_update_dpp(0, v, 0x140, 0xF, 0xF, true);
    v += __builtin_amdgcn_update_dpp(0, v, 0x142, 0xA, 0xF, true);
    v += __builtin_amdgcn_update_dpp(0, v, 0x143, 0xC, 0xF, true);
    return __builtin_amdgcn_readlane(v, 63);
}
__device__ __forceinline__ int count_ge(const unsigned (&key)[64], int nj, unsigned mid) {
    unsigned a0 = 0u, a1 = 0u; int nproc = 0;
#pragma unroll
    for (int jb = 0; jb < 4; ++jb) if (jb * 8 < nj) { nproc += 8;
#pragma unroll
        for (int q = 0; q < 8; ++q) a0 = __builtin_amdgcn_alignbit(a0, key[jb * 8 + q] - mid, 31); }
#pragma unroll
    for (int jb = 4; jb < 8; ++jb) if (jb * 8 < nj) { nproc += 8;
#pragma unroll
        for (int q = 0; q < 8; ++q) a1 = __builtin_amdgcn_alignbit(a1, key[jb * 8 + q] - mid, 31); }
    const int lt = wave_sum_i(__builtin_popcount(a0) + __builtin_popcount(a1));
    return 64 * nproc - lt;
}
__device__ __forceinline__ int lane_prefix(unsigned long long m) { return __builtin_amdgcn_mbcnt_hi((unsigned)(m >> 32), __builtin_amdgcn_mbcnt_lo((unsigned)m, 0u)); }
__device__ __forceinline__ unsigned wave_umax(unsigned v) {
#pragma unroll
    for (int o = 1; o < 64; o <<= 1) { const unsigned t = (unsigned)__shfl_xor((int)v, o); v = t > v ? t : v; }
    return (unsigned)__builtin_amdgcn_readfirstlane((int)v);
}
__device__ __forceinline__ unsigned wave_umin(unsigned v) {
#pragma unroll
    for (int o = 1; o < 64; o <<= 1) { const unsigned t = (unsigned)__shfl_xor((int)v, o); v = t < v ? t : v; }
    return (unsigned)__builtin_amdgcn_readfirstlane((int)v);
}

__device__ __forceinline__ void select_unit(const Params& p, LAS unsigned char* lds, int b, int t0) {
    int tid = threadIdx.x; asm volatile("" : "+v"(tid));
    const int lane = tid & 63, wave = __builtin_amdgcn_readfirstlane(tid >> 6);
    unsigned char* wsq = p.ws; asm volatile("" : "+s"(wsq));
    const GAS bf16_t* Qi = (const GAS bf16_t*)(wsq + WS_QI); const GAS bf16_t* Ki = (const GAS bf16_t*)(wsq + WS_KI); const GAS float* Wi = (const GAS float*)(wsq + WS_WI);
    GAS unsigned* M32 = (GAS unsigned*)(wsq + WS_MASK);
    LAS float* SC = (LAS float*)lds;
    const int c = t0 >> 6, nj = c + 1, nk = 64 * nj, ntile = nk >> 5;
    const size_t tok0 = (size_t)b * SEQ + t0;
    {
        const int r = lane & 31, hh = lane >> 5;
        bf16x8 qa[4];
        const GAS bf16_t* qp = Qi + (tok0 + (r >> 2)) * 256 + (r & 3) * 64 + 8 * hh;
#pragma unroll
        for (int ks = 0; ks < 4; ++ks) qa[ks] = *(const GAS bf16x8*)(qp + 16 * ks);
        f32x4 wv[4];
#pragma unroll
        for (int g = 0; g < 4; ++g) wv[g] = *(const GAS f32x4*)(Wi + (tok0 + 2 * g + hh) * 4);
        const GAS bf16_t* kif = Ki + (size_t)b * 128 * 4 * 512 + lane * 8;
        bf16x8 kbA[4][4], kbB[4][4];
#define LOADK(dst, k0) do { _Pragma("unroll") for (int u = 0; u < 4; ++u) { const int kt = ((k0) + u < ntile) ? (k0) + u : (k0); \
            _Pragma("unroll") for (int ks = 0; ks < 4; ++ks) dst[u][ks] = *(const GAS bf16x8*)(kif + (size_t)(kt * 4 + ks) * 512); } } while (0)
#define COMPK(src, k0) do { _Pragma("unroll") for (int u = 0; u < 4; ++u) if ((k0) + u < ntile) { f32x16 acc; \
            _Pragma("unroll") for (int q = 0; q < 16; ++q) acc[q] = 0.f; \
            _Pragma("unroll") for (int ks = 0; ks < 4; ++ks) acc = __builtin_amdgcn_mfma_f32_32x32x16_bf16(qa[ks], src[u][ks], acc, 0, 0, 0); \
            _Pragma("unroll") for (int g = 0; g < 4; ++g) { float sv = fmaf(wv[g][0], fmaxf(acc[4 * g], 0.f), 0.0f); \
                sv = fmaf(wv[g][1], fmaxf(acc[4 * g + 1], 0.f), sv); sv = fmaf(wv[g][2], fmaxf(acc[4 * g + 2], 0.f), sv); sv = fmaf(wv[g][3], fmaxf(acc[4 * g + 3], 0.f), sv); \
                SC[(2 * g + hh) * 4096 + ((k0) + u) * 32 + r] = sv; } } } while (0)
        int kt0 = wave * 4;
        if (kt0 < ntile) {
            LOADK(kbA, kt0);
            for (;;) {
                const int k1 = kt0 + NWAVES * 4; if (k1 < ntile) LOADK(kbB, k1);
                COMPK(kbA, kt0); if (k1 >= ntile) break;
                const int k2 = k1 + NWAVES * 4; if (k2 < ntile) LOADK(kbA, k2);
                COMPK(kbB, k1); if (k2 >= ntile) break;
                kt0 = k2;
            }
        }
#undef LOADK
#undef COMPK
    }
    __syncthreads();
    LAS float* row = SC + wave * 4096;
    unsigned key[64];
#pragma unroll
    for (int jb = 0; jb < 8; ++jb) {
#pragma unroll
        for (int q = 0; q < 8; ++q) key[jb * 8 + q] = 0u;
        if (jb * 8 < nj) {
#pragma unroll
            for (int q = 0; q < 8; ++q) { const int j = jb * 8 + q; const unsigned u = __float_as_uint(row[j * 64 + lane]); const unsigned kk = ((u & 0x80000000u) ? ~u : (u | 0x80000000u)) >> 1; key[j] = (j < nj) ? kk : 0u; }
        }
    }
    LDS_WAIT(); __syncthreads();
    unsigned hiSel = 1u, T = 0u; int rrem = 0;
    if (nk > 256) {
        unsigned g0 = 0u, g1 = 0u, g2 = 0u, g3 = 0u;
#pragma unroll
        for (int j = 0; j < 64; j += 4) { g0 = key[j] > g0 ? key[j] : g0; g1 = key[j + 1] > g1 ? key[j + 1] : g1; g2 = key[j + 2] > g2 ? key[j + 2] : g2; g3 = key[j + 3] > g3 ? key[j + 3] : g3; }
        const unsigned mx01 = g0 > g1 ? g0 : g1, mx23 = g2 > g3 ? g2 : g3, mn01 = g0 < g1 ? g0 : g1, mn23 = g2 < g3 ? g2 : g3;
        const unsigned km = wave_umax(mx01 > mx23 ? mx01 : mx23);
        unsigned lo = wave_umin(mn01 < mn23 ? mn01 : mn23), hi = km + 1u; int cnt_hi = 0; bool exact = false;
        while (hi - lo > 1u) {
            const unsigned mid = lo + ((hi - lo) >> 1);
            const int cnt = count_ge(key, nj, mid);
            if (cnt >= 256) { lo = mid; if (cnt == 256) { exact = true; break; } } else { hi = mid; cnt_hi = cnt; }
        }
        if (exact) { hiSel = lo; T = 0u; rrem = 0; } else { hiSel = hi; T = lo; rrem = 256 - cnt_hi; }
    }
    GAS unsigned* mrow = M32 + (tok0 + wave) * 128;
    unsigned mlo = 0u, mhi = 0u;
    if (rrem == 0) {
#pragma unroll
        for (int j = 0; j < 64; ++j) if ((j & ~7) < nj) {
            const unsigned long long sm = __ballot(key[j] >= hiSel);
            mlo = (lane == j) ? (unsigned)sm : mlo; mhi = (lane == j) ? (unsigned)(sm >> 32) : mhi;
        }
    } else {
#pragma unroll
        for (int j = 0; j < 64; ++j) if ((j & ~7) < nj) {
            const bool eq = (key[j] == T);
            const unsigned long long eqm = __ballot(eq);
            const bool take = eq && (lane_prefix(eqm) < rrem);
            const int ne = __popcll(eqm); rrem = (ne < rrem) ? rrem - ne : 0;
            const unsigned long long sm = __ballot((key[j] >= hiSel) || take);
            mlo = (lane == j) ? (unsigned)sm : mlo; mhi = (lane == j) ? (unsigned)(sm >> 32) : mhi;
        }
    }
    *(GAS u32x2*)(mrow + 2 * lane) = (u32x2){mlo, mhi};
}

__device__ __forceinline__ void dense_attn_chunk(const Params& p, int b, int c) {
    int tid = threadIdx.x; asm volatile("" : "+v"(tid));
    const int lane = tid & 63, wave = __builtin_amdgcn_readfirstlane(tid >> 6);
    unsigned char* wsq = p.ws; asm volatile("" : "+s"(wsq));
    const GAS bf16_t* Qb = (const GAS bf16_t*)(wsq + WS_Q); const GAS bf16_t* Kb = (const GAS bf16_t*)(wsq + WS_K); const GAS bf16_t* VT = (const GAS bf16_t*)(wsq + WS_VT);
    const GAS unsigned* M32 = (const GAS unsigned*)(wsq + WS_MASK); GAS bf16_t* Attn = (GAS bf16_t*)(wsq + WS_ACAT);
    float mq = fabsf(p.q_norm_g[lane]), mk = fabsf(p.k_norm_g[lane]);
#pragma unroll
    for (int o = 1; o < 64; o <<= 1) { mq = fmaxf(mq, __shfl_xor(mq, o)); mk = fmaxf(mk, __shfl_xor(mk, o)); }
    const float negC = -(8.0f * mq * mk * 1.4426950408889634f * 1.03f);
    const int kvh = wave >> 2, cl = lane & 31, hi = lane >> 5, ntile = 2 * (c + 1);
    const size_t tokc = (size_t)b * SEQ + 64 * c + 16 * (wave & 3);
    bf16x8 qf[2][4]; const GAS unsigned* mrow[2]; size_t tokq[2];
#pragma unroll
    for (int ti = 0; ti < 2; ++ti) { tokq[ti] = tokc + 8 * ti + (cl >> 2); mrow[ti] = M32 + tokq[ti] * 128;
#pragma unroll
        for (int ks = 0; ks < 4; ++ks) qf[ti][ks] = *(const GAS bf16x8*)(Qb + tokq[ti] * 512 + (4 * kvh + (cl & 3)) * 64 + 16 * ks + 8 * hi); }
    f32x16 o[2][2]; float lsum[2] = {0.f, 0.f};
#pragma unroll
    for (int ti = 0; ti < 2; ++ti)
#pragma unroll
        for (int dt = 0; dt < 2; ++dt)
#pragma unroll
            for (int q = 0; q < 16; ++q) o[ti][dt][q] = 0.f;
    const GAS bf16_t* kbase = Kb + (size_t)(b * 2 + kvh) * 128 * 4 * 512 + lane * 8;
    const GAS bf16_t* vbase = VT + (size_t)(b * 2 + kvh) * 128 * 4 * 512 + lane * 8;
    bf16x8 kfA[4], kfB[4], vfA[4], vfB[4]; unsigned mwA[2], mwB[2];
#define LOADT(kf, vf, mw, kt) do { _Pragma("unroll") for (int q = 0; q < 4; ++q) { kf[q] = *(const GAS bf16x8*)(kbase + (size_t)((kt) * 4 + q) * 512); vf[q] = *(const GAS bf16x8*)(vbase + (size_t)((kt) * 4 + q) * 512); } \
        mw[0] = mrow[0][kt]; mw[1] = mrow[1][kt]; } while (0)
#define COMPT(kf, vf, mw) do { _Pragma("unroll") for (int ti = 0; ti < 2; ++ti) { f32x16 sa; const unsigned mwh = mw[ti] >> (4 * hi); \
        _Pragma("unroll") for (int q = 0; q < 16; ++q) sa[q] = negC; \
        _Pragma("unroll") for (int ks = 0; ks < 4; ++ks) sa = __builtin_amdgcn_mfma_f32_32x32x16_bf16(kf[ks], qf[ti][ks], sa, 0, 0, 0); \
        float pv[16]; float ls = 0.f; \
        _Pragma("unroll") for (int r = 0; r < 16; ++r) { const int pos = (r & 3) + 8 * (r >> 2); \
            const float e = __builtin_amdgcn_exp2f(sa[r]); const int m = __builtin_amdgcn_sbfe((int)mwh, pos, 1); \
            pv[r] = __uint_as_float(__float_as_uint(e) & (unsigned)m); ls += pv[r]; } \
        lsum[ti] += ls; \
        _Pragma("unroll") for (int sx = 0; sx < 2; ++sx) { \
            u32x4 pw; pw.x = cvt_pk_bf16(pv[8 * sx], pv[8 * sx + 1]); pw.y = cvt_pk_bf16(pv[8 * sx + 2], pv[8 * sx + 3]); pw.z = cvt_pk_bf16(pv[8 * sx + 4], pv[8 * sx + 5]); pw.w = cvt_pk_bf16(pv[8 * sx + 6], pv[8 * sx + 7]); \
            const bf16x8 pb = __builtin_bit_cast(bf16x8, pw); \
            _Pragma("unroll") for (int dt = 0; dt < 2; ++dt) o[ti][dt] = __builtin_amdgcn_mfma_f32_32x32x16_bf16(vf[dt * 2 + sx], pb, o[ti][dt], 0, 0, 0); } } } while (0)
    LOADT(kfA, vfA, mwA, 0);
    for (int kt = 0; kt < ntile; kt += 2) {
        LOADT(kfB, vfB, mwB, kt + 1);
        COMPT(kfA, vfA, mwA);
        if (kt + 2 < ntile) LOADT(kfA, vfA, mwA, kt + 2);
        COMPT(kfB, vfB, mwB);
    }
#undef LOADT
#undef COMPT
    int lane2 = lane; asm volatile("" : "+v"(lane2));
    const int cl2 = lane2 & 31, hi2 = lane2 >> 5;
#pragma unroll
    for (int ti = 0; ti < 2; ++ti) {
        const float lt = lsum[ti] + __shfl_xor(lsum[ti], 32); const float inv = 1.0f / lt;
        GAS bf16_t* dst = Attn + (tokc + 8 * ti + (cl2 >> 2)) * 1024 + (4 * kvh + (cl2 & 3)) * 64 + 4 * hi2;
#pragma unroll
        for (int dt = 0; dt < 2; ++dt)
#pragma unroll
            for (int g4 = 0; g4 < 4; ++g4) { u32x2 w; w.x = cvt_pk_bf16(o[ti][dt][4 * g4] * inv, o[ti][dt][4 * g4 + 1] * inv); w.y = cvt_pk_bf16(o[ti][dt][4 * g4 + 2] * inv, o[ti][dt][4 * g4 + 3] * inv);
                *(GAS u32x2*)(dst + 32 * dt + 8 * g4) = w; }
    }
}

__device__ __forceinline__ void attn_phase(const Params& p, LAS unsigned char* lds, int bid, int G) {
    for (;;) {
        if (threadIdx.x == 0) { unsigned* ctr = (unsigned*)(p.ws + WS_CTL + 32768) + (blockIdx.x & 7) * 64;
            ((volatile LAS int*)(lds + MISC_OFF + 11264))[0] = (int)__hip_atomic_fetch_add(ctr, 1u, __ATOMIC_RELAXED, __HIP_MEMORY_SCOPE_AGENT); }
        __syncthreads();
        const int idx = __builtin_amdgcn_readfirstlane(((volatile LAS int*)(lds + MISC_OFF + 11264))[0]);
        __syncthreads();
        const int b = blockIdx.x & 7;
        if (idx >= 64) break;
        const int c = 63 - idx;
        for (int sx = 0; sx < 8; ++sx) select_unit(p, lds, b, 64 * c + 8 * sx);
        asm volatile("s_waitcnt vmcnt(0)" ::: "memory"); __syncthreads();
        dense_attn_chunk(p, b, c);
    }
}

constexpr int T_TSTART = 0, T_PADSTART = 40, T_BLOCKBASE = 80, T_NE = 112, T_WB = 144  , T_PART = 400  ;
__device__ __forceinline__ void router_phase(const Params& p, LAS unsigned char* lds, int bid, int G) {
    const int tid = threadIdx.x, lane = tid & 63, wave = __builtin_amdgcn_readfirstlane(tid >> 6);
    constexpr int WP = 1028;
    LAS float* WrT = (LAS float*)lds;
    {
        f32x4 wv_[16]; float gg_[16];
#pragma unroll
        for (int u = 0; u < 16; ++u) { const int i = tid + u * NTHREADS; wv_[u] = *(const f32x4*)(p.router_w + 4 * (size_t)i); gg_[u] = p.norm2_g[i >> 3]; }
#pragma unroll
        for (int u = 0; u < 16; ++u) { const int i = tid + u * NTHREADS; const int c = i >> 3, e0 = 4 * (i & 7);
            WrT[(e0 + 0) * WP + c] = wv_[u][0] * gg_[u]; WrT[(e0 + 1) * WP + c] = wv_[u][1] * gg_[u]; WrT[(e0 + 2) * WP + c] = wv_[u][2] * gg_[u]; WrT[(e0 + 3) * WP + c] = wv_[u][3] * gg_[u]; }
    }
    __syncthreads();
    LAS int* tbl = (LAS int*)(lds + MISC_OFF);
    const float* X1 = p.out; unsigned char* H2 = p.ws + WS_H2;
    int* rec_e = (int*)(p.ws + WS_REC_E); int* rec_pos = (int*)(p.ws + WS_REC_POS); float* rec_gate = (float*)(p.ws + WS_REC_GATE);
    const int ex = lane & 15, kq = lane >> 4;
    const size_t tokw = (size_t)bid * 128 + wave * 16;
    f32x4 acc0 = (f32x4){0.f, 0.f, 0.f, 0.f}, acc1 = acc0; float ssq = 0.f;
    {
        const float* xr = X1 + (tokw + ex) * D + 4 * kq;
        const LAS float* w0 = WrT + ex * WP + 4 * kq; const LAS float* w1 = w0 + 16 * WP;
#pragma unroll 16
        for (int q = 0; q < 64; ++q) {
            const f32x4 a = *(const f32x4*)(xr + 16 * q); const f32x4 b0 = *(const LAS f32x4*)(w0 + 16 * q), b1 = *(const LAS f32x4*)(w1 + 16 * q);
            ssq += (a.x * a.x + a.y * a.y) + (a.z * a.z + a.w * a.w);
#pragma unroll
            for (int k = 0; k < 4; ++k) { acc0 = __builtin_amdgcn_mfma_f32_16x16x4f32(a[k], b0[k], acc0, 0, 0, 0); acc1 = __builtin_amdgcn_mfma_f32_16x16x4f32(a[k], b1[k], acc1, 0, 0, 0); }
        }
    }
    ssq += __shfl_xor(ssq, 16); ssq += __shfl_xor(ssq, 32);
    const float rs = 1.0f / sqrtf(ssq * (1.0f / D) + NORM_EPS);
    const float br0 = p.router_b[ex], br1 = p.router_b[ex + 16];
    float lg0[4], lg1[4];
#pragma unroll
    for (int i = 0; i < 4; ++i) { const float r = __shfl(rs, 4 * kq + i); lg0[i] = acc0[i] * r + br0; lg1[i] = acc1[i] * r + br1; }
    int ti[4][4]; float tv[4][4];
#pragma unroll
    for (int r = 0; r < 4; ++r)
#pragma unroll
        for (int i = 0; i < 4; ++i) {
            float bv = (lg0[i] >= lg1[i]) ? lg0[i] : lg1[i]; int bi = (lg0[i] >= lg1[i]) ? ex : ex + 16;
#pragma unroll
            for (int m = 1; m < 16; m <<= 1) { const float ov = __shfl_xor(bv, m); const int oi = __shfl_xor(bi, m); const bool better = (ov > bv) || (ov == bv && oi < bi); bv = better ? ov : bv; bi = better ? oi : bi; }
            tv[i][r] = bv; ti[i][r] = bi;
            if (bi == ex) lg0[i] = -INFINITY; if (bi == ex + 16) lg1[i] = -INFINITY;
        }
    unsigned M[4];
#pragma unroll
    for (int i = 0; i < 4; ++i) M[i] = (1u << ti[i][0]) | (1u << ti[i][1]) | (1u << ti[i][2]) | (1u << ti[i][3]);
    unsigned Mall[16];
#pragma unroll
    for (int t = 0; t < 16; ++t) Mall[t] = (unsigned)__builtin_amdgcn_readlane((int)M[t & 3], 16 * (t >> 2));
#pragma unroll
    for (int i = 0; i < 4; ++i) {
        const int t = 4 * kq + i;
        const float e1 = __expf(tv[i][1] - tv[i][0]), e2 = __expf(tv[i][2] - tv[i][0]), e3 = __expf(tv[i][3] - tv[i][0]); const float inv = 1.0f / (1.0f + e1 + e2 + e3);
#pragma unroll
        for (int r = 0; r < 4; ++r) {
            const int x = ti[i][r]; int pos = 0;
#pragma unroll
            for (int tp = 0; tp < 16; ++tp) pos += (tp < t) ? (int)((Mall[tp] >> x) & 1u) : 0;
            const float gt = (r == 0 ? 1.0f : (r == 1 ? e1 : (r == 2 ? e2 : e3))) * inv;
            if (ex == r) { rec_e[(tokw + t) * 4 + r] = x; rec_pos[(tokw + t) * 4 + r] = pos; rec_gate[(tokw + t) * 4 + r] = gt; }
        }
    }
    { int cnt = 0;
#pragma unroll
        for (int t = 0; t < 16; ++t) cnt += (int)((Mall[t] >> (lane & 31)) & 1u);
        if (lane < 32) tbl[T_WB + wave * 32 + lane] = cnt; }
    {
        f32x4 g2[4];
#pragma unroll
        for (int j = 0; j < 4; ++j) g2[j] = *(const f32x4*)(p.norm2_g + 4 * lane + 256 * j);
#pragma unroll 4
        for (int t = 0; t < 16; ++t) {
            const float r = __shfl(rs, t);
            const f32x4* xr = (const f32x4*)(X1 + (tokw + t) * D) + lane;
#pragma unroll
            for (int j = 0; j < 4; ++j) { const f32x4 h = xr[64 * j] * r * g2[j]; *(unsigned*)(H2 + (tokw + t) * D + 4 * lane + 256 * j) = pk4_fp8(h.x, h.y, h.z, h.w); }
        }
    }
    __syncthreads();
    if (tid < 256) ((int*)(p.ws + WS_WCNT))[(size_t)bid * 256 + tid] = tbl[T_WB + tid];
    if (tid < 32) { int sm = 0;
#pragma unroll
        for (int w = 0; w < 8; ++w) sm += tbl[T_WB + w * 32 + tid];
        ((int*)(p.ws + WS_BCNT))[bid * 32 + tid] = sm; }
    __syncthreads();
}

__device__ __forceinline__ void moe_tables(const Params& p, LAS int* tbl, int bid) {
    const int tid = threadIdx.x; const int* bcnt = (const int*)(p.ws + WS_BCNT);
    { const int e = tid & 31, part = tid >> 5; int all = 0, below = 0;
        for (int k = 0; k < 16; ++k) { const int blk = part * 16 + k; const int v = bcnt[blk * 32 + e]; all += v; below += (blk < bid) ? v : 0; }
        tbl[T_PART + part * 32 + e] = all; tbl[T_PART + 512 + part * 32 + e] = below; }
    __syncthreads();
    if (tid < 32) { int all = 0, below = 0;
        for (int q = 0; q < 16; ++q) { all += tbl[T_PART + q * 32 + tid]; below += tbl[T_PART + 512 + q * 32 + tid]; }
        tbl[T_NE + tid] = all; tbl[T_BLOCKBASE + tid] = below; }
    __syncthreads();
    if (tid == 0) { int ps = 0, ts = 0;
        for (int e = 0; e < NEXP; ++e) { tbl[T_PADSTART + e] = ps; tbl[T_TSTART + e] = ts; const int nt = (tbl[T_NE + e] + 255) >> 8; ps += nt * 256; ts += nt; }
        tbl[T_PADSTART + NEXP] = ps; tbl[T_TSTART + NEXP] = ts; }
    __syncthreads();
}

__device__ __forceinline__ void permute_phase(const Params& p, LAS unsigned char* lds, int bid, int G) {
    const int tid = threadIdx.x, lane = tid & 63, wave = __builtin_amdgcn_readfirstlane(tid >> 6);
    LAS int* tbl = (LAS int*)(lds + MISC_OFF);
    moe_tables(p, tbl, bid);
    if (tid < 256) { const int w = tid >> 5, e = tid & 31; int s = 0; const int* wc = (const int*)(p.ws + WS_WCNT) + (size_t)bid * 256;
        for (int q = 0; q < 8; ++q) s += (q < w) ? wc[q * 32 + e] : 0;
        tbl[T_WB + tid] = s; }
    __syncthreads();
    const int* rec_e = (const int*)(p.ws + WS_REC_E); const int* rec_pos = (const int*)(p.ws + WS_REC_POS); const float* rec_gate = (const float*)(p.ws + WS_REC_GATE);
    int* slot_of = (int*)(p.ws + WS_SLOT_OF); float* slot_gate = (float*)(p.ws + WS_SLOT_GATE);
    const unsigned char* H2 = p.ws + WS_H2; unsigned char* H2S = p.ws + WS_H2S;
    for (int bt = 0; bt < 4; ++bt) {
        const int idx = wave * 64 + bt * 16 + (lane & 15); const int tl = idx >> 2; const size_t tk = (size_t)bid * 128 + tl;
        const int e = rec_e[tk * 4 + (idx & 3)], pw = rec_pos[tk * 4 + (idx & 3)];
        const int slot = tbl[T_PADSTART + e] + tbl[T_BLOCKBASE + e] + tbl[T_WB + (tl >> 4) * 32 + e] + pw;
        if (lane < 16) { slot_of[tk * 4 + (idx & 3)] = slot; slot_gate[slot] = rec_gate[tk * 4 + (idx & 3)]; }
        u32x4 v0[16];
#pragma unroll
        for (int i = 0; i < 16; ++i) { const size_t tki = (size_t)bid * 128 + ((wave * 64 + bt * 16 + i) >> 2); v0[i] = *(const u32x4*)(H2 + tki * D + 16 * lane); }
#pragma unroll
        for (int i = 0; i < 16; ++i) { const int sl = __shfl(slot, i); *(u32x4*)(H2S + (size_t)sl * D + 16 * lane) = v0[i]; }
    }
}

__device__ __forceinline__ void combine_phase(const Params& p, int bid, int G) {
    const int tid = threadIdx.x, lane = tid & 63, wave = __builtin_amdgcn_readfirstlane(tid >> 6);
    const int gw = bid * NWAVES + wave, NGW = G * NWAVES;
    const int* slot_of = (const int*)(p.ws + WS_SLOT_OF); const unsigned char* Y = p.ws + WS_Y;
    typedef float f32x2v __attribute__((ext_vector_type(2)));
    for (int tk = gw; tk < NTOK; tk += NGW) {
        int sl[4];
#pragma unroll
        for (int r = 0; r < 4; ++r) sl[r] = slot_of[(size_t)tk * 4 + r];
        float* orow = p.out + (size_t)tk * D;
        unsigned yv[4][4];
#pragma unroll
        for (int j = 0; j < 4; ++j)
#pragma unroll
            for (int r = 0; r < 4; ++r) yv[j][r] = *(const unsigned*)(Y + (size_t)sl[r] * D + 4 * lane + 256 * j);
#pragma unroll
        for (int j = 0; j < 4; ++j) { f32x4 a = *(const f32x4*)(orow + 4 * lane + 256 * j); float s0 = 0.f, s1 = 0.f, s2 = 0.f, s3 = 0.f;
#pragma unroll
            for (int r = 0; r < 4; ++r) { const f32x2v lo = __builtin_amdgcn_cvt_pk_f32_fp8((int)yv[j][r], false), hi = __builtin_amdgcn_cvt_pk_f32_fp8((int)yv[j][r], true); s0 += lo.x; s1 += lo.y; s2 += hi.x; s3 += hi.y; }
            a.x += s0 * (1.0f / Y_SCALE); a.y += s1 * (1.0f / Y_SCALE); a.z += s2 * (1.0f / Y_SCALE); a.w += s3 * (1.0f / Y_SCALE);
            *(f32x4*)(orow + 4 * lane + 256 * j) = a; }
    }
}

#define XB_TMO      128
#define XB_XCNT(j)  (256  + 64 * (j))
#define XB_XSUB(j)  (1280 + 64 * (j))
#define XB_XGEN(j)  (2304 + 64 * (j))
#define XB_TOP      3328
#define XB_TOPGEN   3392
#define XCD_BAR_WORDS 3456
#define XB_SPIN_CAP (1u << 18)

__device__ __forceinline__ unsigned xb_ld(unsigned* p)              { return __hip_atomic_load(p, __ATOMIC_RELAXED, __HIP_MEMORY_SCOPE_AGENT); }
__device__ __forceinline__ unsigned xb_add(unsigned* p, unsigned v) { return __hip_atomic_fetch_add(p, v, __ATOMIC_RELAXED, __HIP_MEMORY_SCOPE_AGENT); }
__device__ __forceinline__ unsigned xb_xcc_id() { return (unsigned)__builtin_amdgcn_s_getreg((3 << 11) | 20) & 0xFu; }
#define XB_SPIN(cond, bar) do { unsigned _sp = 0; while (cond) { __builtin_amdgcn_s_sleep(1); \
    if ((++_sp & 255u) == 0u) { if (xb_ld(&(bar)[XB_TMO])) break; if (_sp > XB_SPIN_CAP) { atomicAdd(&(bar)[XB_TMO], 1u); break; } } } } while (0)

struct XcdBarrier {
    unsigned* bar; unsigned x;
    volatile LAS unsigned* st;
};

__device__ __forceinline__ XcdBarrier xcd_barrier_post(unsigned* bar, volatile LAS unsigned* st) {
    XcdBarrier b; b.bar = bar; b.x = xb_xcc_id(); b.st = st;
    if (threadIdx.x == 0) (void)xb_add(&bar[XB_XCNT(b.x)], 1u);
    return b;
}
__device__ __forceinline__ void xcd_barrier_complete(unsigned* bar, unsigned x, unsigned& nloc, unsigned& nx) {
    const unsigned G = gridDim.x * gridDim.y * gridDim.z;
    unsigned sum, cnt, mine, sp = 0u;
    for (;;) {
        sum = 0u; cnt = 0u; mine = 0u;
#pragma unroll
        for (unsigned j = 0; j < 16; ++j) { const unsigned c = xb_ld(&bar[XB_XCNT(j)]); sum += c; cnt += (c > 0u) ? 1u : 0u; mine = (j == x) ? c : mine; }
        if (sum == G) break;
        __builtin_amdgcn_s_sleep(1);
        if ((++sp & 255u) == 0u) { if (xb_ld(&bar[XB_TMO])) break; if (sp > XB_SPIN_CAP) { atomicAdd(&bar[XB_TMO], 1u); break; } }
    }
    nloc = mine > 0u ? mine : 1u; nx = cnt > 0u ? cnt : 1u;
}

__device__ __forceinline__ void xcd_barrier(const XcdBarrier& b) {
    asm volatile("s_waitcnt vmcnt(0)" ::: "memory");
    __syncthreads();
    if (threadIdx.x == 0) {
        unsigned* bar = b.bar;
        __builtin_amdgcn_s_waitcnt(0);
        unsigned nloc = b.st[0], nx = b.st[1];
        if (nloc == 0u) { xcd_barrier_complete(bar, b.x, nloc, nx); b.st[0] = nloc; b.st[1] = nx; }
        const unsigned old = xb_add(&bar[XB_XSUB(b.x)], 1u);
        const unsigned gen = old / nloc;
        if (old + 1u == (gen + 1u) * nloc) {
            __builtin_amdgcn_fence(__ATOMIC_RELEASE, "agent");
            asm volatile("s_waitcnt vmcnt(0)" ::: "memory");
            const unsigned og = xb_add(&bar[XB_TOP], 1u);
            const unsigned tg = og / nx;
            if (og + 1u == (tg + 1u) * nx) xb_add(&bar[XB_TOPGEN], 1u);
            else XB_SPIN(xb_ld(&bar[XB_TOPGEN]) == tg, bar);
            __builtin_amdgcn_fence(__ATOMIC_ACQUIRE, "agent");
            xb_add(&bar[XB_XGEN(b.x)], 1u);
            asm volatile("s_waitcnt vmcnt(0)" ::: "memory");
        } else {
            XB_SPIN(xb_ld(&bar[XB_XGEN(b.x)]) == gen, bar);
            __builtin_amdgcn_fence(__ATOMIC_ACQUIRE, "agent");
            asm volatile("s_waitcnt vmcnt(0)" ::: "memory");
        }
    }
    __syncthreads();
}

constexpr int NPH = 11;
__global__ void __launch_bounds__(NTHREADS, 2) mega(Params p) {
    extern __shared__ __attribute__((aligned(16))) unsigned char lds_raw[];
    LAS unsigned char* lds = (LAS unsigned char*)lds_raw;
    cg::grid_group grid = cg::this_grid();
    const int bid = blockIdx.x, G = gridDim.x;
    unsigned char* ws = p.ws;
    if (p.ph_lo < 0) grid.sync();
    volatile LAS unsigned* bst = (volatile LAS unsigned*)(lds + MISC_OFF + 12032);
    if (threadIdx.x < 2) bst[threadIdx.x] = 0u;
    __syncthreads();
    const XcdBarrier xbar = xcd_barrier_post((unsigned*)(ws + WS_CTL + 4096), bst);
#ifndef PH_MASK
#define PH_MASK 0x7ff
#endif
#define IN(k) (((PH_MASK >> (k)) & 1) && p.ph_lo <= (k) && (k) < p.ph_hi)
#ifndef PH_DUP
#define PH_DUP 0
#endif
#define DUP(k) (((PH_DUP >> (k)) & 1) ? 2 : 1)
#define STAMP(k) do { if (TS_PHASE >= 0 && ((k) == TS_PHASE || (k) == TS_PHASE + 1)) { if (blockIdx.x == 0 && __builtin_amdgcn_readfirstlane(threadIdx.x) < 64) { unsigned tv_ = (unsigned)__builtin_amdgcn_s_memrealtime(); unsigned ad_ = MISC_OFF + 10240 + 4 * ((k) - TS_PHASE); asm volatile("ds_write_b32 %0, %1\n\ts_waitcnt lgkmcnt(0)" :: "v"(ad_), "v"(tv_) : "memory"); } } } while (0)
#define SEAM(k) do { if (IN(k) && IN((k) + 1)) xcd_barrier(xbar); STAMP((k) + 1); } while (0)
    volatile LAS unsigned* tsv = (volatile LAS unsigned*)(lds + MISC_OFF + 10240);
    STAMP(0);
    if (IN(0)) { phase0(p, lds, bid, G); }
    SEAM(0);
    if (IN(1)) {
        pg8::Gemm g{(const bf16_t*)(ws + WS_XN), (const bf16_t*)(ws + WS_WIN), NTOK, INWP, D}; pg8::StaticOrder S; S.init(NTOK, INWP, G, bid);
        EpiInProj E{(bf16_t*)(ws + WS_Q), (bf16_t*)(ws + WS_K), (bf16_t*)(ws + WS_VT), (bf16_t*)(ws + WS_QI), (bf16_t*)(ws + WS_KI), (bf16_t*)(ws + WS_POOL), (bf16_t*)(ws + WS_GA), (bf16_t*)(ws + WS_GP),
                    (float*)(ws + WS_WI), (const float*)(ws + WS_CS), p.q_norm_g, p.k_norm_g, p.idx_g, p.idx_b};
        pg8::gemm_phase(lds, g, S, E);
    }
    SEAM(1);
    if (IN(2)) { pool_phase(p, bid, G); attn_phase(p, lds, bid, G); }
    SEAM(2);
    if (IN(3)) {
        pg8::Gemm g{(const bf16_t*)(ws + WS_ACAT), (const bf16_t*)(ws + WS_WCAT), NTOK, D, D}; pg8::StaticOrder S; S.init(NTOK, D, G, bid);
        EpiGated E{(const bf16_t*)(ws + WS_GA), (const bf16_t*)(ws + WS_GP), (bf16_t*)(ws + WS_MERGED)};
        pg8::gemm_phase(lds, g, S, E);
    }
    SEAM(4); STAMP(4);
    if (IN(5)) {
        pg8::Gemm g{(const bf16_t*)(ws + WS_MERGED), (const bf16_t*)(ws + WS_WOUT), NTOK, D, D}; pg8::StaticOrder S; S.init(NTOK, D, G, bid);
        EpiResid E{p.x, p.out};
        pg8::gemm_phase(lds, g, S, E);
    }
    SEAM(5);
    if (IN(6)) { router_phase(p, lds, bid, G); }
    SEAM(6);
    if (IN(7)) { permute_phase(p, lds, bid, G); }
    SEAM(7);
    if (IN(8)) {
        LAS int* tbl = (LAS int*)(lds + MISC_OFF); moe_tables(p, tbl, bid);
        pg8::Gemm g{(const bf16_t*)(ws + WS_H2S), (const bf16_t*)(ws + WS_WGU), NSLOT, NEXP * 2048, D}; pg8::MoeOrder<8> S{tbl + T_TSTART, G, bid};
        EpiGateUp E{p.b_gu, ws + WS_ACT};
        pg8::gemm_phase<EpiGateUp, pg8::MoeOrder<8>, true>(lds, g, S, E);
    }
    SEAM(8);
    if (IN(9)) {
        LAS int* tbl = (LAS int*)(lds + MISC_OFF); moe_tables(p, tbl, bid);
        pg8::Gemm g{(const bf16_t*)(ws + WS_ACT), (const bf16_t*)(ws + WS_WD), NSLOT, NEXP * 1024, D}; pg8::MoeOrder<4> S{tbl + T_TSTART, G, bid};
        EpiDown E{p.b_d, (const float*)(ws + WS_SLOT_GATE), ws + WS_Y};
        pg8::gemm_phase<EpiDown, pg8::MoeOrder<4>, true>(lds, g, S, E);
    }
    SEAM(9);
    if (IN(10)) combine_phase(p, bid, G);
    STAMP(11);
    if (TS_PHASE >= 0 && blockIdx.x == 0 && threadIdx.x == 0) {
        const unsigned d = tsv[1] - tsv[0], t0 = (unsigned)__builtin_amdgcn_s_memrealtime();
        while ((unsigned)__builtin_amdgcn_s_memrealtime() - t0 < d) __builtin_amdgcn_s_sleep(8);
    }
#undef IN
#undef SEAM
}

extern "C" void kernel_launch(void* const* d_in, const int* in_sizes, int n_in, void* d_out, int out_size, void* d_ws, size_t ws_size, hipStream_t stream) {
    static int grid = 0;
    if (grid == 0) {
        if (n_in != 20 || out_size != NTOK * D || ws_size < WS_END) { fprintf(stderr, "kernel_launch: unexpected shapes: n_in %d out %d ws %zu (need %zu)\n", n_in, out_size, ws_size, (size_t)WS_END); grid = -1; return; }
        int dev = 0, cus = 0, per_cu = 0;
        hipGetDevice(&dev); hipDeviceGetAttribute(&cus, hipDeviceAttributeMultiprocessorCount, dev);
        if (hipFuncSetAttribute((const void*)mega, hipFuncAttributeMaxDynamicSharedMemorySize, LDS_BYTES) != hipSuccess) { fprintf(stderr, "kernel_launch: hipFuncSetAttribute failed\n"); grid = -1; return; }
        if (hipOccupancyMaxActiveBlocksPerMultiprocessor(&per_cu, (const void*)mega, NTHREADS, LDS_BYTES) != hipSuccess || per_cu < 1) { fprintf(stderr, "kernel_launch: occupancy query says %d blocks per CU\n", per_cu); per_cu = 1; }
        (void)hipGetLastError();
        grid = cus;
        if (grid != 256) fprintf(stderr, "kernel_launch: %d CUs; the router / permute phases assume a 256-workgroup grid\n", grid);
    }
    if (grid < 0) return;
    if (hipMemsetAsync((char*)d_ws + WS_CTL, 0, 64 * 1024, stream) != hipSuccess) { fprintf(stderr, "kernel_launch: hipMemsetAsync of the control words failed\n"); return; }
    Params p{};
    p.x = (const float*)d_in[0]; p.pos = (const int*)d_in[1]; p.norm1_g = (const float*)d_in[2]; p.w_in = (const float*)d_in[3]; p.q_norm_g = (const float*)d_in[4];
    p.k_norm_g = (const float*)d_in[5]; p.idx_g = (const float*)d_in[6]; p.idx_b = (const float*)d_in[7]; p.w_a = (const float*)d_in[8]; p.pool_mix = (const float*)d_in[9];
    p.pool_scale = (const float*)d_in[10]; p.w_b = (const float*)d_in[11]; p.w_out = (const float*)d_in[12]; p.norm2_g = (const float*)d_in[13]; p.router_w = (const float*)d_in[14];
    p.router_b = (const float*)d_in[15]; p.w_gu = (const float*)d_in[16]; p.b_gu = (const float*)d_in[17]; p.w_d = (const float*)d_in[18]; p.b_d = (const float*)d_in[19];
    p.out = (float*)d_out; p.ws = (unsigned char*)d_ws;
#if MK_MODE == 0
    p.ph_lo = 0; p.ph_hi = NPH;
    void* args[] = {&p};
    hipError_t e = hipLaunchCooperativeKernel((const void*)mega, dim3(grid), dim3(NTHREADS), args, LDS_BYTES, stream);
    if (e != hipSuccess) fprintf(stderr, "kernel_launch: cooperative launch failed: %s (grid %d)\n", hipGetErrorString(e), grid);
#else
    for (int k = 0; k < NPH; ++k) { p.ph_lo = k; p.ph_hi = k + 1; hipLaunchKernelGGL(mega, dim3(grid), dim3(NTHREADS), LDS_BYTES, stream, p); }
#endif
}
```

```cpp
#include <hip/hip_runtime.h>
#include <hip/hip_cooperative_groups.h>
#include <cstdio>
#include <cstdint>
#include <cmath>
namespace cg = cooperative_groups;

#ifndef TS_PHASE
#define TS_PHASE (-1)
#endif
#ifndef MK_MODE
#define MK_MODE 0
#endif

#define LAS __attribute__((address_space(3)))
#define GAS __attribute__((address_space(1)))
typedef unsigned short bf16_t;
typedef short bf16x8 __attribute__((ext_vector_type(8)));
typedef float f32x2 __attribute__((ext_vector_type(2)));
typedef float f32x4 __attribute__((ext_vector_type(4)));
typedef float f32x16 __attribute__((ext_vector_type(16)));
typedef unsigned u32x2 __attribute__((ext_vector_type(2)));
typedef unsigned u32x4 __attribute__((ext_vector_type(4)));

constexpr int D = 1024, NBATCH = 8, SEQ = 4096, NTOK = NBATCH * SEQ;
constexpr int NEXP = 32, TOPK = 4;
constexpr int INW = 3652, INWP = 3840;
constexpr int NSLOT = 139264;
constexpr float NORM_EPS = 1e-6f;
constexpr float MOE_WSCALE = 64.0f, MOE_WINV = 1.0f / 64.0f;
constexpr float Y_SCALE = 16.0f;
constexpr int NWAVES = 8, NTHREADS = 512;
constexpr int LDS_BYTES = 147456;
constexpr int RING_BYTES = 131072;
constexpr int MISC_OFF = 135168;

constexpr size_t MiB = 1u << 20;
constexpr size_t WS_CTL = 0;
constexpr size_t WS_BCNT = 64 * 1024;
constexpr size_t WS_WCNT = 128 * 1024;
constexpr size_t WS_CS = 2 * MiB;
constexpr size_t WS_WIN = 16 * MiB;
constexpr size_t WS_WCAT = 24 * MiB;
constexpr size_t WS_WOUT = 26 * MiB;
constexpr size_t WS_WGU = 28 * MiB;
constexpr size_t WS_WD = 156 * MiB;
constexpr size_t WS_REC_E = 220 * MiB;
constexpr size_t WS_REC_POS = 221 * MiB;
constexpr size_t WS_REC_GATE = 222 * MiB;
constexpr size_t WS_SLOT_OF = 223 * MiB;
constexpr size_t WS_SLOT_GATE = 223 * MiB + 512 * 1024;
constexpr size_t WS_XN = 226 * MiB;
constexpr size_t WS_Q = 290 * MiB;
constexpr size_t WS_K = 322 * MiB;
constexpr size_t WS_VT = 330 * MiB;
constexpr size_t WS_QI = 338 * MiB;
constexpr size_t WS_KI = 354 * MiB;
constexpr size_t WS_WI = 358 * MiB;
constexpr size_t WS_POOL = 360 * MiB;
constexpr size_t WS_GA = 392 * MiB;
constexpr size_t WS_GP = 456 * MiB;
constexpr size_t WS_ACAT = 520 * MiB;
constexpr size_t WS_TA = 584 * MiB;
constexpr size_t WS_MASK = WS_TA;
constexpr size_t WS_MERGED = 648 * MiB;
constexpr size_t WS_H2 = WS_XN;
constexpr size_t WS_H2S = 290 * MiB;
constexpr size_t WS_Y = WS_H2S;
constexpr size_t WS_ACT = 562 * MiB;
constexpr size_t WS_END = 834 * MiB;
static_assert(WS_SLOT_GATE + (size_t)NSLOT * 4 <= WS_XN, "ws map");

__device__ __forceinline__ unsigned cvt_pk_bf16(float lo, float hi) { unsigned r; asm volatile("v_cvt_pk_bf16_f32 %0, %1, %2" : "=v"(r) : "v"(lo), "v"(hi)); return r; }
__device__ __forceinline__ unsigned pk4_fp8(float a, float b, float c, float d) { int w = __builtin_amdgcn_cvt_pk_fp8_f32(a, b, 0, false); w = __builtin_amdgcn_cvt_pk_fp8_f32(c, d, w, true); return (unsigned)w; }
__device__ __forceinline__ float bf_lo(unsigned w) { return __uint_as_float(w << 16); }
__device__ __forceinline__ float bf_hi(unsigned w) { return __uint_as_float(w & 0xffff0000u); }
__device__ __forceinline__ float wave_sum(float v) {
#pragma unroll
    for (int o = 1; o < 64; o <<= 1) v += __shfl_xor(v, o);
    return v;
}
__device__ __forceinline__ float sigmoidf_(float x) { return __builtin_amdgcn_rcpf(1.0f + __builtin_amdgcn_exp2f(-1.4426950408889634f * x)); }
#define LDS_WAIT() asm volatile("s_waitcnt lgkmcnt(0)" ::: "memory")

__host__ __device__ __forceinline__ int idx_bj_j(int d, int& bj) {
    int j;
    if (d < 16) { bj = 0; j = d; } else if (d < 32) { bj = 1; j = d - 16; } else if (d < 48) { bj = 0; j = d - 16; } else { bj = 1; j = d - 32; }
    return j;
}
__host__ __device__ __forceinline__ int win_phys(int n) {
    if (n < 512) { const int h = n >> 6, d = n & 63; return 256 * (h >> 2) + 128 * (d >> 5) + 32 * (h & 3) + (d & 31); }
    if (n < 768) { const int h = (n - 512) >> 6, d = n & 63; return 512 + 128 * (d >> 5) + 32 * h + (d & 31); }
    if (n < 1024) { const int h = (n - 768) >> 6, d = n & 63; int bj; const int j = idx_bj_j(d, bj); return 768 + 128 * bj + 32 * h + j; }
    if (n < 1088) { const int d = n - 1024; int bj; const int j = idx_bj_j(d, bj); return 1024 + 128 * bj + j; }
    if (n < 1092) return 1024 + 32 + (n - 1088);
    if (n < 1604) return 1280 + (n - 1092);
    if (n < 2628) return 1792 + (n - 1604);
    return 2816 + (n - 2628);
}

namespace pg8 {
constexpr int BM = 256, BK = 64, HALF = 128, HTB = HALF * BK * 2, STAGE_BYTES = 8 * HTB, NXCD = 8, WGM = 8;
template <int SW> __host__ __device__ __forceinline__ int lds_byte(int r, int c) { const int st = (r >> 4) * 2 + (c >> 5), rr = r & 15, cc = c & 31, ob = rr * 64 + cc * 2; return st * 1024 + (ob ^ (((ob >> 9) & 1) << SW)); }
template <int SW> __host__ __device__ __forceinline__ void stage_rc(int b, int& R, int& C) { const int st = b / 1024, sb = b % 1024, swz = sb ^ (((sb >> 9) & 1) << SW); R = (st >> 1) * 16 + swz / 64; C = (st & 1) * 32 + (swz % 64) / 2; }
__host__ __device__ __forceinline__ int perm32(int rho) { const int n = rho >> 4, i = rho & 15; return 8 * (i >> 2) + 4 * n + (i & 3); }

struct Unit { int pm, pn; };
struct Gemm { const bf16_t* A; const bf16_t* Bt; int M, N, K; };

struct StaticOrder {
    int nM, nN, nwg, G, c;
    __device__ void init(int M, int N, int G_, int c_) { nM = M / BM; nN = N / BM; nwg = nM * nN; G = G_; c = c_; }
    __device__ bool next(int i, Unit& u) const {
        const long L = (long)i * G + c; if (L >= nwg) return false;
        int wgid = (int)L; { const int q = nwg / NXCD, r = nwg % NXCD, xcd = wgid % NXCD, off = wgid / NXCD; wgid = (xcd < r ? xcd * (q + 1) : r * (q + 1) + (xcd - r) * q) + off; }
        const int nig = WGM * nN, gid = wgid / nig, fm = gid * WGM, gsz = (nM - fm) < WGM ? (nM - fm) : WGM;
        u.pm = fm + ((wgid % nig) % gsz); u.pn = (wgid % nig) / gsz; return true;
    }
};
template <int NPN> struct MoeOrder {
    const LAS int* tstart; int G, c;
    __device__ bool next(int i, Unit& u) const {
        const int x = c & 7, lc = c >> 3, ng = G >> 3;
        int U = i * ng + lc;
#pragma unroll
        for (int k = 0; k < NEXP / 8; ++k) {
            const int e = x + 8 * k; const int t0 = __builtin_amdgcn_readfirstlane(tstart[e]), t1 = __builtin_amdgcn_readfirstlane(tstart[e + 1]);
            const int nu = (t1 - t0) * NPN;
            if (U < nu) { u.pm = t0 + U / NPN; u.pn = e * NPN + U % NPN; return true; }
            U -= nu;
        }
        return false;
    }
};

typedef int i32x8 __attribute__((ext_vector_type(8)));
__device__ __forceinline__ i32x8 pk32(bf16x8 a, bf16x8 b) { typedef int i32x4 __attribute__((ext_vector_type(4))); const i32x4 x = __builtin_bit_cast(i32x4, a), y = __builtin_bit_cast(i32x4, b); return __builtin_shufflevector(x, y, 0, 1, 2, 3, 4, 5, 6, 7); }
__device__ __forceinline__ void mfma_f8_inplace(f32x4& acc, i32x8 a, i32x8 b, int one) {
    asm volatile("v_mfma_scale_f32_16x16x128_f8f6f4 %0, %1, %2, %0, %3, %3 op_sel_hi:[0,0,0]" : "+v"(acc) : "v"(a), "v"(b), "v"(one));
}
template <class Epi, class Sched, bool F8 = false>
__device__ __forceinline__ void gemm_phase(LAS unsigned char* lds, const Gemm g, const Sched& S, const Epi& E) {
    const int tid = threadIdx.x, wid = __builtin_amdgcn_readfirstlane(tid >> 6), lane = tid & 63, wr = wid >> 2, wc = wid & 3, fr = lane & 15, fq = lane >> 4;
    constexpr int ES = F8 ? 1 : 2;
    const int K = g.K, RB = K * ES, nt = RB / 128;
    unsigned voffA[2], voffB[2];
    constexpr int SW = F8 ? 4 : 5;
    { int R, C; stage_rc<SW>(tid * 16, R, C); const int Rb = (R & ~31) + perm32(R & 31);
        voffA[0] = (unsigned)(R * RB + C * 2); voffB[0] = (unsigned)(Rb * RB + C * 2); voffA[1] = 64u * (unsigned)RB; voffB[1] = 64u * (unsigned)RB; }
    const size_t kstep = (size_t)(BK * 2);
    const size_t hstep = (size_t)HALF * RB;
    const size_t tstep = 2 * hstep;
    const unsigned ldsw = (unsigned)wid * 1024u;
    const int aoff = lds_byte<SW>(wr * 64 + fr, F8 ? fq * 16 : fq * 8), boff = lds_byte<SW>(wc * 32 + fr, F8 ? fq * 16 : fq * 8);
    const int aoff1 = F8 ? lds_byte<SW>(wr * 64 + fr, fq * 16 + 8) : aoff + 1024, boff1 = F8 ? lds_byte<SW>(wc * 32 + fr, fq * 16 + 8) : boff + 1024;
#define PG8_SA(b, h) (((b) * 2 + (h)) * HTB)
#define PG8_SB(b, h) ((4 + (b) * 2 + (h)) * HTB)
#define PG8_STAGE(bufoff, gbase, voff) do { _Pragma("unroll") for (int _i = 0; _i < 2; ++_i) \
        __builtin_amdgcn_global_load_lds((const unsigned*)((const char*)(gbase) + (size_t)(_i ? (voff)[1] : 0u) + (voff)[0]), (LAS unsigned*)(lds + (bufoff) + ldsw + _i * 8192), 16, 0, 0); } while (0)
#define PG8_LDA(dst, b, h) do { _Pragma("unroll") for (int m = 0; m < 4; ++m) _Pragma("unroll") for (int k = 0; k < 2; ++k) dst[m][k] = *(const LAS bf16x8*)(lds + PG8_SA(b, h) + (k ? aoff1 : aoff) + m * 2048); } while (0)
#define PG8_LDB(dst, b, h) do { _Pragma("unroll") for (int n = 0; n < 2; ++n) _Pragma("unroll") for (int k = 0; k < 2; ++k) dst[n][k] = *(const LAS bf16x8*)(lds + PG8_SB(b, h) + (k ? boff1 : boff) + n * 2048); } while (0)
#define PG8_MMA(ai, bj, At, Bt) do { __builtin_amdgcn_s_setprio(1); \
        if constexpr (F8) { _Pragma("unroll") for (int m = 0; m < 4; ++m) _Pragma("unroll") for (int n = 0; n < 2; ++n) \
            mfma_f8_inplace(acc[ai][bj][m][n], pk32(Bt[n][0], Bt[n][1]), pk32(At[m][0], At[m][1]), one_scale); } \
        else { _Pragma("unroll") for (int m = 0; m < 4; ++m) _Pragma("unroll") for (int n = 0; n < 2; ++n) _Pragma("unroll") for (int k = 0; k < 2; ++k) \
            acc[ai][bj][m][n] = __builtin_amdgcn_mfma_f32_16x16x32_bf16(Bt[n][k], At[m][k], acc[ai][bj][m][n], 0, 0, 0); } \
        __builtin_amdgcn_s_setprio(0); } while (0)
#define PG8_WAIT_V(n) asm volatile("s_waitcnt vmcnt(" #n ")" ::: "memory")
#define PG8_WAIT_L(n) asm volatile("s_waitcnt lgkmcnt(" #n ")" ::: "memory")
#define PG8_BAR __builtin_amdgcn_s_barrier()
#define PG8_SCHED __builtin_amdgcn_sched_barrier(0)
    int one_scale = 0x7F7F7F7F; asm volatile("" : "+v"(one_scale));
    Unit cur, nxt; int ui = 0;
    if (!S.next(0, cur)) return;
    cur.pm = __builtin_amdgcn_readfirstlane(cur.pm); cur.pn = __builtin_amdgcn_readfirstlane(cur.pn);
    f32x4 acc[2][2][4][2];
#pragma unroll
    for (int a = 0; a < 2; ++a)
#pragma unroll
        for (int b = 0; b < 2; ++b)
#pragma unroll
            for (int m = 0; m < 4; ++m)
#pragma unroll
                for (int n = 0; n < 2; ++n) acc[a][b][m][n] = (f32x4){0.f, 0.f, 0.f, 0.f};
    bf16x8 At[4][2], B0[2][2], B1[2][2];
    const char* cA = (const char*)g.A + (size_t)cur.pm * tstep; const char* cB = (const char*)g.Bt + (size_t)cur.pn * tstep;
    PG8_STAGE(PG8_SB(0, 0), cB, voffB); PG8_STAGE(PG8_SB(0, 1), cB + hstep, voffB); PG8_STAGE(PG8_SA(0, 0), cA, voffA); PG8_STAGE(PG8_SA(0, 1), cA + hstep, voffA);
    if (wr == 1) PG8_BAR;
    PG8_WAIT_V(2); PG8_BAR;
    PG8_STAGE(PG8_SB(1, 0), cB + kstep, voffB); PG8_STAGE(PG8_SA(1, 0), cA + kstep, voffA); PG8_STAGE(PG8_SB(1, 1), cB + hstep + kstep, voffB);
    PG8_WAIT_V(6); PG8_BAR;
    for (;;) {
        const bool has_next = S.next(ui + 1, nxt); nxt.pm = __builtin_amdgcn_readfirstlane(nxt.pm); nxt.pn = __builtin_amdgcn_readfirstlane(nxt.pn);
        const char* nA = has_next ? (const char*)g.A + (size_t)nxt.pm * tstep : cA; const char* nB = has_next ? (const char*)g.Bt + (size_t)nxt.pn * tstep : cB;
#pragma unroll 1
        for (int t = 0; t < nt; t += 2) {
            const bool last = (t == nt - 2);
            const char* a1 = cA + (size_t)(t + 1) * kstep;
            const char* a2 = last ? nA : cA + (size_t)(t + 2) * kstep; const char* b2 = last ? nB : cB + (size_t)(t + 2) * kstep;
            const char* a3 = a2 + kstep; const char* b3 = b2 + kstep;
            PG8_LDB(B0, 0, 0); PG8_LDB(B1, 0, 1); PG8_SCHED; PG8_LDA(At, 0, 0); PG8_STAGE(PG8_SA(1, 1), a1 + hstep, voffA);
            PG8_WAIT_V(8); PG8_WAIT_L(0); PG8_BAR; PG8_MMA(0, 0, At, B0); PG8_MMA(0, 1, At, B1); PG8_BAR; PG8_SCHED;
            PG8_LDA(At, 0, 1); PG8_STAGE(PG8_SB(0, 0), b2, voffB); PG8_STAGE(PG8_SB(0, 1), b2 + hstep, voffB); PG8_STAGE(PG8_SA(0, 0), a2, voffA);
            PG8_WAIT_V(8); PG8_WAIT_L(0); PG8_BAR; PG8_MMA(1, 0, At, B0); PG8_MMA(1, 1, At, B1); PG8_BAR; PG8_SCHED;
            PG8_LDB(B0, 1, 0); PG8_LDB(B1, 1, 1); PG8_SCHED; PG8_LDA(At, 1, 0); PG8_STAGE(PG8_SA(0, 1), a2 + hstep, voffA);
            PG8_WAIT_V(8); PG8_WAIT_L(0); PG8_BAR; PG8_MMA(0, 0, At, B0); PG8_MMA(0, 1, At, B1); PG8_BAR; PG8_SCHED;
            PG8_LDA(At, 1, 1); PG8_STAGE(PG8_SB(1, 0), b3, voffB); PG8_STAGE(PG8_SB(1, 1), b3 + hstep, voffB); PG8_STAGE(PG8_SA(1, 0), a3, voffA);
            PG8_WAIT_V(8); PG8_WAIT_L(0); PG8_BAR; PG8_MMA(1, 0, At, B0); PG8_MMA(1, 1, At, B1); PG8_BAR; PG8_SCHED;
            if constexpr (Epi::MIDK) { if (t == nt / 2 - 2) E.mid(acc, cur, wr, wc, fr, fq); }
        }
        if (wr == 0) PG8_BAR;
        if constexpr (F8) asm volatile("s_nop 15\n\ts_nop 15" ::: );
        E(acc, cur, wr, wc, fr, fq);
        if (!has_next) break;
#pragma unroll
        for (int a = 0; a < 2; ++a)
#pragma unroll
            for (int b = 0; b < 2; ++b)
#pragma unroll
                for (int m = 0; m < 4; ++m)
#pragma unroll
                    for (int n = 0; n < 2; ++n) acc[a][b][m][n] = (f32x4){0.f, 0.f, 0.f, 0.f};
        cur = nxt; cA = nA; cB = nB; ++ui;
        if (wr == 1) PG8_BAR;
    }
    PG8_WAIT_V(0);
    PG8_BAR;
#undef PG8_SA
#undef PG8_SB
#undef PG8_STAGE
#undef PG8_LDA
#undef PG8_LDB
#undef PG8_MMA
#undef PG8_WAIT_V
#undef PG8_WAIT_L
#undef PG8_BAR
#undef PG8_SCHED
}
}

struct Params {
    const float* x; const int* pos; const float* norm1_g; const float* w_in; const float* q_norm_g; const float* k_norm_g;
    const float* idx_g; const float* idx_b; const float* w_a; const float* pool_mix; const float* pool_scale; const float* w_b;
    const float* w_out; const float* norm2_g; const float* router_w; const float* router_b; const float* w_gu; const float* b_gu;
    const float* w_d; const float* b_d;
    float* out; unsigned char* ws; int ph_lo, ph_hi;
};

using pg8::Unit; using pg8::HALF;
__device__ __forceinline__ void st8(bf16_t* p, const float (&v)[8]) {
    u32x4 w; w.x = cvt_pk_bf16(v[0], v[1]); w.y = cvt_pk_bf16(v[2], v[3]); w.z = cvt_pk_bf16(v[4], v[5]); w.w = cvt_pk_bf16(v[6], v[7]); *(u32x4*)p = w;
}
__device__ __forceinline__ void ld8f(const float* p, float (&v)[8]) { const f32x4 a = *(const f32x4*)p, b = *(const f32x4*)(p + 4); v[0]=a[0]; v[1]=a[1]; v[2]=a[2]; v[3]=a[3]; v[4]=b[0]; v[5]=b[1]; v[6]=b[2]; v[7]=b[3]; }
__device__ __forceinline__ void ld8bf(const bf16_t* p, float (&v)[8]) { const u32x4 w = *(const u32x4*)p; v[0]=bf_lo(w.x); v[1]=bf_hi(w.x); v[2]=bf_lo(w.y); v[3]=bf_hi(w.y); v[4]=bf_lo(w.z); v[5]=bf_hi(w.z); v[6]=bf_lo(w.w); v[7]=bf_hi(w.w); }

struct EpiInProj {
    static constexpr bool MIDK = false;
    bf16_t *Q, *Kb, *Vb, *Qi, *Ki, *Pool, *Ga, *Gp; float* Wi; const float* cs; const float *gq, *gk, *lng, *lnb;
    __device__ __forceinline__ void operator()(const f32x4 (&acc)[2][2][4][2], const Unit& u, int wr, int wc, int fr, int fq) const {
        const int pn = u.pn;
#pragma unroll
        for (int ai = 0; ai < 2; ++ai)
#pragma unroll
            for (int m = 0; m < 4; ++m) {
                const int row = u.pm * 256 + ai * HALF + wr * 64 + m * 16 + fr;
                float v0[8], v1[8];
#pragma unroll
                for (int n = 0; n < 2; ++n)
#pragma unroll
                    for (int i = 0; i < 4; ++i) { v0[4 * n + i] = acc[ai][0][m][n][i]; v1[4 * n + i] = acc[ai][1][m][n][i]; }
                if (pn <= 1 || (pn == 2 && wc < 2)) {
                    float ss = 0.f;
#pragma unroll
                    for (int j = 0; j < 8; ++j) ss += v0[j] * v0[j] + v1[j] * v1[j];
                    ss += __shfl_xor(ss, 16); ss += __shfl_xor(ss, 32);
                    const float rs = 1.0f / sqrtf(ss * (1.0f / 64.0f) + NORM_EPS);
                    const float* gg = (pn <= 1) ? gq : gk; const float sc = (pn <= 1) ? 0.18033688011112042f : 1.0f;
                    float g0[8], g1[8], cc[8], sn[8];
                    ld8f(gg + 8 * fq, g0); ld8f(gg + 32 + 8 * fq, g1);
                    ld8f(cs + (size_t)row * 96 + 8 * fq, cc); ld8f(cs + (size_t)row * 96 + 48 + 8 * fq, sn);
                    float o0[8], o1[8];
#pragma unroll
                    for (int j = 0; j < 8; ++j) { const float x1 = v0[j] * rs * g0[j], x2 = v1[j] * rs * g1[j]; o0[j] = (x1 * cc[j] - x2 * sn[j]) * sc; o1[j] = (x2 * cc[j] + x1 * sn[j]) * sc; }
                    if (pn <= 1) { bf16_t* dst = Q + (size_t)row * 512 + (4 * pn + wc) * 64; st8(dst + 8 * fq, o0); st8(dst + 32 + 8 * fq, o1); }
                    else {
                        bf16_t* dst = Kb + ((((size_t)((row >> 12) * 2 + wc) * 128 + ((row & 4095) >> 5)) * 4 + (fq >> 1)) * 64 + ((fq & 1) * 32 + (row & 31))) * 8;
                        st8(dst, o0); st8(dst + 2 * 512, o1); }
                } else if (pn == 2) {
                    const int t = row & 4095, kk = t & 31;
                    bf16_t* dst = Vb + (((size_t)((row >> 12) * 2 + (wc - 2)) * 128 + (t >> 5)) * 4 + (kk >> 4)) * 512 + (((kk >> 2) & 1) * 32 + 8 * fq) * 8 + 4 * ((kk >> 3) & 1) + (kk & 3);
#pragma unroll
                    for (int j = 0; j < 8; ++j) { dst[j * 8] = (bf16_t)(cvt_pk_bf16(v0[j], v0[j]) & 0xffffu); dst[2 * 512 + j * 8] = (bf16_t)(cvt_pk_bf16(v1[j], v1[j]) & 0xffffu); }
                } else if (pn == 3 || (pn == 4 && wc == 0)) {
                    if (pn == 4) {
                        float s = 0.f;
#pragma unroll
                        for (int j = 0; j < 8; ++j) s += v0[j] + v1[j];
                        s += __shfl_xor(s, 16); s += __shfl_xor(s, 32);
                        const float mu = s * (1.0f / 64.0f); float q = 0.f;
#pragma unroll
                        for (int j = 0; j < 8; ++j) { v0[j] -= mu; v1[j] -= mu; q += v0[j] * v0[j] + v1[j] * v1[j]; }
                        q += __shfl_xor(q, 16); q += __shfl_xor(q, 32);
                        const float rs = 1.0f / sqrtf(q * (1.0f / 64.0f) + NORM_EPS);
                        const int d0 = (fq < 2) ? 8 * fq : 8 * fq + 16, d1 = (fq < 2) ? 16 + 8 * fq : 8 * fq + 32;
                        float a0[8], a1[8], b0[8], b1[8];
                        ld8f(lng + d0, a0); ld8f(lng + d1, a1); ld8f(lnb + d0, b0); ld8f(lnb + d1, b1);
#pragma unroll
                        for (int j = 0; j < 8; ++j) { v0[j] = v0[j] * rs * a0[j] + b0[j]; v1[j] = v1[j] * rs * a1[j] + b1[j]; }
                    }
                    bf16_t* dst = Qi + (size_t)row * 256 + wc * 64;
                    bf16_t* kdst = Ki + (((size_t)(row >> 12) * 128 + ((row & 4095) >> 5)) * 4 * 64 + (row & 31)) * 8;
                    if (fq < 2) {
                        float cc[8], sn[8];
                        ld8f(cs + (size_t)row * 96 + 32 + 8 * fq, cc); ld8f(cs + (size_t)row * 96 + 48 + 32 + 8 * fq, sn);
                        float o0[8], o1[8];
#pragma unroll
                        for (int j = 0; j < 8; ++j) { o0[j] = v0[j] * cc[j] - v1[j] * sn[j]; o1[j] = v1[j] * cc[j] + v0[j] * sn[j]; }
                        if (pn == 3) { st8(dst + 8 * fq, o0); st8(dst + 16 + 8 * fq, o1); }
                        else { st8(kdst + (fq * 32) * 8, o0); st8(kdst + (64 + fq * 32) * 8, o1); }
                    } else {
                        if (pn == 3) { st8(dst + 8 * fq + 16, v0); st8(dst + 8 * fq + 32, v1); }
                        else { st8(kdst + (2 * 64 + (fq - 2) * 32) * 8, v0); st8(kdst + (3 * 64 + (fq - 2) * 32) * 8, v1); } }
                } else if (pn == 4) {
                    if (wc == 1 && fq == 0) *(f32x4*)(Wi + (size_t)row * 4) = (f32x4){v0[0] * 0.0625f, v0[1] * 0.0625f, v0[2] * 0.0625f, v0[3] * 0.0625f};
                } else if (pn <= 6) {
                    bf16_t* dst = Pool + (size_t)row * 512 + (pn - 5) * 256 + wc * 32 + 8 * fq;
                    st8(dst, v0); st8(dst + HALF, v1);
                } else {
                    bf16_t* dst = ((pn <= 10) ? Ga + (size_t)row * 1024 + (pn - 7) * 256 : Gp + (size_t)row * 1024 + (pn - 11) * 256) + wc * 32 + 8 * fq;
#pragma unroll
                    for (int j = 0; j < 8; ++j) { v0[j] = sigmoidf_(v0[j]); v1[j] = sigmoidf_(v1[j]); }
                    st8(dst, v0); st8(dst + HALF, v1);
                }
            }
    }
};

struct EpiGated {
    static constexpr bool MIDK = true;
    const bf16_t* Ga; const bf16_t* Gp; bf16_t* O;
    __device__ __forceinline__ void mid(f32x4 (&acc)[2][2][4][2], const Unit& u, int wr, int wc, int fr, int fq) const {
        asm volatile("" : "+v"(fr), "+v"(fq));
#pragma unroll
        for (int ai = 0; ai < 2; ++ai)
#pragma unroll
            for (int m = 0; m < 4; ++m) {
                const size_t off = (size_t)(u.pm * 256 + ai * HALF + wr * 64 + m * 16 + fr) * 1024 + u.pn * 256 + wc * 32 + 8 * fq;
#pragma unroll
                for (int bj = 0; bj < 2; ++bj) {
                    float ga[8], gp[8]; ld8bf(Ga + off + bj * HALF, ga); ld8bf(Gp + off + bj * HALF, gp);
#pragma unroll
                    for (int n = 0; n < 2; ++n)
#pragma unroll
                        for (int i = 0; i < 4; ++i) acc[ai][bj][m][n][i] *= ga[4 * n + i] * __builtin_amdgcn_rcpf(fmaxf(gp[4 * n + i], 1e-30f));
                }
                if (m & 1) asm volatile("" ::: "memory");
            }
    }
    __device__ __forceinline__ void operator()(const f32x4 (&acc)[2][2][4][2], const Unit& u, int wr, int wc, int fr, int fq) const {
        asm volatile("" : "+v"(fr), "+v"(fq));
#pragma unroll
        for (int ai = 0; ai < 2; ++ai)
#pragma unroll
            for (int m = 0; m < 4; ++m) {
                const size_t off = (size_t)(u.pm * 256 + ai * HALF + wr * 64 + m * 16 + fr) * 1024 + u.pn * 256 + wc * 32 + 8 * fq;
#pragma unroll
                for (int bj = 0; bj < 2; ++bj) {
                    float g[8], o[8]; ld8bf(Gp + off + bj * HALF, g);
#pragma unroll
                    for (int n = 0; n < 2; ++n)
#pragma unroll
                        for (int i = 0; i < 4; ++i) o[4 * n + i] = g[4 * n + i] * acc[ai][bj][m][n][i];
                    st8(O + off + bj * HALF, o);
                }
            }
    }
};
struct EpiResid {
    static constexpr bool MIDK = false;
    const float* X; float* O;
    __device__ __forceinline__ void operator()(const f32x4 (&acc)[2][2][4][2], const Unit& u, int wr, int wc, int fr, int fq) const {
#pragma unroll
        for (int ai = 0; ai < 2; ++ai)
#pragma unroll
            for (int m = 0; m < 4; ++m) {
                const size_t off = (size_t)(u.pm * 256 + ai * HALF + wr * 64 + m * 16 + fr) * 1024 + u.pn * 256 + wc * 32 + 8 * fq;
#pragma unroll
                for (int bj = 0; bj < 2; ++bj)
#pragma unroll
                    for (int n = 0; n < 2; ++n) { const size_t o = off + bj * HALF + 4 * n; *(f32x4*)(O + o) = *(const f32x4*)(X + o) + acc[ai][bj][m][n]; }
            }
    }
};
struct EpiGateUp {
    static constexpr bool MIDK = false;
    const float* bias; unsigned char* Act;
    __device__ __forceinline__ void operator()(const f32x4 (&acc)[2][2][4][2], const Unit& u, int wr, int wc, int fr, int fq) const {
        { int t_ = threadIdx.x; asm volatile("" : "+v"(t_)); fr = t_ & 15; fq = (t_ >> 4) & 3; }
        const int e = u.pn >> 3, pnl = u.pn & 7, col = pnl * 128 + wc * 32 + 8 * fq;
        float bg[8], bu[8]; ld8f(bias + (size_t)e * 2048 + col, bg); ld8f(bias + (size_t)e * 2048 + 1024 + col, bu);
#pragma unroll
        for (int ai = 0; ai < 2; ++ai)
#pragma unroll
            for (int m = 0; m < 4; ++m) {
                const size_t row = (size_t)(u.pm * 256 + ai * HALF + wr * 64 + m * 16 + fr);
                float o[8];
#pragma unroll
                for (int n = 0; n < 2; ++n)
#pragma unroll
                    for (int i = 0; i < 4; ++i) { const int j = 4 * n + i;
                        const float gt = fminf(acc[ai][0][m][n][i] * MOE_WINV + bg[j], 7.0f), up = fminf(fmaxf(acc[ai][1][m][n][i] * MOE_WINV + bu[j], -7.0f), 7.0f);
                        o[j] = gt * __builtin_amdgcn_rcpf(1.0f + __builtin_amdgcn_exp2f(-2.4554669595930156f * gt)) * (up + 1.0f); }
                u32x2 w; w.x = pk4_fp8(o[0], o[1], o[2], o[3]); w.y = pk4_fp8(o[4], o[5], o[6], o[7]);
                *(u32x2*)(Act + row * 1024 + col) = w;
            }
    }
};
struct EpiDown {
    static constexpr bool MIDK = false;
    const float* bias; const float* sgate; unsigned char* Y;
    __device__ __forceinline__ void operator()(const f32x4 (&acc)[2][2][4][2], const Unit& u, int wr, int wc, int fr, int fq) const {
        { int t_ = threadIdx.x; asm volatile("" : "+v"(t_)); fr = t_ & 15; fq = (t_ >> 4) & 3; }
        const int e = u.pn >> 2, pnl = u.pn & 3, col = pnl * 256 + wc * 32 + 8 * fq;
        float b0[8], b1[8]; ld8f(bias + (size_t)e * 1024 + col, b0); ld8f(bias + (size_t)e * 1024 + col + HALF, b1);
#pragma unroll
        for (int ai = 0; ai < 2; ++ai)
#pragma unroll
            for (int m = 0; m < 4; ++m) {
                const size_t row = (size_t)(u.pm * 256 + ai * HALF + wr * 64 + m * 16 + fr);
                const float gt = sgate[row] * Y_SCALE;
                float o0[8], o1[8];
#pragma unroll
                for (int n = 0; n < 2; ++n)
#pragma unroll
                    for (int i = 0; i < 4; ++i) { const int j = 4 * n + i; o0[j] = (acc[ai][0][m][n][i] * MOE_WINV + b0[j]) * gt; o1[j] = (acc[ai][1][m][n][i] * MOE_WINV + b1[j]) * gt; }
                u32x2 w0, w1; w0.x = pk4_fp8(o0[0], o0[1], o0[2], o0[3]); w0.y = pk4_fp8(o0[4], o0[5], o0[6], o0[7]); w1.x = pk4_fp8(o1[0], o1[1], o1[2], o1[3]); w1.y = pk4_fp8(o1[4], o1[5], o1[6], o1[7]);
                *(u32x2*)(Y + row * 1024 + col) = w0; *(u32x2*)(Y + row * 1024 + col + HALF) = w1;
            }
    }
};

template <class RowMap>
__device__ __forceinline__ void cvt_item(const float* W, int K, int N, bf16_t* WT, LAS float* scr, int kb, int nb, int lane, const RowMap& rm, int ldt = 0) {
    if (ldt == 0) ldt = K;
    const int k0 = kb * 64, n0 = nb * 64, n4 = lane & 15, kr = lane >> 4, n = n0 + 4 * n4;
    f32x4 v[16];
#pragma unroll
    for (int i = 0; i < 16; ++i) v[i] = (n < N) ? *(const f32x4*)(W + (size_t)(k0 + 4 * i + kr) * N + n) : (f32x4){0.f, 0.f, 0.f, 0.f};
#pragma unroll
    for (int i = 0; i < 16; ++i) { LAS float* d = scr + (4 * i + kr) * 65 + 4 * n4; d[0] = v[i][0]; d[1] = v[i][1]; d[2] = v[i][2]; d[3] = v[i][3]; }
    LDS_WAIT(); asm volatile("" ::: "memory");
    const int c8 = lane & 7;
#pragma unroll
    for (int jj = 0; jj < 8; ++jj) { const int nn = (lane >> 3) + 8 * jj; const LAS float* s = scr + (8 * c8) * 65 + nn;
        if (n0 + nn < N) { u32x4 o; o.x = cvt_pk_bf16(s[0], s[65]); o.y = cvt_pk_bf16(s[2 * 65], s[3 * 65]); o.z = cvt_pk_bf16(s[4 * 65], s[5 * 65]); o.w = cvt_pk_bf16(s[6 * 65], s[7 * 65]);
            *(u32x4*)(WT + (size_t)rm(n0 + nn) * ldt + k0 + 8 * c8) = o; } }
    LDS_WAIT(); asm volatile("" ::: "memory");
}
template <class RowMap>
__device__ __forceinline__ void cvt_item_f8(const float* W, int K, int N, unsigned char* WT, LAS float* scr, int kb, int nb, int lane, const RowMap& rm, float scale) {
    const int k0 = kb * 64, n0 = nb * 64, n4 = lane & 15, kr = lane >> 4, n = n0 + 4 * n4;
    f32x4 v[16];
#pragma unroll
    for (int i = 0; i < 16; ++i) v[i] = *(const f32x4*)(W + (size_t)(k0 + 4 * i + kr) * N + n);
#pragma unroll
    for (int i = 0; i < 16; ++i) { LAS float* d = scr + (4 * i + kr) * 65 + 4 * n4; d[0] = v[i][0] * scale; d[1] = v[i][1] * scale; d[2] = v[i][2] * scale; d[3] = v[i][3] * scale; }
    LDS_WAIT(); asm volatile("" ::: "memory");
    const int c8 = lane & 7;
#pragma unroll
    for (int jj = 0; jj < 8; ++jj) { const int nn = (lane >> 3) + 8 * jj; const LAS float* sp = scr + (8 * c8) * 65 + nn;
        u32x2 o; o.x = pk4_fp8(sp[0], sp[65], sp[2 * 65], sp[3 * 65]); o.y = pk4_fp8(sp[4 * 65], sp[5 * 65], sp[6 * 65], sp[7 * 65]);
        *(u32x2*)(WT + (size_t)rm(n0 + nn) * K + k0 + 8 * c8) = o; }
    LDS_WAIT(); asm volatile("" ::: "memory");
}
struct RmIdent { int off; __device__ __forceinline__ int operator()(int n) const { return off + n; } };
struct RmWin { __device__ __forceinline__ int operator()(int n) const { return win_phys(n); } };
struct RmGu { int e; __device__ __forceinline__ int operator()(int n) const { return e * 2048 + 256 * ((n & 1023) >> 7) + 128 * (n >> 10) + (n & 127); } };

struct CvtItem { const float* W; int N, K, k0, n0, kind, e; };
__device__ __forceinline__ CvtItem cvt_decode(const Params& p, int it) {
    constexpr int I_GU = NEXP * 16 * 32, I_D = NEXP * 16 * 16, I_IN = 16 * 58, I_A = 8 * 16;
    CvtItem d; int r = it;
    if (r < I_GU) { const int e = r / 512, q = r % 512; d.W = p.w_gu + (size_t)e * 1024 * 2048; d.N = 2048; d.K = 1024; d.k0 = (q / 32) * 64; d.n0 = (q % 32) * 64; d.kind = 0; d.e = e; return d; } r -= I_GU;
    if (r < I_D) { const int e = r / 256, q = r % 256; d.W = p.w_d + (size_t)e * 1024 * 1024; d.N = 1024; d.K = 1024; d.k0 = (q / 16) * 64; d.n0 = (q % 16) * 64; d.kind = 1; d.e = e; return d; } r -= I_D;
    if (r < I_IN) { d.W = p.w_in; d.N = INW; d.K = 1024; d.k0 = (r / 58) * 64; d.n0 = (r % 58) * 64; d.kind = 2; d.e = 0; return d; } r -= I_IN;
    if (r < I_A) { d.W = p.w_a; d.N = 1024; d.K = 512; d.k0 = (r / 16) * 64; d.n0 = (r % 16) * 64; d.kind = 3; d.e = 0; return d; } r -= I_A;
    d.W = p.w_out; d.N = 1024; d.K = 1024; d.k0 = (r / 16) * 64; d.n0 = (r % 16) * 64; d.kind = 4; d.e = 0; return d;
}
__device__ __forceinline__ void cvt_load(const CvtItem& d, int lane, f32x4 (&v)[16]) {
    const int n = d.n0 + 4 * (lane & 15), kr = lane >> 4;
#pragma unroll
    for (int i = 0; i < 16; ++i) v[i] = (n < d.N) ? *(const f32x4*)(d.W + (size_t)(d.k0 + 4 * i + kr) * d.N + n) : (f32x4){0.f, 0.f, 0.f, 0.f};
}
__device__ __forceinline__ void cvt_finish(const CvtItem& d, unsigned char* ws, LAS float* scr, int lane, const f32x4 (&v)[16]) {
    const int n4 = lane & 15, kr = lane >> 4; const float sc = (d.kind < 2) ? MOE_WSCALE : 1.0f;
#pragma unroll
    for (int i = 0; i < 16; ++i) { LAS float* q = scr + (4 * i + kr) * 65 + 4 * n4; q[0] = v[i][0] * sc; q[1] = v[i][1] * sc; q[2] = v[i][2] * sc; q[3] = v[i][3] * sc; }
    LDS_WAIT(); asm volatile("" ::: "memory");
    const int c8 = lane & 7;
#pragma unroll
    for (int jj = 0; jj < 8; ++jj) { const int nn = (lane >> 3) + 8 * jj, n = d.n0 + nn; const LAS float* sp = scr + (8 * c8) * 65 + nn;
        if (n < d.N) {
            if (d.kind < 2) {
                const int prow = (d.kind == 0) ? d.e * 2048 + 256 * ((n & 1023) >> 7) + 128 * (n >> 10) + (n & 127) : d.e * 1024 + n;
                u32x2 o; o.x = pk4_fp8(sp[0], sp[65], sp[2 * 65], sp[3 * 65]); o.y = pk4_fp8(sp[4 * 65], sp[5 * 65], sp[6 * 65], sp[7 * 65]);
                *(u32x2*)(ws + (d.kind == 0 ? WS_WGU : WS_WD) + (size_t)prow * 1024 + d.k0 + 8 * c8) = o;
            } else {
                u32x4 o; o.x = cvt_pk_bf16(sp[0], sp[65]); o.y = cvt_pk_bf16(sp[2 * 65], sp[3 * 65]); o.z = cvt_pk_bf16(sp[4 * 65], sp[5 * 65]); o.w = cvt_pk_bf16(sp[6 * 65], sp[7 * 65]);
                bf16_t* dst = (d.kind == 2) ? (bf16_t*)(ws + WS_WIN) + (size_t)win_phys(n) * 1024 : (d.kind == 3) ? (bf16_t*)(ws + WS_WCAT) + (size_t)n * 1024 : (bf16_t*)(ws + WS_WOUT) + (size_t)n * 1024;
                *(u32x4*)(dst + d.k0 + 8 * c8) = o;
            }
        } }
    LDS_WAIT(); asm volatile("" ::: "memory");
}

__device__ __forceinline__ void phase0(const Params& p, LAS unsigned char* lds, int bid, int G) {
    const int tid = threadIdx.x, lane = tid & 63, wave = __builtin_amdgcn_readfirstlane(tid >> 6);
    const int gw = bid * NWAVES + wave, NGW = G * NWAVES;
    unsigned char* ws = p.ws;
    LAS float* scr = (LAS float*)(lds + wave * 16640);
    constexpr int NITEMS = NEXP * 16 * 32 + NEXP * 16 * 16 + 16 * 58 + 8 * 16 + 16 * 16;
    {
        f32x4 vA[16], vB[16];
        int it = gw;
        if (it < NITEMS) {
            CvtItem dA = cvt_decode(p, it), dB = dA; cvt_load(dA, lane, vA);
            for (;;) {
                const int i1 = it + NGW; if (i1 < NITEMS) { dB = cvt_decode(p, i1); cvt_load(dB, lane, vB); }
                cvt_finish(dA, ws, scr, lane, vA); if (i1 >= NITEMS) break;
                const int i2 = i1 + NGW; if (i2 < NITEMS) { dA = cvt_decode(p, i2); cvt_load(dA, lane, vA); }
                cvt_finish(dB, ws, scr, lane, vB); if (i2 >= NITEMS) break;
                it = i2;
            }
        }
    }
    for (int it = gw; it < 16 * 4 * 32; it += NGW) {
        const int nb = it & 15, g = (it >> 4) & 3, cb = it >> 6, n = nb * 64 + lane, c0 = cb * 4;
        float a[4];
#pragma unroll
        for (int q = 0; q < 4; ++q) a[q] = 0.f;
        const float* mix = p.pool_mix + (size_t)g * 128 * 128 + (size_t)c0 * 128;
        for (int d0 = 0; d0 < 128; d0 += 16) {
            float wb[16];
#pragma unroll
            for (int dd = 0; dd < 16; ++dd) wb[dd] = p.w_b[(size_t)(g * 128 + d0 + dd) * 1024 + n];
#pragma unroll
            for (int dd = 0; dd < 16; ++dd) { const float w = p.pool_scale[g * 128 + d0 + dd] * wb[dd];
#pragma unroll
                for (int q = 0; q < 4; ++q) a[q] += mix[q * 128 + d0 + dd] * w; }
        }
        { u32x2 w; w.x = cvt_pk_bf16(a[0], a[1]); w.y = cvt_pk_bf16(a[2], a[3]); *(u32x2*)((bf16_t*)(ws + WS_WCAT) + (size_t)n * 1024 + 512 + g * 128 + c0) = w; }
    }
    {
        f32x4 gv[4];
#pragma unroll
        for (int j = 0; j < 4; ++j) gv[j] = *(const f32x4*)(p.norm1_g + 4 * lane + 256 * j);
        bf16_t* XN = (bf16_t*)(ws + WS_XN);
        for (int m0 = gw * 4; m0 < NTOK; m0 += NGW * 4) {
            f32x4 v[4][4];
#pragma unroll
            for (int r = 0; r < 4; ++r) { const f32x4* xr = (const f32x4*)(p.x + (size_t)(m0 + r) * D) + lane;
#pragma unroll
                for (int j = 0; j < 4; ++j) v[r][j] = xr[64 * j]; }
#pragma unroll
            for (int r = 0; r < 4; ++r) { float sq = 0.f;
#pragma unroll
                for (int j = 0; j < 4; ++j) sq += (v[r][j].x * v[r][j].x + v[r][j].y * v[r][j].y) + (v[r][j].z * v[r][j].z + v[r][j].w * v[r][j].w);
                const float rs = 1.0f / sqrtf(wave_sum(sq) * (1.0f / D) + NORM_EPS);
#pragma unroll
                for (int j = 0; j < 4; ++j) { const f32x4 o = v[r][j] * rs * gv[j]; u32x2 w; w.x = cvt_pk_bf16(o.x, o.y); w.y = cvt_pk_bf16(o.z, o.w); *(u32x2*)(XN + (size_t)(m0 + r) * D + 4 * lane + 256 * j) = w; } }
        }
    }
    {
        LAS float* invf = (LAS float*)(lds + MISC_OFF + 9216);
        __syncthreads();
        if (tid < 48) invf[tid] = powf(10000.0f, (tid < 32) ? -(float)tid / 32.0f : -(float)(tid - 32) / 16.0f);
        __syncthreads();
        float* cs = (float*)(ws + WS_CS);
        for (int i = bid * NTHREADS + tid; i < NTOK * 48; i += G * NTHREADS) {
            const int row = i / 48, j = i % 48;
            const float ang = (float)p.pos[row] * invf[j];
            const float n = rintf(ang * 0.6366197723675814f);
            float r = fmaf(-n, 1.5707962512969971f, ang); r = fmaf(-n, 7.5497894158615964e-08f, r); r = fmaf(-n, 5.3903029534742384e-15f, r);
            const float t = r * 0.15915494309189535f;
            const float s0 = __builtin_amdgcn_sinf(t), c0 = __builtin_amdgcn_cosf(t);
            const int qd = (int)n & 3;
            const float sn = (qd == 0) ? s0 : (qd == 1) ? c0 : (qd == 2) ? -s0 : -c0;
            const float cc = (qd == 0) ? c0 : (qd == 1) ? -s0 : (qd == 2) ? -c0 : s0;
            cs[(size_t)row * 96 + j] = cc; cs[(size_t)row * 96 + 48 + j] = sn;
        }
    }
}

__device__ __forceinline__ void pool_phase(const Params& p, int bid, int G) {
    const int tid = threadIdx.x, lane = tid & 63, wave = __builtin_amdgcn_readfirstlane(tid >> 6);
    const int gw = bid * NWAVES + wave, NGW = G * NWAVES;
    const bf16_t* Pool = (const bf16_t*)(p.ws + WS_POOL); bf16_t* Mixed = (bf16_t*)(p.ws + WS_ACAT) + 512;
    const int w = 2 << (lane >> 4);
    for (int it = gw; it < NBATCH * 256; it += NGW) {
        const int b = it >> 8, tb = (it & 255) * 16;
        const bf16_t* P = Pool + (size_t)b * SEQ * 512 + 8 * lane;
        float sum[8];
#pragma unroll
        for (int q = 0; q < 8; ++q) sum[q] = 0.f;
        for (int d = 1; d < 16; ++d) if (d < w && tb - d >= 0) { float v[8]; ld8bf(P + (size_t)(tb - d) * 512, v);
#pragma unroll
            for (int q = 0; q < 8; ++q) sum[q] += v[q]; }
        for (int t = tb; t < tb + 16; ++t) {
            float cur[8]; ld8bf(P + (size_t)t * 512, cur);
#pragma unroll
            for (int q = 0; q < 8; ++q) sum[q] += cur[q];
            const float inv = 1.0f / (float)((t + 1 < w) ? t + 1 : w);
            float o[8];
#pragma unroll
            for (int q = 0; q < 8; ++q) o[q] = sum[q] * inv - cur[q];
            st8(Mixed + ((size_t)b * SEQ + t) * 1024 + 8 * lane, o);
            if (t - w + 1 >= 0) { float old[8]; ld8bf(P + (size_t)(t - w + 1) * 512, old);
#pragma unroll
                for (int q = 0; q < 8; ++q) sum[q] -= old[q]; }
        }
    }
}

__device__ __forceinline__ int wave_sum_i(int v) {
    v += __builtin_amdgcn_update_dpp(0, v, 0xB1, 0xF, 0xF, true);
    v += __builtin_amdgcn_update_dpp(0, v, 0x4E, 0xF, 0xF, true);
    v += __builtin_amdgcn_update_dpp(0, v, 0x141, 0xF, 0xF, true);
    v += __builtin_amdgcn_update_dpp(0, v, 0x140, 0xF, 0xF, true);
    v += __builtin_amdgcn_update_dpp(0, v, 0x142, 0xA, 0xF, true);
    v += __builtin_amdgcn_update_dpp(0, v, 0x143, 0xC, 0xF, true);
    return __builtin_amdgcn_readlane(v, 63);
}
__device__ __forceinline__ int count_ge(const unsigned (&key)[64], int nj, unsigned mid) {
    unsigned a0 = 0u, a1 = 0u; int nproc = 0;
#pragma unroll
    for (int jb = 0; jb < 4; ++jb) if (jb * 8 < nj) { nproc += 8;
#pragma unroll
        for (int q = 0; q < 8; ++q) a0 = __builtin_amdgcn_alignbit(a0, key[jb * 8 + q] - mid, 31); }
#pragma unroll
    for (int jb = 4; jb < 8; ++jb) if (jb * 8 < nj) { nproc += 8;
#pragma unroll
        for (int q = 0; q < 8; ++q) a1 = __builtin_amdgcn_alignbit(a1, key[jb * 8 + q] - mid, 31); }
    const int lt = wave_sum_i(__builtin_popcount(a0) + __builtin_popcount(a1));
    return 64 * nproc - lt;
}
__device__ __forceinline__ int lane_prefix(unsigned long long m) { return __builtin_amdgcn_mbcnt_hi((unsigned)(m >> 32), __builtin_amdgcn_mbcnt_lo((unsigned)m, 0u)); }
__device__ __forceinline__ unsigned wave_umax(unsigned v) {
#pragma unroll
    for (int o = 1; o < 64; o <<= 1) { const unsigned t = (unsigned)__shfl_xor((int)v, o); v = t > v ? t : v; }
    return (unsigned)__builtin_amdgcn_readfirstlane((int)v);
}
__device__ __forceinline__ unsigned wave_umin(unsigned v) {
#pragma unroll
    for (int o = 1; o < 64; o <<= 1) { const unsigned t = (unsigned)__shfl_xor((int)v, o); v = t < v ? t : v; }
    return (unsigned)__builtin_amdgcn_readfirstlane((int)v);
}

__device__ __forceinline__ void select_unit(const Params& p, LAS unsigned char* lds, int b, int t0) {
    int tid = threadIdx.x; asm volatile("" : "+v"(tid));
    const int lane = tid & 63, wave = __builtin_amdgcn_readfirstlane(tid >> 6);
    unsigned char* wsq = p.ws; asm volatile("" : "+s"(wsq));
    const GAS bf16_t* Qi = (const GAS bf16_t*)(wsq + WS_QI); const GAS bf16_t* Ki = (const GAS bf16_t*)(wsq + WS_KI); const GAS float* Wi = (const GAS float*)(wsq + WS_WI);
    GAS unsigned* M32 = (GAS unsigned*)(wsq + WS_MASK);
    LAS float* SC = (LAS float*)lds;
    const int c = t0 >> 6, nj = c + 1, nk = 64 * nj, ntile = nk >> 5;
    const size_t tok0 = (size_t)b * SEQ + t0;
    {
        const int r = lane & 31, hh = lane >> 5;
        bf16x8 qa[4];
        const GAS bf16_t* qp = Qi + (tok0 + (r >> 2)) * 256 + (r & 3) * 64 + 8 * hh;
#pragma unroll
        for (int ks = 0; ks < 4; ++ks) qa[ks] = *(const GAS bf16x8*)(qp + 16 * ks);
        f32x4 wv[4];
#pragma unroll
        for (int g = 0; g < 4; ++g) wv[g] = *(const GAS f32x4*)(Wi + (tok0 + 2 * g + hh) * 4);
        const GAS bf16_t* kif = Ki + (size_t)b * 128 * 4 * 512 + lane * 8;
        bf16x8 kbA[4][4], kbB[4][4];
#define LOADK(dst, k0) do { _Pragma("unroll") for (int u = 0; u < 4; ++u) { const int kt = ((k0) + u < ntile) ? (k0) + u : (k0); \
            _Pragma("unroll") for (int ks = 0; ks < 4; ++ks) dst[u][ks] = *(const GAS bf16x8*)(kif + (size_t)(kt * 4 + ks) * 512); } } while (0)
#define COMPK(src, k0) do { _Pragma("unroll") for (int u = 0; u < 4; ++u) if ((k0) + u < ntile) { f32x16 acc; \
            _Pragma("unroll") for (int q = 0; q < 16; ++q) acc[q] = 0.f; \
            _Pragma("unroll") for (int ks = 0; ks < 4; ++ks) acc = __builtin_amdgcn_mfma_f32_32x32x16_bf16(qa[ks], src[u][ks], acc, 0, 0, 0); \
            _Pragma("unroll") for (int g = 0; g < 4; ++g) { float sv = fmaf(wv[g][0], fmaxf(acc[4 * g], 0.f), 0.0f); \
                sv = fmaf(wv[g][1], fmaxf(acc[4 * g + 1], 0.f), sv); sv = fmaf(wv[g][2], fmaxf(acc[4 * g + 2], 0.f), sv); sv = fmaf(wv[g][3], fmaxf(acc[4 * g + 3], 0.f), sv); \
                SC[(2 * g + hh) * 4096 + ((k0) + u) * 32 + r] = sv; } } } while (0)
        int kt0 = wave * 4;
        if (kt0 < ntile) {
            LOADK(kbA, kt0);
            for (;;) {
                const int k1 = kt0 + NWAVES * 4; if (k1 < ntile) LOADK(kbB, k1);
                COMPK(kbA, kt0); if (k1 >= ntile) break;
                const int k2 = k1 + NWAVES * 4; if (k2 < ntile) LOADK(kbA, k2);
                COMPK(kbB, k1); if (k2 >= ntile) break;
                kt0 = k2;
            }
        }
#undef LOADK
#undef COMPK
    }
    __syncthreads();
    LAS float* row = SC + wave * 4096;
    unsigned key[64];
#pragma unroll
    for (int jb = 0; jb < 8; ++jb) {
#pragma unroll
        for (int q = 0; q < 8; ++q) key[jb * 8 + q] = 0u;
        if (jb * 8 < nj) {
#pragma unroll
            for (int q = 0; q < 8; ++q) { const int j = jb * 8 + q; const unsigned u = __float_as_uint(row[j * 64 + lane]); const unsigned kk = ((u & 0x80000000u) ? ~u : (u | 0x80000000u)) >> 1; key[j] = (j < nj) ? kk : 0u; }
        }
    }
    LDS_WAIT(); __syncthreads();
    unsigned hiSel = 1u, T = 0u; int rrem = 0;
    if (nk > 256) {
        unsigned g0 = 0u, g1 = 0u, g2 = 0u, g3 = 0u;
#pragma unroll
        for (int j = 0; j < 64; j += 4) { g0 = key[j] > g0 ? key[j] : g0; g1 = key[j + 1] > g1 ? key[j + 1] : g1; g2 = key[j + 2] > g2 ? key[j + 2] : g2; g3 = key[j + 3] > g3 ? key[j + 3] : g3; }
        const unsigned mx01 = g0 > g1 ? g0 : g1, mx23 = g2 > g3 ? g2 : g3, mn01 = g0 < g1 ? g0 : g1, mn23 = g2 < g3 ? g2 : g3;
        const unsigned km = wave_umax(mx01 > mx23 ? mx01 : mx23);
        unsigned lo = wave_umin(mn01 < mn23 ? mn01 : mn23), hi = km + 1u; int cnt_hi = 0; bool exact = false;
        while (hi - lo > 1u) {
            const unsigned mid = lo + ((hi - lo) >> 1);
            const int cnt = count_ge(key, nj, mid);
            if (cnt >= 256) { lo = mid; if (cnt == 256) { exact = true; break; } } else { hi = mid; cnt_hi = cnt; }
        }
        if (exact) { hiSel = lo; T = 0u; rrem = 0; } else { hiSel = hi; T = lo; rrem = 256 - cnt_hi; }
    }
    GAS unsigned* mrow = M32 + (tok0 + wave) * 128;
    unsigned mlo = 0u, mhi = 0u;
    if (rrem == 0) {
#pragma unroll
        for (int j = 0; j < 64; ++j) if ((j & ~7) < nj) {
            const unsigned long long sm = __ballot(key[j] >= hiSel);
            mlo = (lane == j) ? (unsigned)sm : mlo; mhi = (lane == j) ? (unsigned)(sm >> 32) : mhi;
        }
    } else {
#pragma unroll
        for (int j = 0; j < 64; ++j) if ((j & ~7) < nj) {
            const bool eq = (key[j] == T);
            const unsigned long long eqm = __ballot(eq);
            const bool take = eq && (lane_prefix(eqm) < rrem);
            const int ne = __popcll(eqm); rrem = (ne < rrem) ? rrem - ne : 0;
            const unsigned long long sm = __ballot((key[j] >= hiSel) || take);
            mlo = (lane == j) ? (unsigned)sm : mlo; mhi = (lane == j) ? (unsigned)(sm >> 32) : mhi;
        }
    }
    *(GAS u32x2*)(mrow + 2 * lane) = (u32x2){mlo, mhi};
}

__device__ __forceinline__ void dense_attn_chunk(const Params& p, int b, int c) {
    int tid = threadIdx.x; asm volatile("" : "+v"(tid));
    const int lane = tid & 63, wave = __builtin_amdgcn_readfirstlane(tid >> 6);
    unsigned char* wsq = p.ws; asm volatile("" : "+s"(wsq));
    const GAS bf16_t* Qb = (const GAS bf16_t*)(wsq + WS_Q); const GAS bf16_t* Kb = (const GAS bf16_t*)(wsq + WS_K); const GAS bf16_t* VT = (const GAS bf16_t*)(wsq + WS_VT);
    const GAS unsigned* M32 = (const GAS unsigned*)(wsq + WS_MASK); GAS bf16_t* Attn = (GAS bf16_t*)(wsq + WS_ACAT);
    float mq = fabsf(p.q_norm_g[lane]), mk = fabsf(p.k_norm_g[lane]);
#pragma unroll
    for (int o = 1; o < 64; o <<= 1) { mq = fmaxf(mq, __shfl_xor(mq, o)); mk = fmaxf(mk, __shfl_xor(mk, o)); }
    const float negC = -(8.0f * mq * mk * 1.4426950408889634f * 1.03f);
    const int kvh = wave >> 2, cl = lane & 31, hi = lane >> 5, ntile = 2 * (c + 1);
    const size_t tokc = (size_t)b * SEQ + 64 * c + 16 * (wave & 3);
    bf16x8 qf[2][4]; const GAS unsigned* mrow[2]; size_t tokq[2];
#pragma unroll
    for (int ti = 0; ti < 2; ++ti) { tokq[ti] = tokc + 8 * ti + (cl >> 2); mrow[ti] = M32 + tokq[ti] * 128;
#pragma unroll
        for (int ks = 0; ks < 4; ++ks) qf[ti][ks] = *(const GAS bf16x8*)(Qb + tokq[ti] * 512 + (4 * kvh + (cl & 3)) * 64 + 16 * ks + 8 * hi); }
    f32x16 o[2][2]; float lsum[2] = {0.f, 0.f};
#pragma unroll
    for (int ti = 0; ti < 2; ++ti)
#pragma unroll
        for (int dt = 0; dt < 2; ++dt)
#pragma unroll
            for (int q = 0; q < 16; ++q) o[ti][dt][q] = 0.f;
    const GAS bf16_t* kbase = Kb + (size_t)(b * 2 + kvh) * 128 * 4 * 512 + lane * 8;
    const GAS bf16_t* vbase = VT + (size_t)(b * 2 + kvh) * 128 * 4 * 512 + lane * 8;
    bf16x8 kfA[4], kfB[4], vfA[4], vfB[4]; unsigned mwA[2], mwB[2];
#define LOADT(kf, vf, mw, kt) do { _Pragma("unroll") for (int q = 0; q < 4; ++q) { kf[q] = *(const GAS bf16x8*)(kbase + (size_t)((kt) * 4 + q) * 512); vf[q] = *(const GAS bf16x8*)(vbase + (size_t)((kt) * 4 + q) * 512); } \
        mw[0] = mrow[0][kt]; mw[1] = mrow[1][kt]; } while (0)
#define COMPT(kf, vf, mw) do { _Pragma("unroll") for (int ti = 0; ti < 2; ++ti) { f32x16 sa; const unsigned mwh = mw[ti] >> (4 * hi); \
        _Pragma("unroll") for (int q = 0; q < 16; ++q) sa[q] = negC; \
        _Pragma("unroll") for (int ks = 0; ks < 4; ++ks) sa = __builtin_amdgcn_mfma_f32_32x32x16_bf16(kf[ks], qf[ti][ks], sa, 0, 0, 0); \
        float pv[16]; float ls = 0.f; \
        _Pragma("unroll") for (int r = 0; r < 16; ++r) { const int pos = (r & 3) + 8 * (r >> 2); \
            const float e = __builtin_amdgcn_exp2f(sa[r]); const int m = __builtin_amdgcn_sbfe((int)mwh, pos, 1); \
            pv[r] = __uint_as_float(__float_as_uint(e) & (unsigned)m); ls += pv[r]; } \
        lsum[ti] += ls; \
        _Pragma("unroll") for (int sx = 0; sx < 2; ++sx) { \
            u32x4 pw; pw.x = cvt_pk_bf16(pv[8 * sx], pv[8 * sx + 1]); pw.y = cvt_pk_bf16(pv[8 * sx + 2], pv[8 * sx + 3]); pw.z = cvt_pk_bf16(pv[8 * sx + 4], pv[8 * sx + 5]); pw.w = cvt_pk_bf16(pv[8 * sx + 6], pv[8 * sx + 7]); \
            const bf16x8 pb = __builtin_bit_cast(bf16x8, pw); \
            _Pragma("unroll") for (int dt = 0; dt < 2; ++dt) o[ti][dt] = __builtin_amdgcn_mfma_f32_32x32x16_bf16(vf[dt * 2 + sx], pb, o[ti][dt], 0, 0, 0); } } } while (0)
    LOADT(kfA, vfA, mwA, 0);
    for (int kt = 0; kt < ntile; kt += 2) {
        LOADT(kfB, vfB, mwB, kt + 1);
        COMPT(kfA, vfA, mwA);
        if (kt + 2 < ntile) LOADT(kfA, vfA, mwA, kt + 2);
        COMPT(kfB, vfB, mwB);
    }
#undef LOADT
#undef COMPT
    int lane2 = lane; asm volatile("" : "+v"(lane2));
    const int cl2 = lane2 & 31, hi2 = lane2 >> 5;
#pragma unroll
    for (int ti = 0; ti < 2; ++ti) {
        const float lt = lsum[ti] + __shfl_xor(lsum[ti], 32); const float inv = 1.0f / lt;
        GAS bf16_t* dst = Attn + (tokc + 8 * ti + (cl2 >> 2)) * 1024 + (4 * kvh + (cl2 & 3)) * 64 + 4 * hi2;
#pragma unroll
        for (int dt = 0; dt < 2; ++dt)
#pragma unroll
            for (int g4 = 0; g4 < 4; ++g4) { u32x2 w; w.x = cvt_pk_bf16(o[ti][dt][4 * g4] * inv, o[ti][dt][4 * g4 + 1] * inv); w.y = cvt_pk_bf16(o[ti][dt][4 * g4 + 2] * inv, o[ti][dt][4 * g4 + 3] * inv);
                *(GAS u32x2*)(dst + 32 * dt + 8 * g4) = w; }
    }
}

__device__ __forceinline__ void attn_phase(const Params& p, LAS unsigned char* lds, int bid, int G) {
    for (;;) {
        if (threadIdx.x == 0) { unsigned* ctr = (unsigned*)(p.ws + WS_CTL + 32768) + (blockIdx.x & 7) * 64;
            ((volatile LAS int*)(lds + MISC_OFF + 11264))[0] = (int)__hip_atomic_fetch_add(ctr, 1u, __ATOMIC_RELAXED, __HIP_MEMORY_SCOPE_AGENT); }
        __syncthreads();
        const int idx = __builtin_amdgcn_readfirstlane(((volatile LAS int*)(lds + MISC_OFF + 11264))[0]);
        __syncthreads();
        const int b = blockIdx.x & 7;
        if (idx >= 64) break;
        const int c = 63 - idx;
        for (int sx = 0; sx < 8; ++sx) select_unit(p, lds, b, 64 * c + 8 * sx);
        asm volatile("s_waitcnt vmcnt(0)" ::: "memory"); __syncthreads();
        dense_attn_chunk(p, b, c);
    }
}

constexpr int T_TSTART = 0, T_PADSTART = 40, T_BLOCKBASE = 80, T_NE = 112, T_WB = 144  , T_PART = 400  ;
__device__ __forceinline__ void router_phase(const Params& p, LAS unsigned char* lds, int bid, int G) {
    const int tid = threadIdx.x, lane = tid & 63, wave = __builtin_amdgcn_readfirstlane(tid >> 6);
    constexpr int WP = 1028;
    LAS float* WrT = (LAS float*)lds;
    {
        f32x4 wv_[16]; float gg_[16];
#pragma unroll
        for (int u = 0; u < 16; ++u) { const int i = tid + u * NTHREADS; wv_[u] = *(const f32x4*)(p.router_w + 4 * (size_t)i); gg_[u] = p.norm2_g[i >> 3]; }
#pragma unroll
        for (int u = 0; u < 16; ++u) { const int i = tid + u * NTHREADS; const int c = i >> 3, e0 = 4 * (i & 7);
            WrT[(e0 + 0) * WP + c] = wv_[u][0] * gg_[u]; WrT[(e0 + 1) * WP + c] = wv_[u][1] * gg_[u]; WrT[(e0 + 2) * WP + c] = wv_[u][2] * gg_[u]; WrT[(e0 + 3) * WP + c] = wv_[u][3] * gg_[u]; }
    }
    __syncthreads();
    LAS int* tbl = (LAS int*)(lds + MISC_OFF);
    const float* X1 = p.out; unsigned char* H2 = p.ws + WS_H2;
    int* rec_e = (int*)(p.ws + WS_REC_E); int* rec_pos = (int*)(p.ws + WS_REC_POS); float* rec_gate = (float*)(p.ws + WS_REC_GATE);
    const int ex = lane & 15, kq = lane >> 4;
    const size_t tokw = (size_t)bid * 128 + wave * 16;
    f32x4 acc0 = (f32x4){0.f, 0.f, 0.f, 0.f}, acc1 = acc0; float ssq = 0.f;
    {
        const float* xr = X1 + (tokw + ex) * D + 4 * kq;
        const LAS float* w0 = WrT + ex * WP + 4 * kq; const LAS float* w1 = w0 + 16 * WP;
#pragma unroll 16
        for (int q = 0; q < 64; ++q) {
            const f32x4 a = *(const f32x4*)(xr + 16 * q); const f32x4 b0 = *(const LAS f32x4*)(w0 + 16 * q), b1 = *(const LAS f32x4*)(w1 + 16 * q);
            ssq += (a.x * a.x + a.y * a.y) + (a.z * a.z + a.w * a.w);
#pragma unroll
            for (int k = 0; k < 4; ++k) { acc0 = __builtin_amdgcn_mfma_f32_16x16x4f32(a[k], b0[k], acc0, 0, 0, 0); acc1 = __builtin_amdgcn_mfma_f32_16x16x4f32(a[k], b1[k], acc1, 0, 0, 0); }
        }
    }
    ssq += __shfl_xor(ssq, 16); ssq += __shfl_xor(ssq, 32);
    const float rs = 1.0f / sqrtf(ssq * (1.0f / D) + NORM_EPS);
    const float br0 = p.router_b[ex], br1 = p.router_b[ex + 16];
    float lg0[4], lg1[4];
#pragma unroll
    for (int i = 0; i < 4; ++i) { const float r = __shfl(rs, 4 * kq + i); lg0[i] = acc0[i] * r + br0; lg1[i] = acc1[i] * r + br1; }
    int ti[4][4]; float tv[4][4];
#pragma unroll
    for (int r = 0; r < 4; ++r)
#pragma unroll
        for (int i = 0; i < 4; ++i) {
            float bv = (lg0[i] >= lg1[i]) ? lg0[i] : lg1[i]; int bi = (lg0[i] >= lg1[i]) ? ex : ex + 16;
#pragma unroll
            for (int m = 1; m < 16; m <<= 1) { const float ov = __shfl_xor(bv, m); const int oi = __shfl_xor(bi, m); const bool better = (ov > bv) || (ov == bv && oi < bi); bv = better ? ov : bv; bi = better ? oi : bi; }
            tv[i][r] = bv; ti[i][r] = bi;
            if (bi == ex) lg0[i] = -INFINITY; if (bi == ex + 16) lg1[i] = -INFINITY;
        }
    unsigned M[4];
#pragma unroll
    for (int i = 0; i < 4; ++i) M[i] = (1u << ti[i][0]) | (1u << ti[i][1]) | (1u << ti[i][2]) | (1u << ti[i][3]);
    unsigned Mall[16];
#pragma unroll
    for (int t = 0; t < 16; ++t) Mall[t] = (unsigned)__builtin_amdgcn_readlane((int)M[t & 3], 16 * (t >> 2));
#pragma unroll
    for (int i = 0; i < 4; ++i) {
        const int t = 4 * kq + i;
        const float e1 = __expf(tv[i][1] - tv[i][0]), e2 = __expf(tv[i][2] - tv[i][0]), e3 = __expf(tv[i][3] - tv[i][0]); const float inv = 1.0f / (1.0f + e1 + e2 + e3);
#pragma unroll
        for (int r = 0; r < 4; ++r) {
            const int x = ti[i][r]; int pos = 0;
#pragma unroll
            for (int tp = 0; tp < 16; ++tp) pos += (tp < t) ? (int)((Mall[tp] >> x) & 1u) : 0;
            const float gt = (r == 0 ? 1.0f : (r == 1 ? e1 : (r == 2 ? e2 : e3))) * inv;
            if (ex == r) { rec_e[(tokw + t) * 4 + r] = x; rec_pos[(tokw + t) * 4 + r] = pos; rec_gate[(tokw + t) * 4 + r] = gt; }
        }
    }
    { int cnt = 0;
#pragma unroll
        for (int t = 0; t < 16; ++t) cnt += (int)((Mall[t] >> (lane & 31)) & 1u);
        if (lane < 32) tbl[T_WB + wave * 32 + lane] = cnt; }
    {
        f32x4 g2[4];
#pragma unroll
        for (int j = 0; j < 4; ++j) g2[j] = *(const f32x4*)(p.norm2_g + 4 * lane + 256 * j);
#pragma unroll 4
        for (int t = 0; t < 16; ++t) {
            const float r = __shfl(rs, t);
            const f32x4* xr = (const f32x4*)(X1 + (tokw + t) * D) + lane;
#pragma unroll
            for (int j = 0; j < 4; ++j) { const f32x4 h = xr[64 * j] * r * g2[j]; *(unsigned*)(H2 + (tokw + t) * D + 4 * lane + 256 * j) = pk4_fp8(h.x, h.y, h.z, h.w); }
        }
    }
    __syncthreads();
    if (tid < 256) ((int*)(p.ws + WS_WCNT))[(size_t)bid * 256 + tid] = tbl[T_WB + tid];
    if (tid < 32) { int sm = 0;
#pragma unroll
        for (int w = 0; w < 8; ++w) sm += tbl[T_WB + w * 32 + tid];
        ((int*)(p.ws + WS_BCNT))[bid * 32 + tid] = sm; }
    __syncthreads();
}

__device__ __forceinline__ void moe_tables(const Params& p, LAS int* tbl, int bid) {
    const int tid = threadIdx.x; const int* bcnt = (const int*)(p.ws + WS_BCNT);
    { const int e = tid & 31, part = tid >> 5; int all = 0, below = 0;
        for (int k = 0; k < 16; ++k) { const int blk = part * 16 + k; const int v = bcnt[blk * 32 + e]; all += v; below += (blk < bid) ? v : 0; }
        tbl[T_PART + part * 32 + e] = all; tbl[T_PART + 512 + part * 32 + e] = below; }
    __syncthreads();
    if (tid < 32) { int all = 0, below = 0;
        for (int q = 0; q < 16; ++q) { all += tbl[T_PART + q * 32 + tid]; below += tbl[T_PART + 512 + q * 32 + tid]; }
        tbl[T_NE + tid] = all; tbl[T_BLOCKBASE + tid] = below; }
    __syncthreads();
    if (tid == 0) { int ps = 0, ts = 0;
        for (int e = 0; e < NEXP; ++e) { tbl[T_PADSTART + e] = ps; tbl[T_TSTART + e] = ts; const int nt = (tbl[T_NE + e] + 255) >> 8; ps += nt * 256; ts += nt; }
        tbl[T_PADSTART + NEXP] = ps; tbl[T_TSTART + NEXP] = ts; }
    __syncthreads();
}

__device__ __forceinline__ void permute_phase(const Params& p, LAS unsigned char* lds, int bid, int G) {
    const int tid = threadIdx.x, lane = tid & 63, wave = __builtin_amdgcn_readfirstlane(tid >> 6);
    LAS int* tbl = (LAS int*)(lds + MISC_OFF);
    moe_tables(p, tbl, bid);
    if (tid < 256) { const int w = tid >> 5, e = tid & 31; int s = 0; const int* wc = (const int*)(p.ws + WS_WCNT) + (size_t)bid * 256;
        for (int q = 0; q < 8; ++q) s += (q < w) ? wc[q * 32 + e] : 0;
        tbl[T_WB + tid] = s; }
    __syncthreads();
    const int* rec_e = (const int*)(p.ws + WS_REC_E); const int* rec_pos = (const int*)(p.ws + WS_REC_POS); const float* rec_gate = (const float*)(p.ws + WS_REC_GATE);
    int* slot_of = (int*)(p.ws + WS_SLOT_OF); float* slot_gate = (float*)(p.ws + WS_SLOT_GATE);
    const unsigned char* H2 = p.ws + WS_H2; unsigned char* H2S = p.ws + WS_H2S;
    for (int bt = 0; bt < 4; ++bt) {
        const int idx = wave * 64 + bt * 16 + (lane & 15); const int tl = idx >> 2; const size_t tk = (size_t)bid * 128 + tl;
        const int e = rec_e[tk * 4 + (idx & 3)], pw = rec_pos[tk * 4 + (idx & 3)];
        const int slot = tbl[T_PADSTART + e] + tbl[T_BLOCKBASE + e] + tbl[T_WB + (tl >> 4) * 32 + e] + pw;
        if (lane < 16) { slot_of[tk * 4 + (idx & 3)] = slot; slot_gate[slot] = rec_gate[tk * 4 + (idx & 3)]; }
        u32x4 v0[16];
#pragma unroll
        for (int i = 0; i < 16; ++i) { const size_t tki = (size_t)bid * 128 + ((wave * 64 + bt * 16 + i) >> 2); v0[i] = *(const u32x4*)(H2 + tki * D + 16 * lane); }
#pragma unroll
        for (int i = 0; i < 16; ++i) { const int sl = __shfl(slot, i); *(u32x4*)(H2S + (size_t)sl * D + 16 * lane) = v0[i]; }
    }
}

__device__ __forceinline__ void combine_phase(const Params& p, int bid, int G) {
    const int tid = threadIdx.x, lane = tid & 63, wave = __builtin_amdgcn_readfirstlane(tid >> 6);
    const int gw = bid * NWAVES + wave, NGW = G * NWAVES;
    const int* slot_of = (const int*)(p.ws + WS_SLOT_OF); const unsigned char* Y = p.ws + WS_Y;
    typedef float f32x2v __attribute__((ext_vector_type(2)));
    for (int tk = gw; tk < NTOK; tk += NGW) {
        int sl[4];
#pragma unroll
        for (int r = 0; r < 4; ++r) sl[r] = slot_of[(size_t)tk * 4 + r];
        float* orow = p.out + (size_t)tk * D;
        unsigned yv[4][4];
#pragma unroll
        for (int j = 0; j < 4; ++j)
#pragma unroll
            for (int r = 0; r < 4; ++r) yv[j][r] = *(const unsigned*)(Y + (size_t)sl[r] * D + 4 * lane + 256 * j);
#pragma unroll
        for (int j = 0; j < 4; ++j) { f32x4 a = *(const f32x4*)(orow + 4 * lane + 256 * j); float s0 = 0.f, s1 = 0.f, s2 = 0.f, s3 = 0.f;
#pragma unroll
            for (int r = 0; r < 4; ++r) { const f32x2v lo = __builtin_amdgcn_cvt_pk_f32_fp8((int)yv[j][r], false), hi = __builtin_amdgcn_cvt_pk_f32_fp8((int)yv[j][r], true); s0 += lo.x; s1 += lo.y; s2 += hi.x; s3 += hi.y; }
            a.x += s0 * (1.0f / Y_SCALE); a.y += s1 * (1.0f / Y_SCALE); a.z += s2 * (1.0f / Y_SCALE); a.w += s3 * (1.0f / Y_SCALE);
            *(f32x4*)(orow + 4 * lane + 256 * j) = a; }
    }
}

#define XB_TMO      128
#define XB_XCNT(j)  (256  + 64 * (j))
#define XB_XSUB(j)  (1280 + 64 * (j))
#define XB_XGEN(j)  (2304 + 64 * (j))
#define XB_TOP      3328
#define XB_TOPGEN   3392
#define XCD_BAR_WORDS 3456
#define XB_SPIN_CAP (1u << 18)

__device__ __forceinline__ unsigned xb_ld(unsigned* p)              { return __hip_atomic_load(p, __ATOMIC_RELAXED, __HIP_MEMORY_SCOPE_AGENT); }
__device__ __forceinline__ unsigned xb_add(unsigned* p, unsigned v) { return __hip_atomic_fetch_add(p, v, __ATOMIC_RELAXED, __HIP_MEMORY_SCOPE_AGENT); }
__device__ __forceinline__ unsigned xb_xcc_id() { return (unsigned)__builtin_amdgcn_s_getreg((3 << 11) | 20) & 0xFu; }
#define XB_SPIN(cond, bar) do { unsigned _sp = 0; while (cond) { __builtin_amdgcn_s_sleep(1); \
    if ((++_sp & 255u) == 0u) { if (xb_ld(&(bar)[XB_TMO])) break; if (_sp > XB_SPIN_CAP) { atomicAdd(&(bar)[XB_TMO], 1u); break; } } } } while (0)

struct XcdBarrier {
    unsigned* bar; unsigned x;
    volatile LAS unsigned* st;
};

__device__ __forceinline__ XcdBarrier xcd_barrier_post(unsigned* bar, volatile LAS unsigned* st) {
    XcdBarrier b; b.bar = bar; b.x = xb_xcc_id(); b.st = st;
    if (threadIdx.x == 0) (void)xb_add(&bar[XB_XCNT(b.x)], 1u);
    return b;
}
__device__ __forceinline__ void xcd_barrier_complete(unsigned* bar, unsigned x, unsigned& nloc, unsigned& nx) {
    const unsigned G = gridDim.x * gridDim.y * gridDim.z;
    unsigned sum, cnt, mine, sp = 0u;
    for (;;) {
        sum = 0u; cnt = 0u; mine = 0u;
#pragma unroll
        for (unsigned j = 0; j < 16; ++j) { const unsigned c = xb_ld(&bar[XB_XCNT(j)]); sum += c; cnt += (c > 0u) ? 1u : 0u; mine = (j == x) ? c : mine; }
        if (sum == G) break;
        __builtin_amdgcn_s_sleep(1);
        if ((++sp & 255u) == 0u) { if (xb_ld(&bar[XB_TMO])) break; if (sp > XB_SPIN_CAP) { atomicAdd(&bar[XB_TMO], 1u); break; } }
    }
    nloc = mine > 0u ? mine : 1u; nx = cnt > 0u ? cnt : 1u;
}

__device__ __forceinline__ void xcd_barrier(const XcdBarrier& b) {
    asm volatile("s_waitcnt vmcnt(0)" ::: "memory");
    __syncthreads();
    if (threadIdx.x == 0) {
        unsigned* bar = b.bar;
        __builtin_amdgcn_s_waitcnt(0);
        unsigned nloc = b.st[0], nx = b.st[1];
        if (nloc == 0u) { xcd_barrier_complete(bar, b.x, nloc, nx); b.st[0] = nloc; b.st[1] = nx; }
        const unsigned old = xb_add(&bar[XB_XSUB(b.x)], 1u);
        const unsigned gen = old / nloc;
        if (old + 1u == (gen + 1u) * nloc) {
            __builtin_amdgcn_fence(__ATOMIC_RELEASE, "agent");
            asm volatile("s_waitcnt vmcnt(0)" ::: "memory");
            const unsigned og = xb_add(&bar[XB_TOP], 1u);
            const unsigned tg = og / nx;
            if (og + 1u == (tg + 1u) * nx) xb_add(&bar[XB_TOPGEN], 1u);
            else XB_SPIN(xb_ld(&bar[XB_TOPGEN]) == tg, bar);
            __builtin_amdgcn_fence(__ATOMIC_ACQUIRE, "agent");
            xb_add(&bar[XB_XGEN(b.x)], 1u);
            asm volatile("s_waitcnt vmcnt(0)" ::: "memory");
        } else {
            XB_SPIN(xb_ld(&bar[XB_XGEN(b.x)]) == gen, bar);
            __builtin_amdgcn_fence(__ATOMIC_ACQUIRE, "agent");
            asm volatile("s_waitcnt vmcnt(0)" ::: "memory");
        }
    }
    __syncthreads();
}

constexpr int NPH = 11;
__global__ void __launch_bounds__(NTHREADS, 2) mega(Params p) {
    extern __shared__ __attribute__((aligned(16))) unsigned char lds_raw[];
    LAS unsigned char* lds = (LAS unsigned char*)lds_raw;
    cg::grid_group grid = cg::this_grid();
    const int bid = blockIdx.x, G = gridDim.x;
    unsigned char* ws = p.ws;
    if (p.ph_lo < 0) grid.sync();
    volatile LAS unsigned* bst = (volatile LAS unsigned*)(lds + MISC_OFF + 12032);
    if (threadIdx.x < 2) bst[threadIdx.x] = 0u;
    __syncthreads();
    const XcdBarrier xbar = xcd_barrier_post((unsigned*)(ws + WS_CTL + 4096), bst);
#ifndef PH_MASK
#define PH_MASK 0x7ff
#endif
#define IN(k) (((PH_MASK >> (k)) & 1) && p.ph_lo <= (k) && (k) < p.ph_hi)
#ifndef PH_DUP
#define PH_DUP 0
#endif
#define DUP(k) (((PH_DUP >> (k)) & 1) ? 2 : 1)
#define STAMP(k) do { if (TS_PHASE >= 0 && ((k) == TS_PHASE || (k) == TS_PHASE + 1)) { if (blockIdx.x == 0 && __builtin_amdgcn_readfirstlane(threadIdx.x) < 64) { unsigned tv_ = (unsigned)__builtin_amdgcn_s_memrealtime(); unsigned ad_ = MISC_OFF + 10240 + 4 * ((k) - TS_PHASE); asm volatile("ds_write_b32 %0, %1\n\ts_waitcnt lgkmcnt(0)" :: "v"(ad_), "v"(tv_) : "memory"); } } } while (0)
#define SEAM(k) do { if (IN(k) && IN((k) + 1)) xcd_barrier(xbar); STAMP((k) + 1); } while (0)
    volatile LAS unsigned* tsv = (volatile LAS unsigned*)(lds + MISC_OFF + 10240);
    STAMP(0);
    if (IN(0)) { phase0(p, lds, bid, G); }
    SEAM(0);
    if (IN(1)) {
        pg8::Gemm g{(const bf16_t*)(ws + WS_XN), (const bf16_t*)(ws + WS_WIN), NTOK, INWP, D}; pg8::StaticOrder S; S.init(NTOK, INWP, G, bid);
        EpiInProj E{(bf16_t*)(ws + WS_Q), (bf16_t*)(ws + WS_K), (bf16_t*)(ws + WS_VT), (bf16_t*)(ws + WS_QI), (bf16_t*)(ws + WS_KI), (bf16_t*)(ws + WS_POOL), (bf16_t*)(ws + WS_GA), (bf16_t*)(ws + WS_GP),
                    (float*)(ws + WS_WI), (const float*)(ws + WS_CS), p.q_norm_g, p.k_norm_g, p.idx_g, p.idx_b};
        pg8::gemm_phase(lds, g, S, E);
    }
    SEAM(1);
    if (IN(2)) { pool_phase(p, bid, G); attn_phase(p, lds, bid, G); }
    SEAM(2);
    if (IN(3)) {
        pg8::Gemm g{(const bf16_t*)(ws + WS_ACAT), (const bf16_t*)(ws + WS_WCAT), NTOK, D, D}; pg8::StaticOrder S; S.init(NTOK, D, G, bid);
        EpiGated E{(const bf16_t*)(ws + WS_GA), (const bf16_t*)(ws + WS_GP), (bf16_t*)(ws + WS_MERGED)};
        pg8::gemm_phase(lds, g, S, E);
    }
    SEAM(4); STAMP(4);
    if (IN(5)) {
        pg8::Gemm g{(const bf16_t*)(ws + WS_MERGED), (const bf16_t*)(ws + WS_WOUT), NTOK, D, D}; pg8::StaticOrder S; S.init(NTOK, D, G, bid);
        EpiResid E{p.x, p.out};
        pg8::gemm_phase(lds, g, S, E);
    }
    SEAM(5);
    if (IN(6)) { router_phase(p, lds, bid, G); }
    SEAM(6);
    if (IN(7)) { permute_phase(p, lds, bid, G); }
    SEAM(7);
    if (IN(8)) {
        LAS int* tbl = (LAS int*)(lds + MISC_OFF); moe_tables(p, tbl, bid);
        pg8::Gemm g{(const bf16_t*)(ws + WS_H2S), (const bf16_t*)(ws + WS_WGU), NSLOT, NEXP * 2048, D}; pg8::MoeOrder<8> S{tbl + T_TSTART, G, bid};
        EpiGateUp E{p.b_gu, ws + WS_ACT};
        pg8::gemm_phase<EpiGateUp, pg8::MoeOrder<8>, true>(lds, g, S, E);
    }
    SEAM(8);
    if (IN(9)) {
        LAS int* tbl = (LAS int*)(lds + MISC_OFF); moe_tables(p, tbl, bid);
        pg8::Gemm g{(const bf16_t*)(ws + WS_ACT), (const bf16_t*)(ws + WS_WD), NSLOT, NEXP * 1024, D}; pg8::MoeOrder<4> S{tbl + T_TSTART, G, bid};
        EpiDown E{p.b_d, (const float*)(ws + WS_SLOT_GATE), ws + WS_Y};
        pg8::gemm_phase<EpiDown, pg8::MoeOrder<4>, true>(lds, g, S, E);
    }
    SEAM(9);
    if (IN(10)) combine_phase(p, bid, G);
    STAMP(11);
    if (TS_PHASE >= 0 && blockIdx.x == 0 && threadIdx.x == 0) {
        const unsigned d = tsv[1] - tsv[0], t0 = (unsigned)__builtin_amdgcn_s_memrealtime();
        while ((unsigned)__builtin_amdgcn_s_memrealtime() - t0 < d) __builtin_amdgcn_s_sleep(8);
    }
#undef IN
#undef SEAM
}

extern "C" void kernel_launch(void* const* d_in, const int* in_sizes, int n_in, void* d_out, int out_size, void* d_ws, size_t ws_size, hipStream_t stream) {
    static int grid = 0;
    if (grid == 0) {
        if (n_in != 20 || out_size != NTOK * D || ws_size < WS_END) { fprintf(stderr, "kernel_launch: unexpected shapes: n_in %d out %d ws %zu (need %zu)\n", n_in, out_size, ws_size, (size_t)WS_END); grid = -1; return; }
        int dev = 0, cus = 0, per_cu = 0;
        hipGetDevice(&dev); hipDeviceGetAttribute(&cus, hipDeviceAttributeMultiprocessorCount, dev);
        if (hipFuncSetAttribute((const void*)mega, hipFuncAttributeMaxDynamicSharedMemorySize, LDS_BYTES) != hipSuccess) { fprintf(stderr, "kernel_launch: hipFuncSetAttribute failed\n"); grid = -1; return; }
        if (hipOccupancyMaxActiveBlocksPerMultiprocessor(&per_cu, (const void*)mega, NTHREADS, LDS_BYTES) != hipSuccess || per_cu < 1) { fprintf(stderr, "kernel_launch: occupancy query says %d blocks per CU\n", per_cu); per_cu = 1; }
        (void)hipGetLastError();
        grid = cus;
        if (grid != 256) fprintf(stderr, "kernel_launch: %d CUs; the router / permute phases assume a 256-workgroup grid\n", grid);
    }
    if (grid < 0) return;
    if (hipMemsetAsync((char*)d_ws + WS_CTL, 0, 64 * 1024, stream) != hipSuccess) { fprintf(stderr, "kernel_launch: hipMemsetAsync of the control words failed\n"); return; }
    Params p{};
    p.x = (const float*)d_in[0]; p.pos = (const int*)d_in[1]; p.norm1_g = (const float*)d_in[2]; p.w_in = (const float*)d_in[3]; p.q_norm_g = (const float*)d_in[4];
    p.k_norm_g = (const float*)d_in[5]; p.idx_g = (const float*)d_in[6]; p.idx_b = (const float*)d_in[7]; p.w_a = (const float*)d_in[8]; p.pool_mix = (const float*)d_in[9];
    p.pool_scale = (const float*)d_in[10]; p.w_b = (const float*)d_in[11]; p.w_out = (const float*)d_in[12]; p.norm2_g = (const float*)d_in[13]; p.router_w = (const float*)d_in[14];
    p.router_b = (const float*)d_in[15]; p.w_gu = (const float*)d_in[16]; p.b_gu = (const float*)d_in[17]; p.w_d = (const float*)d_in[18]; p.b_d = (const float*)d_in[19];
    p.out = (float*)d_out; p.ws = (unsigned char*)d_ws;
#if MK_MODE == 0
    p.ph_lo = 0; p.ph_hi = NPH;
    void* args[] = {&p};
    hipError_t e = hipLaunchCooperativeKernel((const void*)mega, dim3(grid), dim3(NTHREADS), args, LDS_BYTES, stream);
    if (e != hipSuccess) fprintf(stderr, "kernel_launch: cooperative launch failed: %s (grid %d)\n", hipGetErrorString(e), grid);
#else
    for (int k = 0; k < NPH; ++k) { p.ph_lo = k; p.ph_hi = k + 1; hipLaunchKernelGGL(mega, dim3(grid), dim3(NTHREADS), LDS_BYTES, stream, p); }
#endif
}
```
